# Optimizing an MI355X kernel written in HIP

```python
import math
import jax, jax.numpy as jnp
from jax import lax
import numpy as np

D_MODEL = 1024
BATCH = 16
SEQ = 4096
DEPTH = 4

HEAD_DIM = 64
A_WIDTH = D_MODEL // 2
A_HEADS = A_WIDTH // HEAD_DIM
DILATED_BRANCHES = ((128, 1), (512, 4), (2048, 16))
BLOCK = 128
B_WIDTH = D_MODEL // 2
B_GROUPS = 4
B_GROUP_CH = B_WIDTH // B_GROUPS
CHUNK = 128
C_WIDTH = D_MODEL // 2
CONV_WIDTH = 31
D_WIDTH = D_MODEL // 2
D_HEADS = D_WIDTH // HEAD_DIM
N_BUCKETS = 32
MAX_DISTANCE = 2048
N_GROUPS = 4
EXPERTS_PER_GROUP = 4
N_EXPERTS = N_GROUPS * EXPERTS_PER_GROUP
EXPERT_TOP_K = 2
D_EXPERT = D_MODEL // 2
EPS = 1e-6
NEG = -1e30
N_EVEN = (DEPTH + 1) // 2
N_ODD = DEPTH // 2

kernel_name = "hybrid_dilated_gmlp_conformer_stickbreak_hmoe"


def rms_norm(x, g):
    xf = x.astype(jnp.float32)
    y = xf * lax.rsqrt(jnp.mean(xf * xf, -1, keepdims=True) + EPS)
    return (y * g.astype(jnp.float32)).astype(x.dtype)


def layer_norm(x, g, b):
    xf = x.astype(jnp.float32)
    mu = jnp.mean(xf, -1, keepdims=True)
    xc = xf - mu
    var = jnp.mean(xc * xc, -1, keepdims=True)
    y = xc * lax.rsqrt(var + EPS) * g.astype(jnp.float32) + b.astype(jnp.float32)
    return y.astype(x.dtype)


def t5_bucket(dist):
    max_exact = N_BUCKETS // 2
    d = np.maximum(dist, 1).astype(np.float32)
    large = max_exact + (np.log(d / max_exact) / np.log(MAX_DISTANCE / max_exact)
                         * (N_BUCKETS - max_exact)).astype(np.int32)
    large = np.minimum(large, N_BUCKETS - 1)
    return np.where(dist < max_exact, dist, large).astype(np.int32)


def dilated_branch(q, k, v, rel_table, window, dilation):
    b, h, s, hd = q.shape
    n_keys = window // dilation
    sub_len = -(-s // dilation)
    lp = -(-sub_len // BLOCK) * BLOCK
    sp = lp * dilation
    nb = lp // BLOCK
    pad = ((0, 0), (0, 0), (0, sp - s), (0, 0))

    def to_blocks(t):
        t = jnp.pad(t, pad).reshape(b, h, lp, dilation, hd)
        t = jnp.swapaxes(t, 2, 3)
        return t.reshape(b, h, dilation, nb, BLOCK, hd)

    def with_prev(t):
        prev = jnp.pad(t, ((0, 0), (0, 0), (0, 0), (1, 0), (0, 0), (0, 0)))[:, :, :, :-1]
        return jnp.concatenate([prev, t], axis=4)

    qb = to_blocks(q)
    kb = with_prev(to_blocks(k))
    vb = with_prev(to_blocks(v))
    scores = jnp.einsum('bhrnqd,bhrnkd->bhrnqk', qb, kb)

    qi = np.arange(BLOCK)[:, None]
    kj = np.arange(2 * BLOCK)[None, :]
    sub_dist = qi + BLOCK - kj
    in_window = (sub_dist >= 0) & (sub_dist <= n_keys)
    bucket = t5_bucket(np.clip(sub_dist, 0, None) * dilation)
    bias = jnp.transpose(rel_table.astype(jnp.float32)[bucket], (2, 0, 1))
    first_block = (np.arange(nb) == 0)[:, None, None]
    valid = in_window[None] & ~(first_block & (kj < BLOCK)[None])
    logits = jnp.where(valid, scores + bias[None, :, None, None], NEG)

    mx = jnp.max(logits, -1)
    p = jnp.exp(logits - mx[..., None])
    den = jnp.sum(p, -1)
    num = jnp.einsum('bhrnqk,bhrnkd->bhrnqd', p, vb)

    def from_blocks(t):
        rest = t.shape[5:]
        t = t.reshape(b, h, dilation, lp, *rest)
        t = jnp.swapaxes(t, 2, 3).reshape(b, h, sp, *rest)
        return t[:, :, :s]

    return from_blocks(num), from_blocks(den), from_blocks(mx)


def dilated_attention(q, k, v, rel_table):
    b, s, h, hd = q.shape
    qf = jnp.swapaxes(q.astype(jnp.float32), 1, 2) * (hd ** -0.5)
    kf = jnp.swapaxes(k.astype(jnp.float32), 1, 2)
    vf = jnp.swapaxes(v.astype(jnp.float32), 1, 2)
    outs = [dilated_branch(qf, kf, vf, rel_table, w, d) for (w, d) in DILATED_BRANCHES]
    m_all = jnp.max(jnp.stack([m for (_, _, m) in outs]), 0)
    num = sum(n * jnp.exp(m - m_all)[..., None] for (n, _, m) in outs)
    den = sum(l * jnp.exp(m - m_all) for (_, l, m) in outs)
    o = num / den[..., None]
    return jnp.swapaxes(o, 1, 2).reshape(b, s, h * hd)


def spatial_gating(u, v, ln_g, ln_b, w_s, b_s):
    b, s, _ = v.shape
    u = jax.nn.gelu(u)
    v = layer_norm(jax.nn.gelu(v), ln_g, ln_b)
    vc = v.reshape(b, s // CHUNK, CHUNK, B_GROUPS, B_GROUP_CH)
    tril = np.tril(np.ones((CHUNK, CHUNK), dtype=bool))
    w = jnp.where(tril[None], w_s, 0.0)
    mixed = jnp.einsum('gts,bnsgc->bntgc', w, vc) + jnp.swapaxes(b_s, 0, 1)[None, None, :, :, None]
    return u * mixed.reshape(b, s, B_WIDTH).astype(u.dtype)


def conv_module(a, gate, w_dw, b_dw, ln_g, ln_b):
    hcur = a * jax.nn.sigmoid(gate)
    hcur = lax.conv_general_dilated(
        hcur, w_dw[:, None, :].astype(hcur.dtype), window_strides=(1,),
        padding=[(CONV_WIDTH - 1, 0)], dimension_numbers=('NWC', 'WIO', 'NWC'),
        feature_group_count=C_WIDTH) + b_dw
    hcur = layer_norm(hcur, ln_g, ln_b)
    return jax.nn.silu(hcur)


def stick_breaking_attention(q, k, v):
    b, s, h, hd = q.shape
    qf = jnp.transpose(q.astype(jnp.float32), (0, 2, 1, 3)) * (hd ** -0.5)
    kf = jnp.transpose(k.astype(jnp.float32), (0, 2, 1, 3))
    vf = jnp.transpose(v.astype(jnp.float32), (0, 2, 1, 3))
    nb = s // BLOCK
    q_blocks = jnp.moveaxis(qf.reshape(b, h, nb, BLOCK, hd), 2, 0)
    key_pos = jnp.arange(s)

    def block(args):
        qb, i = args
        z = jnp.einsum('bhqd,bhkd->bhqk', qb, kf)
        t = i * BLOCK + jnp.arange(BLOCK)
        causal = key_pos[None, :] < t[:, None]
        log_keep = jnp.where(causal, jax.nn.log_sigmoid(-z), 0.0)
        between = lax.cumsum(log_keep, axis=3, reverse=True) - log_keep
        att = jnp.where(causal, jnp.exp(jax.nn.log_sigmoid(z) + between), 0.0)
        return jnp.einsum('bhqk,bhkd->bhqd', att, vf)

    out = lax.map(block, (q_blocks, jnp.arange(nb)))
    out = jnp.moveaxis(out, 0, 2).reshape(b, h, s, hd)
    return jnp.transpose(out, (0, 2, 1, 3)).reshape(b, s, h * hd)


def hierarchical_moe(hin, w_group, b_group, w_router, b_router, w_gate, w_up, w_down):
    b, s, d = hin.shape
    xt = hin.reshape(b * s, d)
    xf = xt.astype(jnp.float32)
    g_prob = jax.nn.softmax(xf @ w_group.astype(jnp.float32) + b_group.astype(jnp.float32), -1)
    g_w, g_idx = lax.top_k(g_prob, 1)
    e_logits = jnp.einsum('td,gde->tge', xf, w_router.astype(jnp.float32)) + b_router.astype(jnp.float32)
    e_logits = jnp.take_along_axis(e_logits, g_idx[:, :, None], axis=1)[:, 0]
    e_val, e_idx = lax.top_k(e_logits, EXPERT_TOP_K)
    e_w = jax.nn.softmax(e_val, -1)
    flat_idx = g_idx * EXPERTS_PER_GROUP + e_idx
    gates = jnp.sum(jax.nn.one_hot(flat_idx, N_EXPERTS, dtype=jnp.float32)
                    * (g_w * e_w)[..., None], axis=1)
    y = jnp.zeros((b * s, d), jnp.float32)
    for e in range(N_EXPERTS):
        hid = jax.nn.silu(xt @ w_gate[e]) * (xt @ w_up[e])
        y = y + gates[:, e:e + 1] * (hid @ w_down[e]).astype(jnp.float32)
    return y.astype(hin.dtype).reshape(b, s, d)


def setup_inputs(seed: int = 0) -> dict:
    key = jax.random.key(seed)
    ks = iter(jax.random.split(key, 32))

    def nrm(shape, scale):
        return scale * jax.random.normal(next(ks), shape, jnp.float32)

    d = D_MODEL
    ev_in = 3 * A_WIDTH + 2 * B_WIDTH
    od_in = 2 * C_WIDTH + 3 * D_WIDTH
    return {
        "x": nrm((BATCH, SEQ, d), 1.0),
        "c": nrm((BATCH, d), 1.0),
        "rel_bias": nrm((N_BUCKETS, A_HEADS), 0.5),
        "norm1_g": 1.0 + nrm((DEPTH, d), 0.1),
        "norm2_g": 1.0 + nrm((DEPTH, d), 0.1),
        "w_ada": nrm((DEPTH, d, 6 * d), 0.5 * d ** -0.5),
        "b_ada": nrm((DEPTH, 6 * d), 0.02),
        "ev_w_in": nrm((N_EVEN, d, ev_in), d ** -0.5),
        "ev_w_out": nrm((N_EVEN, A_WIDTH + B_WIDTH, d), (A_WIDTH + B_WIDTH) ** -0.5),
        "ev_gmlp_ln_g": 1.0 + nrm((N_EVEN, B_WIDTH), 0.1),
        "ev_gmlp_ln_b": nrm((N_EVEN, B_WIDTH), 0.02),
        "ev_w_s": nrm((N_EVEN, B_GROUPS, CHUNK, CHUNK), CHUNK ** -0.5),
        "ev_b_s": 1.0 + nrm((N_EVEN, B_GROUPS, CHUNK), 0.1),
        "od_w_in": nrm((N_ODD, d, od_in), d ** -0.5),
        "od_w_out": nrm((N_ODD, C_WIDTH + D_WIDTH, d), (C_WIDTH + D_WIDTH) ** -0.5),
        "od_w_dw": nrm((N_ODD, CONV_WIDTH, C_WIDTH), CONV_WIDTH ** -0.5),
        "od_b_dw": nrm((N_ODD, C_WIDTH), 0.02),
        "od_conv_ln_g": 1.0 + nrm((N_ODD, C_WIDTH), 0.1),
        "od_conv_ln_b": nrm((N_ODD, C_WIDTH), 0.02),
        "moe_w_group": nrm((DEPTH, d, N_GROUPS), d ** -0.5),
        "moe_b_group": nrm((DEPTH, N_GROUPS), 0.01),
        "moe_w_router": nrm((DEPTH, N_GROUPS, d, EXPERTS_PER_GROUP), d ** -0.5),
        "moe_b_router": nrm((DEPTH, N_GROUPS, EXPERTS_PER_GROUP), 0.01),
        "moe_w_gate": nrm((DEPTH, N_EXPERTS, d, D_EXPERT), d ** -0.5),
        "moe_w_up": nrm((DEPTH, N_EXPERTS, d, D_EXPERT), d ** -0.5),
        "moe_w_down": nrm((DEPTH, N_EXPERTS, D_EXPERT, d), D_EXPERT ** -0.5),
        "final_norm_g": 1.0 + nrm((d,), 0.1),
    }


def reference(x, c, rel_bias, norm1_g, norm2_g, w_ada, b_ada, ev_w_in, ev_w_out,
              ev_gmlp_ln_g, ev_gmlp_ln_b, ev_w_s, ev_b_s, od_w_in, od_w_out, od_w_dw,
              od_b_dw, od_conv_ln_g, od_conv_ln_b, moe_w_group, moe_b_group, moe_w_router,
              moe_b_router, moe_w_gate, moe_w_up, moe_w_down, final_norm_g):
    b, s, _ = x.shape
    for layer in range(DEPTH):
        j = layer // 2
        mod = jax.nn.silu(c) @ w_ada[layer] + b_ada[layer]
        sh1, sc1, g1, sh2, sc2, g2 = jnp.split(mod[:, None, :], 6, axis=-1)
        hcur = rms_norm(x, norm1_g[layer]) * (1 + sc1) + sh1
        if layer % 2 == 0:
            proj = hcur @ ev_w_in[j]
            q, k, v, u, gv = jnp.split(
                proj, [A_WIDTH, 2 * A_WIDTH, 3 * A_WIDTH, 3 * A_WIDTH + B_WIDTH], axis=-1)
            o_a = dilated_attention(q.reshape(b, s, A_HEADS, HEAD_DIM),
                                    k.reshape(b, s, A_HEADS, HEAD_DIM),
                                    v.reshape(b, s, A_HEADS, HEAD_DIM), rel_bias)
            o_b = spatial_gating(u, gv, ev_gmlp_ln_g[j], ev_gmlp_ln_b[j], ev_w_s[j], ev_b_s[j])
            mix = jnp.concatenate([o_a.astype(x.dtype), o_b.astype(x.dtype)], -1) @ ev_w_out[j]
        else:
            proj = hcur @ od_w_in[j]
            a, gate, q, k, v = jnp.split(
                proj, [C_WIDTH, 2 * C_WIDTH, 2 * C_WIDTH + D_WIDTH, 2 * C_WIDTH + 2 * D_WIDTH], axis=-1)
            o_c = conv_module(a, gate, od_w_dw[j], od_b_dw[j], od_conv_ln_g[j], od_conv_ln_b[j])
            o_d = stick_breaking_attention(q.reshape(b, s, D_HEADS, HEAD_DIM),
                                           k.reshape(b, s, D_HEADS, HEAD_DIM),
                                           v.reshape(b, s, D_HEADS, HEAD_DIM))
            mix = jnp.concatenate([o_c.astype(x.dtype), o_d.astype(x.dtype)], -1) @ od_w_out[j]
        x = x + g1 * mix
        hcur = rms_norm(x, norm2_g[layer]) * (1 + sc2) + sh2
        x = x + g2 * hierarchical_moe(hcur, moe_w_group[layer], moe_b_group[layer],
                                      moe_w_router[layer], moe_b_router[layer],
                                      moe_w_gate[layer], moe_w_up[layer], moe_w_down[layer])
    return rms_norm(x, final_norm_g)
```

```cpp
#include <hip/hip_runtime.h>
#include <cstdio>
#include <cstdint>

#define LAS __attribute__((address_space(3)))
#define GAS __attribute__((address_space(1)))
typedef unsigned short bf16_t;
typedef short bf16x8 __attribute__((ext_vector_type(8)));
typedef float f32x4 __attribute__((ext_vector_type(4)));
typedef float f32x2 __attribute__((ext_vector_type(2)));
typedef float f32x16 __attribute__((ext_vector_type(16)));
typedef unsigned u32x4 __attribute__((ext_vector_type(4)));
typedef unsigned u32x2 __attribute__((ext_vector_type(2)));
typedef __bf16 bf16x2v __attribute__((ext_vector_type(2)));

constexpr int T = 65536, D = 1024, SEQ = 4096, NBATCH = 16, NL = 4, NPROJ = 2560, NEXP = 16, DE = 512, NCLS = 24;
constexpr float EPS = 1e-6f;
constexpr int NWAVES = 8, NTHREADS = 512;

constexpr size_t MiB = 1u << 20;
constexpr size_t WS_CTL = 0, CTL_ZERO_BYTES = 1 * MiB;
constexpr size_t WS_WIN = 2 * MiB;
constexpr size_t WS_WOUT = 22 * MiB;
constexpr size_t WS_WS = 30 * MiB;
constexpr size_t WS_MOD = 31 * MiB;
constexpr size_t WS_RW = 33 * MiB;
constexpr size_t WS_LIST = 34 * MiB;
constexpr size_t WS_WGU = 40 * MiB;
constexpr size_t WS_WDT = 168 * MiB;
constexpr size_t WS_HBUF = 232 * MiB;
constexpr size_t WS_MIX = 360 * MiB;
constexpr size_t WS_PROJ = 488 * MiB;
constexpr size_t WS_END = 808 * MiB;
constexpr int HID_ROWS = T + NCLS * 256;
constexpr size_t WS_HSORT = WS_PROJ + 160 * MiB;
constexpr int CW_BAR = 4096;
constexpr int CW_CNT = 8192;

constexpr int LDS_BYTES = 155648;
constexpr int MISC_OFF = LDS_BYTES - 1024;

__device__ __forceinline__ unsigned pk2(float a, float b) { f32x2 v = {a, b}; bf16x2v r = __builtin_convertvector(v, bf16x2v); return __builtin_bit_cast(unsigned, r); }
__device__ __forceinline__ float bf_lo(unsigned u) { return __uint_as_float(u << 16); }
__device__ __forceinline__ float bf_hi(unsigned u) { return __uint_as_float(u & 0xffff0000u); }
__device__ __forceinline__ float bf1(bf16_t b) { return __uint_as_float(((unsigned)b) << 16); }
__device__ __forceinline__ float wave_sum(float v) {
#pragma unroll
    for (int o = 1; o < 64; o <<= 1) v += __shfl_xor(v, o);
    return v;
}
__device__ __forceinline__ float wave_max(float v) {
#pragma unroll
    for (int o = 1; o < 64; o <<= 1) v = fmaxf(v, __shfl_xor(v, o));
    return v;
}
__device__ __forceinline__ float silu_f(float x) { return x / (1.f + __expf(-x)); }
__device__ __forceinline__ float sigmoid_f(float x) { return 1.f / (1.f + __expf(-x)); }
__device__ __forceinline__ float gelu_tanh(float x) {
    const float u = 0.7978845608028654f * (x + 0.044715f * x * x * x);
    const float e = __expf(2.f * u);
    const float th = 1.f - 2.f / (e + 1.f);
    return 0.5f * x * (1.f + th);
}
#define LDS_WAIT() asm volatile("s_waitcnt lgkmcnt(0)" ::: "memory")

#define XB_TMO      128
#define XB_XCNT(j)  (256  + 64 * (j))
#define XB_XSUB(j)  (1280 + 64 * (j))
#define XB_XGEN(j)  (2304 + 64 * (j))
#define XB_TOP      3328
#define XB_TOPGEN   3392
#define XCD_BAR_WORDS 3456
#define XB_SPIN_CAP (1u << 20)

__device__ __forceinline__ unsigned xb_ld(unsigned* p)              { return __hip_atomic_load(p, __ATOMIC_RELAXED, __HIP_MEMORY_SCOPE_AGENT); }
__device__ __forceinline__ unsigned xb_add(unsigned* p, unsigned v) { return __hip_atomic_fetch_add(p, v, __ATOMIC_RELAXED, __HIP_MEMORY_SCOPE_AGENT); }
__device__ __forceinline__ unsigned xb_xcc_id() { return (unsigned)__builtin_amdgcn_s_getreg((3 << 11) | 20) & 0xFu; }
#define XB_SPIN(cond, bar) do { unsigned _sp = 0; while (cond) { __builtin_amdgcn_s_sleep(1); \
    if ((++_sp & 255u) == 0u) { if (xb_ld(&(bar)[XB_TMO])) break; if (_sp > XB_SPIN_CAP) { atomicAdd(&(bar)[XB_TMO], 1u); break; } } } } while (0)

struct XcdBarrier { unsigned* bar; unsigned x; volatile LAS unsigned* st; };

__device__ __forceinline__ XcdBarrier xcd_barrier_post(unsigned* bar, volatile LAS unsigned* st) {
    XcdBarrier b; b.bar = bar; b.x = xb_xcc_id(); b.st = st;
    if (threadIdx.x == 0) (void)xb_add(&bar[XB_XCNT(b.x)], 1u);
    return b;
}
__device__ __forceinline__ void xcd_barrier_complete(unsigned* bar, unsigned x, unsigned& nloc, unsigned& nx) {
    const unsigned G = gridDim.x * gridDim.y * gridDim.z;
    unsigned sum, cnt, mine, sp = 0u;
    for (;;) {
        sum = 0u; cnt = 0u; mine = 0u;
#pragma unroll
        for (unsigned j = 0; j < 16; ++j) { const unsigned c = xb_ld(&bar[XB_XCNT(j)]); sum += c; cnt += (c > 0u) ? 1u : 0u; mine = (j == x) ? c : mine; }
        if (sum == G) break;
        __builtin_amdgcn_s_sleep(1);
        if ((++sp & 255u) == 0u) { if (xb_ld(&bar[XB_TMO])) break; if (sp > XB_SPIN_CAP) { atomicAdd(&bar[XB_TMO], 1u); break; } }
    }
    nloc = mine > 0u ? mine : 1u; nx = cnt > 0u ? cnt : 1u;
}
__device__ __forceinline__ void xcd_barrier(const XcdBarrier& b) {
    asm volatile("s_waitcnt vmcnt(0)" ::: "memory");
    __syncthreads();
    if (threadIdx.x == 0) {
        unsigned* bar = b.bar;
        __builtin_amdgcn_s_waitcnt(0);
        unsigned nloc = b.st[0], nx = b.st[1];
        if (nloc == 0u) { xcd_barrier_complete(bar, b.x, nloc, nx); b.st[0] = nloc; b.st[1] = nx; }
        const unsigned old = xb_add(&bar[XB_XSUB(b.x)], 1u);
        const unsigned gen = old / nloc;
        if (old + 1u == (gen + 1u) * nloc) {
            __builtin_amdgcn_fence(__ATOMIC_RELEASE, "agent");
            asm volatile("s_waitcnt vmcnt(0)" ::: "memory");
            const unsigned og = xb_add(&bar[XB_TOP], 1u);
            const unsigned tg = og / nx;
            if (og + 1u == (tg + 1u) * nx) xb_add(&bar[XB_TOPGEN], 1u);
            else XB_SPIN(xb_ld(&bar[XB_TOPGEN]) == tg, bar);
            __builtin_amdgcn_fence(__ATOMIC_ACQUIRE, "agent");
            xb_add(&bar[XB_XGEN(b.x)], 1u);
            asm volatile("s_waitcnt vmcnt(0)" ::: "memory");
        } else {
            XB_SPIN(xb_ld(&bar[XB_XGEN(b.x)]) == gen, bar);
            __builtin_amdgcn_fence(__ATOMIC_ACQUIRE, "agent");
            asm volatile("s_waitcnt vmcnt(0)" ::: "memory");
        }
    }
    __syncthreads();
}

namespace pg8 {
constexpr int BM = 256, BK = 64, HALF = 128, HTB = HALF * BK * 2, STAGE_BYTES = 8 * HTB, NXCD = 8, WGM = 8, KT = 16;
__device__ __forceinline__ int lds_byte(int r, int c) { const int st = (r >> 4) * 2 + (c >> 5), rr = r & 15, cc = c & 31, ob = rr * 64 + cc * 2; return st * 1024 + (ob ^ (((ob >> 9) & 1) << 5)); }
__device__ __forceinline__ void stage_rc(int b, int& R, int& C) { const int st = b / 1024, sb = b % 1024, swz = sb ^ (((sb >> 9) & 1) << 5); R = (st >> 1) * 16 + swz / 64; C = (st & 1) * 32 + (swz % 64) / 2; }
__device__ __forceinline__ int perm32(int rho) { const int n = rho >> 4, i = rho & 15; return 8 * (i >> 2) + 4 * n + (i & 3); }

struct Unit { const char* A; const char* B0; const char* B1; const int* list; int nvalid, r0, c0, aux; };

__device__ __forceinline__ bool static_tile(int i, int G, int c, int nM, int nN, int& pm, int& pn) {
    const int nwg = nM * nN; const long L = (long)i * G + c; if (L >= nwg) return false;
    int wgid = (int)L; { const int q = nwg / NXCD, r = nwg % NXCD, xcd = wgid % NXCD, off = wgid / NXCD; wgid = (xcd < r ? xcd * (q + 1) : r * (q + 1) + (xcd - r) * q) + off; }
    const int nig = WGM * nN, gid = wgid / nig, fm = gid * WGM, gsz = (nM - fm) < WGM ? (nM - fm) : WGM;
    pm = fm + ((wgid % nig) % gsz); pn = (wgid % nig) / gsz; return true;
}

template <class Epi, class Sched>
__device__ __forceinline__ void gemm_phase(LAS unsigned char* lds, const int lda, const int ldb, const Sched& S, const Epi& E) {
    int tid = threadIdx.x; asm volatile("" : "+v"(tid));
    const int wid = __builtin_amdgcn_readfirstlane(tid >> 6), lane = tid & 63, wr = wid >> 2, wc = wid & 3, fr = lane & 15, fq = lane >> 4;
    unsigned voffA[2], voffB[2];
#pragma unroll
    for (int i = 0; i < 2; ++i) { int R, C; stage_rc(tid * 16 + i * 8192, R, C); const int Rb = Epi::PERM ? ((R & ~31) + perm32(R & 31)) : R;
        voffA[i] = (unsigned)(R * lda + C) * 2u; voffB[i] = (unsigned)(Rb * ldb + C) * 2u; }
    const size_t kstep = (size_t)(BK * 2);
    const size_t hstepA = (size_t)HALF * lda * 2, hstepB = (size_t)HALF * ldb * 2;
    const unsigned ldsw = (unsigned)wid * 1024u;
    const int aoff = lds_byte(wr * 64 + fr, fq * 8), boff = lds_byte(wc * 32 + fr, fq * 8);
#define PG8_SA(b, h) (((b) * 2 + (h)) * HTB)
#define PG8_SB(b, h) ((4 + (b) * 2 + (h)) * HTB)
#define PG8_STAGE(bufoff, gbase, voff) do { _Pragma("unroll") for (int _i = 0; _i < 2; ++_i) \
        __builtin_amdgcn_global_load_lds((const unsigned*)((const char*)(gbase) + (voff)[_i]), (LAS unsigned*)(lds + (bufoff) + ldsw + _i * 8192), 16, 0, 0); } while (0)
#define PG8_LDA(dst, b, h) do { _Pragma("unroll") for (int m = 0; m < 4; ++m) _Pragma("unroll") for (int k = 0; k < 2; ++k) dst[m][k] = *(const LAS bf16x8*)(lds + PG8_SA(b, h) + aoff + m * 2048 + k * 1024); } while (0)
#define PG8_LDB(dst, b, h) do { _Pragma("unroll") for (int n = 0; n < 2; ++n) _Pragma("unroll") for (int k = 0; k < 2; ++k) dst[n][k] = *(const LAS bf16x8*)(lds + PG8_SB(b, h) + boff + n * 2048 + k * 1024); } while (0)
#define PG8_MMA(ai, bj, At, Bt) do { __builtin_amdgcn_s_setprio(1); _Pragma("unroll") for (int m = 0; m < 4; ++m) _Pragma("unroll") for (int n = 0; n < 2; ++n) _Pragma("unroll") for (int k = 0; k < 2; ++k) \
        acc[ai][bj][m][n] = __builtin_amdgcn_mfma_f32_16x16x32_bf16(Bt[n][k], At[m][k], acc[ai][bj][m][n], 0, 0, 0); __builtin_amdgcn_s_setprio(0); } while (0)
#define PG8_WAIT_V(n) asm volatile("s_waitcnt vmcnt(" #n ")" ::: "memory")
#define PG8_WAIT_L(n) asm volatile("s_waitcnt lgkmcnt(" #n ")" ::: "memory")
#define PG8_BAR __builtin_amdgcn_s_barrier()
#define PG8_SCHED __builtin_amdgcn_sched_barrier(0)
    Unit cur, nxt; int ui = 0;
    if (!S.next(0, cur)) return;
    f32x4 acc[2][2][4][2];
#pragma unroll
    for (int a = 0; a < 2; ++a)
#pragma unroll
        for (int b = 0; b < 2; ++b)
#pragma unroll
            for (int m = 0; m < 4; ++m)
#pragma unroll
                for (int n = 0; n < 2; ++n) acc[a][b][m][n] = (f32x4){0.f, 0.f, 0.f, 0.f};
    bf16x8 At[4][2], B0[2][2], B1[2][2];
    const char* cA = cur.A; const char* cB0 = cur.B0; const char* cB1 = cur.B1;
    PG8_STAGE(PG8_SB(0, 0), cB0, voffB); PG8_STAGE(PG8_SA(0, 0), cA, voffA); PG8_STAGE(PG8_SB(0, 1), cB0 + hstepB, voffB); PG8_STAGE(PG8_SA(0, 1), cA + hstepA, voffA);
    if (wr == 1) PG8_BAR;
    PG8_WAIT_V(4); PG8_BAR;
    PG8_STAGE(PG8_SB(1, 0), cB0 + kstep, voffB); PG8_STAGE(PG8_SA(1, 0), cA + kstep, voffA); PG8_STAGE(PG8_SB(1, 1), cB0 + hstepB + kstep, voffB);
    PG8_WAIT_V(6); PG8_BAR;
    for (;;) {
        const bool has_next = S.next(ui + 1, nxt);
        const char* nA = has_next ? nxt.A : cA; const char* nB = has_next ? nxt.B0 : cB0;
        for (int t = 0; t < KT; t += 2) {
            const bool last = (t == KT - 2);
            const char* a1 = cA + (size_t)(t + 1) * kstep;
            const char* a2 = last ? nA : cA + (size_t)(t + 2) * kstep;
            const char* b2 = last ? nB : ((t + 2 < 8) ? cB0 : cB1) + (size_t)(t + 2) * kstep;
            const char* a3 = a2 + kstep; const char* b3 = b2 + kstep;
            PG8_LDB(B0, 0, 0); PG8_SCHED; PG8_LDA(At, 0, 0); PG8_STAGE(PG8_SA(1, 1), a1 + hstepA, voffA);
            PG8_WAIT_L(8); PG8_BAR; PG8_WAIT_L(0); PG8_MMA(0, 0, At, B0); PG8_BAR; PG8_SCHED;
            PG8_LDB(B1, 0, 1); PG8_STAGE(PG8_SB(0, 0), b2, voffB);
            PG8_BAR; PG8_WAIT_L(0); PG8_MMA(0, 1, At, B1); PG8_BAR;
            PG8_LDA(At, 0, 1); PG8_STAGE(PG8_SA(0, 0), a2, voffA);
            PG8_BAR; PG8_WAIT_L(0); PG8_MMA(1, 0, At, B0); PG8_BAR; PG8_SCHED;
            PG8_STAGE(PG8_SB(0, 1), b2 + hstepB, voffB);
            PG8_WAIT_V(6); PG8_BAR; PG8_MMA(1, 1, At, B1); PG8_BAR;
            PG8_LDB(B0, 1, 0); PG8_SCHED; PG8_LDA(At, 1, 0); PG8_STAGE(PG8_SA(0, 1), a2 + hstepA, voffA);
            PG8_WAIT_L(8); PG8_BAR; PG8_WAIT_L(0); PG8_MMA(0, 0, At, B0); PG8_BAR; PG8_SCHED;
            PG8_LDB(B1, 1, 1); PG8_STAGE(PG8_SB(1, 0), b3, voffB);
            PG8_BAR; PG8_WAIT_L(0); PG8_MMA(0, 1, At, B1); PG8_BAR;
            PG8_LDA(At, 1, 1); PG8_STAGE(PG8_SA(1, 0), a3, voffA);
            PG8_BAR; PG8_WAIT_L(0); PG8_MMA(1, 0, At, B0); PG8_BAR; PG8_SCHED;
            PG8_STAGE(PG8_SB(1, 1), b3 + hstepB, voffB);
            PG8_WAIT_V(6); PG8_BAR; PG8_MMA(1, 1, At, B1); PG8_BAR;
        }
        E(acc, cur, wr, wc, fr, fq);
        if (!has_next) break;
#pragma unroll
        for (int a = 0; a < 2; ++a)
#pragma unroll
            for (int b = 0; b < 2; ++b)
#pragma unroll
                for (int m = 0; m < 4; ++m)
#pragma unroll
                    for (int n = 0; n < 2; ++n) acc[a][b][m][n] = (f32x4){0.f, 0.f, 0.f, 0.f};
        cur = nxt; cA = nA; cB0 = cur.B0; cB1 = cur.B1; ++ui;
    }
    PG8_WAIT_V(0);
    if (wr == 0) PG8_BAR;
    PG8_BAR;
#undef PG8_SA
#undef PG8_SB
#undef PG8_STAGE
#undef PG8_LDA
#undef PG8_LDB
#undef PG8_MMA
#undef PG8_WAIT_V
#undef PG8_WAIT_L
#undef PG8_BAR
#undef PG8_SCHED
}


struct EpiBf16Store {
    static constexpr bool PERM = true;
    bf16_t* O; int ldc;
    __device__ __forceinline__ void operator()(const f32x4 (&acc)[2][2][4][2], const Unit& u, int wr, int wc, int fr, int fq) const {
        const int row0 = u.r0 + wr * 64 + fr, col0 = u.c0 + wc * 32 + 8 * fq;
#pragma unroll
        for (int ai = 0; ai < 2; ++ai)
#pragma unroll
            for (int m = 0; m < 4; ++m) { bf16_t* rowp = O + (size_t)(row0 + ai * HALF + m * 16) * ldc + col0;
#pragma unroll
                for (int bj = 0; bj < 2; ++bj) { const f32x4 v0 = acc[ai][bj][m][0], v1 = acc[ai][bj][m][1];
                    u32x4 w; w.x = pk2(v0[0], v0[1]); w.y = pk2(v0[2], v0[3]); w.z = pk2(v1[0], v1[1]); w.w = pk2(v1[2], v1[3]);
                    *(u32x4*)(rowp + bj * HALF) = w; } }
    }
};
struct EpiResid {
    static constexpr bool PERM = false;
    const float* xin; float* xout; const float* gate;
    __device__ __forceinline__ void operator()(const f32x4 (&acc)[2][2][4][2], const Unit& u, int wr, int wc, int fr, int fq) const {
        const int row0 = u.r0 + wr * 64 + fr, col0 = u.c0 + wc * 32 + 4 * fq;
        const float* gp = gate + (size_t)(u.r0 >> 12) * 6144 + col0;
        f32x4 gv[2][2];
#pragma unroll
        for (int bj = 0; bj < 2; ++bj)
#pragma unroll
            for (int n = 0; n < 2; ++n) gv[bj][n] = *(const f32x4*)(gp + bj * HALF + n * 16);
#pragma unroll
        for (int ai = 0; ai < 2; ++ai)
#pragma unroll
            for (int m = 0; m < 4; ++m) { const size_t ro = (size_t)(row0 + ai * HALF + m * 16) * D + col0;
#pragma unroll
                for (int bj = 0; bj < 2; ++bj)
#pragma unroll
                    for (int n = 0; n < 2; ++n) { const f32x4 xi = *(const f32x4*)(xin + ro + bj * HALF + n * 16);
                        *(f32x4*)(xout + ro + bj * HALF + n * 16) = xi + gv[bj][n] * acc[ai][bj][m][n]; } }
    }
};
struct EpiHid {
    static constexpr bool PERM = true;
    bf16_t* H; const float* rw;
    __device__ __forceinline__ void operator()(const f32x4 (&acc)[2][2][4][2], const Unit& u, int wr, int wc, int fr, int fq) const {
        const int rl0 = wr * 64 + fr, col0 = u.c0 + wc * 32 + 8 * fq;
#pragma unroll
        for (int ai = 0; ai < 2; ++ai)
#pragma unroll
            for (int m = 0; m < 4; ++m) { const int rl = rl0 + ai * HALF + m * 16;
                float w = 0.f; if (rl < u.nvalid) w = rw[(size_t)(u.r0 + rl) * 2 + u.aux];
                const f32x4 g0 = acc[ai][0][m][0], g1 = acc[ai][0][m][1], u0 = acc[ai][1][m][0], u1 = acc[ai][1][m][1];
                float h[8];
#pragma unroll
                for (int j = 0; j < 4; ++j) { h[j] = silu_f(g0[j]) * u0[j] * w; h[4 + j] = silu_f(g1[j]) * u1[j] * w; }
                u32x4 o; o.x = pk2(h[0], h[1]); o.y = pk2(h[2], h[3]); o.z = pk2(h[4], h[5]); o.w = pk2(h[6], h[7]);
                *(u32x4*)(H + (size_t)(u.r0 + rl) * D + col0) = o; }
    }
};
struct EpiMoeOut {
    static constexpr bool PERM = false;
    float* x; const float* gate;
    __device__ __forceinline__ void operator()(const f32x4 (&acc)[2][2][4][2], const Unit& u, int wr, int wc, int fr, int fq) const {
        const int rl0 = wr * 64 + fr, col0 = u.c0 + wc * 32 + 4 * fq;
#pragma unroll
        for (int ai = 0; ai < 2; ++ai)
#pragma unroll
            for (int m = 0; m < 4; ++m) { const int rl = rl0 + ai * HALF + m * 16;
                if (rl < u.nvalid) { const int tok = u.list[rl]; const float* gp = gate + (size_t)(tok >> 12) * 6144 + col0; float* xp = x + (size_t)tok * D + col0;
#pragma unroll
                    for (int bj = 0; bj < 2; ++bj)
#pragma unroll
                        for (int n = 0; n < 2; ++n) { const f32x4 gv = *(const f32x4*)(gp + bj * HALF + n * 16); const f32x4 xi = *(const f32x4*)(xp + bj * HALF + n * 16);
                            *(f32x4*)(xp + bj * HALF + n * 16) = xi + gv * acc[ai][bj][m][n]; } } }
    }
};

struct DenseSched {
    const char* A; const char* Bt; int nM, nN, G, c, lda, ldb;
    __device__ __forceinline__ bool next(int i, Unit& u) const {
        int pm, pn; if (!static_tile(i, G, c, nM, nN, pm, pn)) return false;
        u.A = A + (size_t)pm * BM * lda * 2; u.B0 = Bt + (size_t)pn * BM * ldb * 2; u.B1 = u.B0; u.list = nullptr; u.nvalid = 256; u.r0 = pm * BM; u.c0 = pn * BM; u.aux = 0; return true;
    }
};
__device__ __forceinline__ void cls_experts(int cls, int& e_lo, int& e_hi) {
    const int g = cls / 6, p = cls % 6; const int lo = (p < 3) ? 0 : (p < 5 ? 1 : 2); const int hi = (p < 3) ? p + 1 : (p < 5 ? p - 1 : 3);
    e_lo = g * 4 + lo; e_hi = g * 4 + hi;
}
struct MoeSched1 {
    const char* A; const char* Wgu; const LAS int* tbl; int G, c;
    __device__ __forceinline__ bool next(int i, Unit& u) const {
        const int MT = tbl[24]; int mt, pn; if (!static_tile(i, G, c, MT, 8, mt, pn)) return false;
        int cls = 0;
#pragma unroll 1
        for (int k = 1; k < NCLS; ++k) if (tbl[k] <= mt) cls = k;
        const int ml = mt - tbl[cls]; int e_lo, e_hi; cls_experts(cls, e_lo, e_hi);
        const int e = (pn < 4) ? e_lo : e_hi;
        u.A = A + (size_t)mt * 256 * 1024 * 2; u.B0 = Wgu + ((size_t)e * 1024 + (size_t)(pn & 3) * 256) * 1024 * 2; u.B1 = u.B0; u.list = nullptr;
        const int rem = tbl[32 + cls] - ml * 256; u.nvalid = rem < 256 ? rem : 256; u.r0 = mt * 256; u.c0 = (pn >> 2) * 512 + (pn & 3) * 128; u.aux = pn >> 2; return true;
    }
};
struct MoeSched2 {
    const char* H; const char* Wdt; const int* slot_tok; const LAS int* tbl; int G, c;
    __device__ __forceinline__ bool next(int i, Unit& u) const {
        const int MT = tbl[24]; int mt, pn; if (!static_tile(i, G, c, MT, 4, mt, pn)) return false;
        int cls = 0;
#pragma unroll 1
        for (int k = 1; k < NCLS; ++k) if (tbl[k] <= mt) cls = k;
        const int ml = mt - tbl[cls]; int e_lo, e_hi; cls_experts(cls, e_lo, e_hi);
        u.A = H + (size_t)mt * 256 * 1024 * 2;
        const char* brow = Wdt + (size_t)pn * 256 * 8192 * 2;
        u.B0 = brow + (size_t)e_lo * 512 * 2; u.B1 = brow + (size_t)e_hi * 512 * 2 - 8 * 128; u.list = slot_tok + (size_t)mt * 256;
        const int rem = tbl[32 + cls] - ml * 256; u.nvalid = rem < 256 ? rem : 256; u.r0 = mt * 256; u.c0 = pn * 256; u.aux = 0; return true;
    }
};
}

struct Args { const float* in[27]; float* out; unsigned char* ws; int ph_lo, ph_hi; };

__device__ const unsigned char BUCKET[3][132] = {
 {0,1,2,3,4,5,6,7,8,9,10,11,12,13,14,15,16,16,16,16,16,16,17,17,17,17,17,17,17,17,18,18,18,18,18,18,18,18,18,18,19,19,19,19,19,19,19,19,19,19,19,19,19,19,20,20,20,20,20,20,20,20,20,20,20,20,20,20,20,20,20,20,20,21,21,21,21,21,21,21,21,21,21,21,21,21,21,21,21,21,21,21,21,21,21,21,21,21,21,22,22,22,22,22,22,22,22,22,22,22,22,22,22,22,22,22,22,22,22,22,22,22,22,22,22,22,22,22,22,0,0,0},
 {0,4,8,12,16,16,17,17,18,18,19,19,19,19,20,20,20,20,20,21,21,21,21,21,21,22,22,22,22,22,22,22,22,22,23,23,23,23,23,23,23,23,23,23,23,23,24,24,24,24,24,24,24,24,24,24,24,24,24,24,24,24,25,25,25,25,25,25,25,25,25,25,25,25,25,25,25,25,25,25,25,25,25,26,26,26,26,26,26,26,26,26,26,26,26,26,26,26,26,26,26,26,26,26,26,26,26,26,26,26,26,26,26,27,27,27,27,27,27,27,27,27,27,27,27,27,27,27,27,0,0,0},
 {0,16,18,19,20,21,21,22,22,23,23,23,24,24,24,24,25,25,25,25,25,26,26,26,26,26,26,26,26,27,27,27,27,27,27,27,27,27,27,28,28,28,28,28,28,28,28,28,28,28,28,28,29,29,29,29,29,29,29,29,29,29,29,29,29,29,29,29,29,29,30,30,30,30,30,30,30,30,30,30,30,30,30,30,30,30,30,30,30,30,30,30,30,30,30,31,31,31,31,31,31,31,31,31,31,31,31,31,31,31,31,31,31,31,31,31,31,31,31,31,31,31,31,31,31,31,31,31,31,0,0,0}};

struct Frame {
    LAS unsigned char* lds;
    int tid, lane, wave, vcu, G;
    unsigned char* ws;
};

__device__ __forceinline__ void frame_refresh(Frame& F) {
    int tid = threadIdx.x; asm volatile("" : "+v"(tid));
    F.tid = tid; F.lane = tid & 63; F.wave = __builtin_amdgcn_readfirstlane(tid >> 6);
}
__device__ __forceinline__ void transpose_item(const float* W, int srcN, int k0, int n0, bf16_t* dst, size_t dstride, LAS float* scr, int lane) {
#pragma unroll 8
    for (int i = 0; i < 32; ++i) { const int kk = 2 * i + (lane >> 5); scr[kk * 33 + (lane & 31)] = W[(size_t)(k0 + kk) * srcN + n0 + (lane & 31)]; }
    LDS_WAIT(); asm volatile("" ::: "memory");
    const int c = lane & 7;
#pragma unroll
    for (int j = 0; j < 4; ++j) { const int n = (lane >> 3) + 8 * j; const LAS float* s = scr + (8 * c) * 33 + n;
        u32x4 o; o.x = pk2(s[0 * 33], s[1 * 33]); o.y = pk2(s[2 * 33], s[3 * 33]); o.z = pk2(s[4 * 33], s[5 * 33]); o.w = pk2(s[6 * 33], s[7 * 33]);
        *(u32x4*)(dst + (size_t)n * dstride + 8 * c) = o; }
    LDS_WAIT(); asm volatile("" ::: "memory");
}

__device__ __forceinline__ void phase_prologue(Frame& F, const Args& a) {
    frame_refresh(F);
    LAS float* scr = (LAS float*)(F.lds + F.wave * 16384);
    const int gw = F.vcu * NWAVES + F.wave, NGW = F.G * NWAVES;
    bf16_t* WIN = (bf16_t*)(F.ws + WS_WIN); bf16_t* WOUT = (bf16_t*)(F.ws + WS_WOUT); bf16_t* WGU = (bf16_t*)(F.ws + WS_WGU); bf16_t* WDT = (bf16_t*)(F.ws + WS_WDT);
    constexpr int I_IN = 4 * 16 * 80, I_OUT = 4 * 16 * 32, I_G = 64 * 16 * 16, I_D = 64 * 8 * 32;
    constexpr int NITEMS = I_IN + I_OUT + 2 * I_G + I_D;
    for (int it = gw; it < NITEMS; it += NGW) {
        int r = it;
        if (r < I_IN) { const int l = r / 1280, q = r % 1280, kb = q / 80, nb = q % 80;
            const float* W = ((l & 1) ? a.in[13] : a.in[7]) + (size_t)(l >> 1) * 1024 * NPROJ;
            transpose_item(W, NPROJ, 64 * kb, 32 * nb, WIN + ((size_t)l * NPROJ + 32 * nb) * 1024 + 64 * kb, 1024, scr, F.lane); continue; }
        r -= I_IN;
        if (r < I_OUT) { const int l = r / 512, q = r % 512, kb = q / 32, nb = q % 32;
            const float* W = ((l & 1) ? a.in[14] : a.in[8]) + (size_t)(l >> 1) * 1024 * 1024;
            transpose_item(W, 1024, 64 * kb, 32 * nb, WOUT + ((size_t)l * 1024 + 32 * nb) * 1024 + 64 * kb, 1024, scr, F.lane); continue; }
        r -= I_OUT;
        if (r < 2 * I_G) { const int up = r / I_G, q0 = r % I_G, le = q0 / 256, q = q0 % 256, kb = q / 16, nb = q % 16;
            const float* W = (up ? a.in[24] : a.in[23]) + (size_t)le * 1024 * 512;
            const int n0 = 32 * nb, drow = 256 * (n0 >> 7) + 128 * up + (n0 & 127);
            transpose_item(W, 512, 64 * kb, n0, WGU + ((size_t)le * 1024 + drow) * 1024 + 64 * kb, 1024, scr, F.lane); continue; }
        r -= 2 * I_G;
        { const int le = r / 256, q = r % 256, kb = q / 32, nb = q % 32, l = le >> 4, e = le & 15;
            const float* W = a.in[25] + (size_t)le * 512 * 1024;
            transpose_item(W, 1024, 64 * kb, 32 * nb, WDT + ((size_t)l * 1024 + 32 * nb) * 8192 + e * 512 + 64 * kb, 8192, scr, F.lane); }
    }
    { bf16_t* WS = (bf16_t*)(F.ws + WS_WS); const float* src = a.in[11];
      for (int i = (F.vcu * NTHREADS + F.tid); i < 2 * 4 * 128 * 128; i += F.G * NTHREADS) { const int t = (i >> 7) & 127, s = i & 127; const float v = (s <= t) ? src[i] : 0.f; WS[i] = (bf16_t)(pk2(v, 0.f) & 0xffffu); } }
    __syncthreads();
    { LAS float* sc = (LAS float*)F.lds;
      LAS float* red = (LAS float*)(F.lds + 65536);
      const float* c = a.in[1];
      for (int i = F.tid; i < 16 * 1024; i += NTHREADS) sc[i] = silu_f(c[i]);
      __syncthreads();
      float* MOD = (float*)(F.ws + WS_MOD);
      for (int grp = F.vcu; grp < 4 * 96; grp += F.G) {
          const int l = grp / 96, n = (grp % 96) * 64 + F.lane;
          const float* w = a.in[5] + ((size_t)l * 1024 + F.wave * 128) * 6144 + n;
          float acc[16];
#pragma unroll
          for (int b = 0; b < 16; ++b) acc[b] = 0.f;
#pragma unroll 4
          for (int k = 0; k < 128; ++k) { const float wv = w[(size_t)k * 6144];
#pragma unroll
              for (int b = 0; b < 16; ++b) acc[b] += sc[b * 1024 + F.wave * 128 + k] * wv; }
#pragma unroll
          for (int b = 0; b < 16; ++b) red[(F.wave * 16 + b) * 64 + F.lane] = acc[b];
          __syncthreads();
#pragma unroll
          for (int bb = 0; bb < 2; ++bb) { const int b = F.wave * 2 + bb; float s = a.in[6][(size_t)l * 6144 + n];
#pragma unroll
              for (int w8 = 0; w8 < 8; ++w8) s += red[(w8 * 16 + b) * 64 + F.lane];
              MOD[((size_t)l * 16 + b) * 6144 + n] = s; }
          __syncthreads();
      }
    }
}

__device__ __forceinline__ void norm_mod_row(const float* xrow, const float* gam, const float* sh, const float* sc, int lane, f32x4 (&h)[4]) {
    const f32x4* xr = (const f32x4*)xrow + lane;
    f32x4 v[4]; float ss = 0.f;
#pragma unroll
    for (int j = 0; j < 4; ++j) { v[j] = xr[64 * j]; ss += (v[j].x * v[j].x + v[j].y * v[j].y) + (v[j].z * v[j].z + v[j].w * v[j].w); }
    const float rstd = rsqrtf(wave_sum(ss) * (1.f / D) + EPS);
#pragma unroll
    for (int j = 0; j < 4; ++j) { const f32x4 g = ((const f32x4*)gam)[lane + 64 * j], s1 = ((const f32x4*)sc)[lane + 64 * j], s0 = ((const f32x4*)sh)[lane + 64 * j];
        h[j] = v[j] * rstd * g * (1.f + s1) + s0; }
}
__device__ __forceinline__ void store_row_bf16(bf16_t* orow, int lane, const f32x4 (&h)[4]) {
    u32x2* o = (u32x2*)orow + lane;
#pragma unroll
    for (int j = 0; j < 4; ++j) { u32x2 w; w.x = pk2(h[j].x, h[j].y); w.y = pk2(h[j].z, h[j].w); o[64 * j] = w; }
}

__device__ __forceinline__ void phase_norm1(Frame& F, const Args& a, int l, const float* xin) {
    frame_refresh(F);
    const int gw = F.vcu * NWAVES + F.wave, NGW = F.G * NWAVES;
    const float* MOD = (const float*)(F.ws + WS_MOD) + (size_t)l * 16 * 6144;
    bf16_t* HB = (bf16_t*)(F.ws + WS_HBUF);
    const float* gam = a.in[3] + (size_t)l * D;
    for (int row = gw; row < T; row += NGW) {
        const int b = row >> 12; f32x4 h[4];
        norm_mod_row(xin + (size_t)row * D, gam, MOD + (size_t)b * 6144, MOD + (size_t)b * 6144 + 1024, F.lane, h);
        store_row_bf16(HB + (size_t)row * D, F.lane, h);
    }
}

__device__ __forceinline__ void phase_dilated_naive(Frame& F, const Args& a) {
    frame_refresh(F);
    const int gw = F.vcu * NWAVES + F.wave, NGW = F.G * NWAVES, lane = F.lane;
    const bf16_t* P = (const bf16_t*)(F.ws + WS_PROJ); bf16_t* MIX = (bf16_t*)(F.ws + WS_MIX);
    const float* relb = a.in[2];
    for (int task = gw; task < T * 8; task += NGW) {
        const int row = task >> 3, hd = task & 7, t = row & (SEQ - 1);
        float q[64];
        { const u32x4* qp = (const u32x4*)(P + (size_t)row * NPROJ + hd * 64);
#pragma unroll
          for (int i = 0; i < 8; ++i) { const u32x4 w = qp[i]; q[8*i+0] = bf_lo(w.x) * 0.125f; q[8*i+1] = bf_hi(w.x) * 0.125f; q[8*i+2] = bf_lo(w.y) * 0.125f; q[8*i+3] = bf_hi(w.y) * 0.125f;
              q[8*i+4] = bf_lo(w.z) * 0.125f; q[8*i+5] = bf_hi(w.z) * 0.125f; q[8*i+6] = bf_lo(w.w) * 0.125f; q[8*i+7] = bf_hi(w.w) * 0.125f; } }
        float sc[3][3]; float mx = -1e30f;
#pragma unroll
        for (int br = 0; br < 3; ++br) { const int d = (br == 0) ? 1 : (br == 1 ? 4 : 16);
#pragma unroll
            for (int rnd = 0; rnd < 3; ++rnd) { const int j = lane + 64 * rnd; const bool valid = (j <= 128) && (t - j * d >= 0);
                float s = -1e30f;
                if (valid) { const u32x4* kp = (const u32x4*)(P + (size_t)(row - j * d) * NPROJ + 512 + hd * 64); float dot = 0.f;
#pragma unroll
                    for (int i = 0; i < 8; ++i) { const u32x4 w = kp[i]; dot += q[8*i+0] * bf_lo(w.x) + q[8*i+1] * bf_hi(w.x) + q[8*i+2] * bf_lo(w.y) + q[8*i+3] * bf_hi(w.y)
                            + q[8*i+4] * bf_lo(w.z) + q[8*i+5] * bf_hi(w.z) + q[8*i+6] * bf_lo(w.w) + q[8*i+7] * bf_hi(w.w); }
                    s = dot + relb[(int)BUCKET[br][j] * 8 + hd]; }
                sc[br][rnd] = s; mx = fmaxf(mx, s); } }
        mx = wave_max(mx);
        float lsum = 0.f;
#pragma unroll
        for (int br = 0; br < 3; ++br)
#pragma unroll
            for (int rnd = 0; rnd < 3; ++rnd) { const float p = (sc[br][rnd] > -1e29f) ? __expf(sc[br][rnd] - mx) : 0.f; sc[br][rnd] = p; lsum += p; }
        lsum = wave_sum(lsum);
        float acc = 0.f;
#pragma unroll
        for (int br = 0; br < 3; ++br) { const int d = (br == 0) ? 1 : (br == 1 ? 4 : 16);
#pragma unroll
            for (int rnd = 0; rnd < 3; ++rnd) { const int nj = (rnd == 2) ? 1 : 64;
                for (int jj = 0; jj < nj; ++jj) { const int j = jj + 64 * rnd; const float p = __shfl(sc[br][rnd], jj);
                    if (t - j * d >= 0) acc += p * bf1(P[(size_t)(row - j * d) * NPROJ + 1024 + hd * 64 + lane]); } } }
        const float o = acc / lsum;
        MIX[(size_t)row * D + hd * 64 + lane] = (bf16_t)(pk2(o, 0.f) & 0xffffu);
    }
}

__device__ __forceinline__ void phase_gmlp(Frame& F, const Args& a, int j2) {
    frame_refresh(F);
    const bf16_t* P = (const bf16_t*)(F.ws + WS_PROJ); bf16_t* MIX = (bf16_t*)(F.ws + WS_MIX);
    const bf16_t* WSM = (const bf16_t*)(F.ws + WS_WS) + (size_t)j2 * 4 * 128 * 128;
    const float* lng = a.in[9] + (size_t)j2 * 512; const float* lnb = a.in[10] + (size_t)j2 * 512; const float* bs = a.in[12] + (size_t)j2 * 4 * 128;
    constexpr int VP = 136;
    LAS bf16_t* vT = (LAS bf16_t*)F.lds;
    const int lane = F.lane, wave = F.wave;
    for (int ch = F.vcu; ch < T / 128; ch += F.G) {
        const int row0 = ch * 128;
        float lg[8], lb[8];
#pragma unroll
        for (int i = 0; i < 8; ++i) { lg[i] = lng[8 * lane + i]; lb[i] = lnb[8 * lane + i]; }
        for (int tt = 0; tt < 16; ++tt) { const int tl = wave * 16 + tt;
            const u32x4 w = *(const u32x4*)(P + (size_t)(row0 + tl) * NPROJ + 2048 + 8 * lane);
            float g[8]; g[0] = gelu_tanh(bf_lo(w.x)); g[1] = gelu_tanh(bf_hi(w.x)); g[2] = gelu_tanh(bf_lo(w.y)); g[3] = gelu_tanh(bf_hi(w.y));
            g[4] = gelu_tanh(bf_lo(w.z)); g[5] = gelu_tanh(bf_hi(w.z)); g[6] = gelu_tanh(bf_lo(w.w)); g[7] = gelu_tanh(bf_hi(w.w));
            float s = 0.f;
#pragma unroll
            for (int i = 0; i < 8; ++i) s += g[i];
            const float mu = wave_sum(s) * (1.f / 512.f); float s2 = 0.f;
#pragma unroll
            for (int i = 0; i < 8; ++i) { g[i] -= mu; s2 += g[i] * g[i]; }
            const float rstd = rsqrtf(wave_sum(s2) * (1.f / 512.f) + EPS);
#pragma unroll
            for (int i = 0; i < 8; ++i) { const float v = g[i] * rstd * lg[i] + lb[i]; vT[(8 * lane + i) * VP + tl] = (bf16_t)(pk2(v, 0.f) & 0xffffu); }
        }
        __syncthreads();
        const int g = wave >> 1, r32 = lane & 31, hh = lane >> 5;
        for (int ti = 0; ti < 2; ++ti) { const int tm = (wave & 1) + 2 * ti;
            f32x16 accv[4];
#pragma unroll
            for (int c4 = 0; c4 < 4; ++c4)
#pragma unroll
                for (int i = 0; i < 16; ++i) accv[c4][i] = 0.f;
            const int nks = 2 * (tm + 1);
            for (int ks = 0; ks < nks; ++ks) {
                const bf16x8 af = *(const bf16x8*)(WSM + ((size_t)g * 128 + tm * 32 + r32) * 128 + ks * 16 + 8 * hh);
#pragma unroll
                for (int c4 = 0; c4 < 4; ++c4) { const bf16x8 bfv = *(const LAS bf16x8*)(vT + (g * 128 + c4 * 32 + r32) * VP + ks * 16 + 8 * hh);
                    accv[c4] = __builtin_amdgcn_mfma_f32_32x32x16_bf16(af, bfv, accv[c4], 0, 0, 0); }
            }
#pragma unroll
            for (int i = 0; i < 16; ++i) { const int tl = tm * 32 + (i & 3) + 8 * (i >> 2) + 4 * hh; const float bsv = bs[g * 128 + tl];
#pragma unroll
                for (int c4 = 0; c4 < 4; ++c4) { const int chn = g * 128 + c4 * 32 + r32;
                    const float u = gelu_tanh(bf1(P[(size_t)(row0 + tl) * NPROJ + 1536 + chn]));
                    const float o = u * (accv[c4][i] + bsv);
                    MIX[(size_t)(row0 + tl) * D + 512 + chn] = (bf16_t)(pk2(o, 0.f) & 0xffffu); } }
        }
        __syncthreads();
    }
}

template <bool OUT>
__device__ __forceinline__ void conv_chunk(const bf16_t* P, int row0, int tseq0, int tl0, int c0, float (&x0)[32], float (&x1)[32], const float (&w0)[31], const float (&w1)[31], float bd0, float bd1, LAS float* tile) {
#pragma unroll
    for (int i = 0; i < 32; ++i) { const int tl = tl0 + i;
        float h0 = 0.f, h1 = 0.f;
        if (tseq0 + tl >= 0) { const bf16_t* pr = P + (size_t)(row0 + tl) * NPROJ; const unsigned av = *(const unsigned*)(pr + c0), gv = *(const unsigned*)(pr + 512 + c0);
            h0 = bf_lo(av) * sigmoid_f(bf_lo(gv)); h1 = bf_hi(av) * sigmoid_f(bf_hi(gv)); }
        x0[i] = h0; x1[i] = h1;
        if (OUT) { float o0 = bd0, o1 = bd1;
#pragma unroll
            for (int j = 0; j < 31; ++j) { o0 += w0[j] * x0[(i + 2 + j) & 31]; o1 += w1[j] * x1[(i + 2 + j) & 31]; }
            *(LAS f32x2*)(tile + i * 512 + c0) = (f32x2){o0, o1}; }
    }
}
__device__ __forceinline__ void phase_conv(Frame& F, const Args& a, int j2) {
    frame_refresh(F);
    const bf16_t* P = (const bf16_t*)(F.ws + WS_PROJ); bf16_t* MIX = (bf16_t*)(F.ws + WS_MIX);
    const float* wdw = a.in[15] + (size_t)j2 * 31 * 512; const float* bdw = a.in[16] + (size_t)j2 * 512;
    const float* lng = a.in[17] + (size_t)j2 * 512; const float* lnb = a.in[18] + (size_t)j2 * 512;
    const int half = F.tid >> 8, ht = F.tid & 255, c0 = 2 * ht;
    LAS float* tile = (LAS float*)F.lds + half * (32 * 512);
    float w0[31], w1[31];
#pragma unroll
    for (int j = 0; j < 31; ++j) { w0[j] = wdw[j * 512 + c0]; w1[j] = wdw[j * 512 + c0 + 1]; }
    const float bd0 = bdw[c0], bd1 = bdw[c0 + 1];
    const int wih = F.wave & 3;
    for (int s0 = F.vcu * 2; s0 < T / 128; s0 += F.G * 2) {
        const int seg = s0 + half;
        const int row0 = seg * 128, tseq0 = row0 & (SEQ - 1);
        float x0[32], x1[32];
        conv_chunk<false>(P, row0, tseq0, -32, c0, x0, x1, w0, w1, bd0, bd1, tile);
#pragma unroll 1
        for (int cb = 0; cb < 4; ++cb) {
            conv_chunk<true>(P, row0, tseq0, cb * 32, c0, x0, x1, w0, w1, bd0, bd1, tile);
            __syncthreads();
            for (int rr = wih; rr < 32; rr += 4) { const LAS float* tr = tile + rr * 512 + 8 * F.lane; float v[8]; float s = 0.f;
#pragma unroll
                for (int e = 0; e < 8; ++e) { v[e] = tr[e]; s += v[e]; }
                const float mu = wave_sum(s) * (1.f / 512.f); float s2 = 0.f;
#pragma unroll
                for (int e = 0; e < 8; ++e) { v[e] -= mu; s2 += v[e] * v[e]; }
                const float rstd = rsqrtf(wave_sum(s2) * (1.f / 512.f) + EPS);
                float o[8];
#pragma unroll
                for (int e = 0; e < 8; ++e) o[e] = silu_f(v[e] * rstd * lng[8 * F.lane + e] + lnb[8 * F.lane + e]);
                u32x4 ow; ow.x = pk2(o[0], o[1]); ow.y = pk2(o[2], o[3]); ow.z = pk2(o[4], o[5]); ow.w = pk2(o[6], o[7]);
                *(u32x4*)(MIX + (size_t)(row0 + cb * 32 + rr) * D + 8 * F.lane) = ow; }
            __syncthreads();
        }
    }
}

__device__ __forceinline__ void phase_stick_naive(Frame& F) {
    frame_refresh(F);
    const int gw = F.vcu * NWAVES + F.wave, NGW = F.G * NWAVES, lane = F.lane;
    const bf16_t* P = (const bf16_t*)(F.ws + WS_PROJ); bf16_t* MIX = (bf16_t*)(F.ws + WS_MIX);
    for (int task = gw; task < T * 8; task += NGW) {
        const int row = task >> 3, hd = task & 7, t = row & (SEQ - 1);
        float q[64];
        { const u32x4* qp = (const u32x4*)(P + (size_t)row * NPROJ + 1024 + hd * 64);
#pragma unroll
          for (int i = 0; i < 8; ++i) { const u32x4 w = qp[i]; q[8*i+0] = bf_lo(w.x) * 0.125f; q[8*i+1] = bf_hi(w.x) * 0.125f; q[8*i+2] = bf_lo(w.y) * 0.125f; q[8*i+3] = bf_hi(w.y) * 0.125f;
              q[8*i+4] = bf_lo(w.z) * 0.125f; q[8*i+5] = bf_hi(w.z) * 0.125f; q[8*i+6] = bf_lo(w.w) * 0.125f; q[8*i+7] = bf_hi(w.w) * 0.125f; } }
        float acc = 0.f, carry = 0.f;
        for (int r0 = 0; r0 < t; r0 += 64) {
            const int dist = r0 + lane + 1; const bool valid = dist <= t;
            float lk = 0.f, ls = 0.f;
            if (valid) { const u32x4* kp = (const u32x4*)(P + (size_t)(row - dist) * NPROJ + 1536 + hd * 64); float z = 0.f;
#pragma unroll
                for (int i = 0; i < 8; ++i) { const u32x4 w = kp[i]; z += q[8*i+0] * bf_lo(w.x) + q[8*i+1] * bf_hi(w.x) + q[8*i+2] * bf_lo(w.y) + q[8*i+3] * bf_hi(w.y)
                        + q[8*i+4] * bf_lo(w.z) + q[8*i+5] * bf_hi(w.z) + q[8*i+6] * bf_lo(w.w) + q[8*i+7] * bf_hi(w.w); }
                const float sp = fmaxf(z, 0.f) + __logf(1.f + __expf(-fabsf(z)));
                lk = -sp; ls = z - sp; }
            float incl = lk;
#pragma unroll
            for (int o = 1; o < 64; o <<= 1) { const float n = __shfl_up(incl, o); if (lane >= o) incl += n; }
            const float between = carry + incl - lk;
            const float att = valid ? __expf(ls + between) : 0.f;
            carry += __shfl(incl, 63);
            const int nj = (t - r0) < 64 ? (t - r0) : 64;
            for (int jj = 0; jj < nj; ++jj) { const float p = __shfl(att, jj); acc += p * bf1(P[(size_t)(row - (r0 + jj + 1)) * NPROJ + 2048 + hd * 64 + lane]); }
            if (carry < -110.f) break;
        }
        MIX[(size_t)row * D + 512 + hd * 64 + lane] = (bf16_t)(pk2(acc, 0.f) & 0xffffu);
    }
}

__device__ __forceinline__ void phase_router(Frame& F, const Args& a, int l) {
    frame_refresh(F);
    LAS float* wl = (LAS float*)F.lds;
    LAS int* cls_s = (LAS int*)(F.lds + 81920);
    LAS int* pos_s = cls_s + 256;
    LAS int* lcnt = pos_s + 256;
    LAS int* lbase = lcnt + 32;
    const float* wg = a.in[19] + (size_t)l * 1024 * 4; const float* wrt = a.in[21] + (size_t)l * 4 * 1024 * 4;
    for (int i = F.tid; i < 20 * 1024; i += NTHREADS) { const int c = i >> 10, k = i & 1023; wl[i] = (c < 4) ? wg[k * 4 + c] : wrt[((size_t)((c - 4) >> 2) * 1024 + k) * 4 + ((c - 4) & 3)]; }
    __syncthreads();
    const float* MOD = (const float*)(F.ws + WS_MOD) + (size_t)l * 16 * 6144;
    const float* gam = a.in[4] + (size_t)l * D; const float* bg = a.in[20] + l * 4; const float* br = a.in[22] + l * 16;
    bf16_t* HB = (bf16_t*)(F.ws + WS_HBUF); float* RW = (float*)(F.ws + WS_RW); int* SINFO = (int*)(F.ws + WS_LIST);
    unsigned* cnt = (unsigned*)(F.ws + WS_CTL) + CW_CNT + l * NCLS * 64;
    const float* x = a.out;
    const int lane = F.lane;
    for (int rb = F.vcu; rb < T / 256; rb += F.G) {
        if (F.tid < 32) lcnt[F.tid] = 0;
        __syncthreads();
        for (int it = 0; it < 16; ++it) {
            const int rl0 = F.wave * 32 + it * 2, row0 = rb * 256 + rl0, b = row0 >> 12;
            f32x4 h[2][4];
#pragma unroll
            for (int r = 0; r < 2; ++r) { norm_mod_row(x + (size_t)(row0 + r) * D, gam, MOD + (size_t)b * 6144 + 3072, MOD + (size_t)b * 6144 + 4096, lane, h[r]);
                store_row_bf16(HB + (size_t)(row0 + r) * D, lane, h[r]); }
            float lg[2][20];
#pragma unroll
            for (int c = 0; c < 20; ++c) { float s0 = 0.f, s1 = 0.f;
#pragma unroll
                for (int j = 0; j < 4; ++j) { const f32x4 w = *(const LAS f32x4*)(wl + c * 1024 + 4 * lane + 256 * j);
                    s0 += h[0][j].x * w.x + h[0][j].y * w.y + h[0][j].z * w.z + h[0][j].w * w.w;
                    s1 += h[1][j].x * w.x + h[1][j].y * w.y + h[1][j].z * w.z + h[1][j].w * w.w; }
                lg[0][c] = wave_sum(s0); lg[1][c] = wave_sum(s1); }
#pragma unroll
            for (int r = 0; r < 2; ++r) {
                float gl[4];
#pragma unroll
                for (int i = 0; i < 4; ++i) gl[i] = lg[r][i] + bg[i];
                int gi = 0; float gm = gl[0];
#pragma unroll
                for (int i = 1; i < 4; ++i) if (gl[i] > gm) { gm = gl[i]; gi = i; }
                float gs = 0.f;
#pragma unroll
                for (int i = 0; i < 4; ++i) gs += __expf(gl[i] - gm);
                const float gwt = 1.f / gs;
                float el[4];
#pragma unroll
                for (int e = 0; e < 4; ++e) { const float v = (gi == 0) ? lg[r][4 + e] : (gi == 1) ? lg[r][8 + e] : (gi == 2) ? lg[r][12 + e] : lg[r][16 + e]; el[e] = v + br[gi * 4 + e]; }
                int ea = 0; float va = el[0];
#pragma unroll
                for (int e = 1; e < 4; ++e) if (el[e] > va) { va = el[e]; ea = e; }
                int eb = -1; float vb = -3.0e38f;
#pragma unroll
                for (int e = 0; e < 4; ++e) if (e != ea && el[e] > vb) { vb = el[e]; eb = e; }
                const float wa = 1.f / (1.f + __expf(vb - va)), wb = 1.f - wa;
                const int lo = ea < eb ? ea : eb, hi = ea < eb ? eb : ea;
                const int pidx = (lo == 0) ? hi - 1 : (lo == 1 ? hi + 1 : 5);
                const int cls = gi * 6 + pidx;
                const float wlo = gwt * (ea == lo ? wa : wb), whi = gwt * (ea == lo ? wb : wa);
                if (lane == 0) { cls_s[rl0 + r] = cls; *(f32x2*)(RW + (size_t)(row0 + r) * 2) = (f32x2){wlo, whi}; }
            }
        }
        __syncthreads();
        if (F.tid < 256) pos_s[F.tid] = atomicAdd((int*)&lcnt[cls_s[F.tid]], 1);
        __syncthreads();
        if (F.tid < NCLS) lbase[F.tid] = (int)__hip_atomic_fetch_add(cnt + F.tid * 64, (unsigned)lcnt[F.tid], __ATOMIC_RELAXED, __HIP_MEMORY_SCOPE_AGENT);
        __syncthreads();
        if (F.tid < 256) { const int c = cls_s[F.tid]; SINFO[rb * 256 + F.tid] = (c << 16) | (lbase[c] + pos_s[F.tid]); }
        __syncthreads();
    }
}

__device__ __forceinline__ void build_moe_table(Frame& F, int l) {
    frame_refresh(F);
    LAS int* tbl = (LAS int*)(F.lds + 131072);
    unsigned* cnt = (unsigned*)(F.ws + WS_CTL) + CW_CNT + l * NCLS * 64;
    if (F.tid == 0) { int acc = 0;
        for (int c = 0; c < NCLS; ++c) { const int n = (int)__hip_atomic_load(cnt + c * 64, __ATOMIC_RELAXED, __HIP_MEMORY_SCOPE_AGENT); tbl[c] = acc; tbl[32 + c] = n; acc += (n + 255) >> 8; }
        tbl[24] = acc; }
    __syncthreads();
}

__device__ __forceinline__ void phase_permute(Frame& F) {
    const LAS int* tbl = (const LAS int*)(F.lds + 131072);
    const int gw = F.vcu * NWAVES + F.wave, NGW = F.G * NWAVES, lane = F.lane;
    const int* SINFO = (const int*)(F.ws + WS_LIST); int* STOK = (int*)(F.ws + WS_LIST + 1 * MiB); float* RWS = (float*)(F.ws + WS_LIST + 2 * MiB);
    const float* RW = (const float*)(F.ws + WS_RW);
    const bf16_t* HB = (const bf16_t*)(F.ws + WS_HBUF); bf16_t* HS = (bf16_t*)(F.ws + WS_HSORT);
    for (int row = gw; row < T; row += NGW) {
        const int si = SINFO[row]; const int cls = si >> 16, pos = si & 0xffff;
        const int slot = tbl[cls] * 256 + pos;
        const u32x4* src = (const u32x4*)(HB + (size_t)row * D) + lane; u32x4* dst = (u32x4*)(HS + (size_t)slot * D) + lane;
        const u32x4 v0 = src[0], v1 = src[64]; dst[0] = v0; dst[64] = v1;
        if (lane == 0) { STOK[slot] = row; *(f32x2*)(RWS + (size_t)slot * 2) = *(const f32x2*)(RW + (size_t)row * 2); }
    }
}

__device__ __forceinline__ void phase_final(Frame& F, const Args& a) {
    frame_refresh(F);
    const int gw = F.vcu * NWAVES + F.wave, NGW = F.G * NWAVES;
    const f32x4* g4 = (const f32x4*)a.in[26];
    for (int row = gw; row < T; row += NGW) {
        f32x4* xr = (f32x4*)(a.out + (size_t)row * D) + F.lane;
        f32x4 v[4]; float ss = 0.f;
#pragma unroll
        for (int j = 0; j < 4; ++j) { v[j] = xr[64 * j]; ss += (v[j].x * v[j].x + v[j].y * v[j].y) + (v[j].z * v[j].z + v[j].w * v[j].w); }
        const float rstd = rsqrtf(wave_sum(ss) * (1.f / D) + EPS);
#pragma unroll
        for (int j = 0; j < 4; ++j) xr[64 * j] = v[j] * rstd * g4[F.lane + 64 * j];
    }
}

constexpr int NPHASE = 38;
#ifndef PHMASK
#define PHMASK 0xFFFFu
#endif
#define PHON(b) ((PHMASK >> (b)) & 1u)

__global__ void __launch_bounds__(NTHREADS, 2) fwd_kernel(Args args) {
    extern __shared__ __attribute__((aligned(16))) unsigned char lds_raw[];
    Frame F;
    F.lds = (LAS unsigned char*)lds_raw;
    F.tid = threadIdx.x; F.lane = F.tid & 63; F.wave = __builtin_amdgcn_readfirstlane(F.tid >> 6);
    F.G = gridDim.x; { const int bx = blockIdx.x; F.vcu = (F.G % 8 == 0) ? (bx % 8) * (F.G / 8) + bx / 8 : bx; }
    F.ws = args.ws;
    volatile LAS unsigned* MISC = (volatile LAS unsigned*)(F.lds + MISC_OFF);
    for (int u = F.tid; u < 256; u += NTHREADS) MISC[u] = 0u;
    __syncthreads();
    unsigned* ctl = (unsigned*)(F.ws + WS_CTL);
    const int lo = args.ph_lo, hi = args.ph_hi;
    const bool multi = (hi - lo) > 1;
    XcdBarrier bar; bar.bar = ctl + CW_BAR; bar.x = 0; bar.st = nullptr;
    if (multi) bar = xcd_barrier_post(ctl + CW_BAR, MISC + 8);
#define IN(k) (lo <= (k) && (k) < hi)
#define SEAM(k) do { if (IN(k) && IN((k) + 1)) xcd_barrier(bar); } while (0)

    if (PHON(0) && IN(0)) { phase_prologue(F, args); }
    SEAM(0);

    const float* MODB = (const float*)(F.ws + WS_MOD);
#pragma unroll 1
    for (int l = 0; l < NL; ++l) {
        const int pb = 1 + 9 * l;
        const float* xin = (l == 0) ? args.in[0] : args.out;
        if (PHON(1) && IN(pb + 0)) phase_norm1(F, args, l, xin);
        SEAM(pb + 0);
        if (PHON(2) && IN(pb + 1)) {
            pg8::DenseSched S{(const char*)(F.ws + WS_HBUF), (const char*)(F.ws + WS_WIN) + (size_t)l * NPROJ * 1024 * 2, T / 256, NPROJ / 256, F.G, (int)blockIdx.x, 1024, 1024};
            pg8::EpiBf16Store E{(bf16_t*)(F.ws + WS_PROJ), NPROJ};
            pg8::gemm_phase<pg8::EpiBf16Store, pg8::DenseSched>(F.lds, 1024, 1024, S, E);
        }
        SEAM(pb + 1);
        if (IN(pb + 2)) { if (l & 1) { if (PHON(3)) phase_conv(F, args, l >> 1); } else { if (PHON(4)) phase_dilated_naive(F, args); } }
        SEAM(pb + 2);
        if (IN(pb + 3)) { if (l & 1) { if (PHON(5)) phase_stick_naive(F); } else { if (PHON(6)) phase_gmlp(F, args, l >> 1); } }
        SEAM(pb + 3);
        if (PHON(7) && IN(pb + 4)) {
            pg8::DenseSched S{(const char*)(F.ws + WS_MIX), (const char*)(F.ws + WS_WOUT) + (size_t)l * 1024 * 1024 * 2, T / 256, D / 256, F.G, (int)blockIdx.x, 1024, 1024};
            pg8::EpiResid E{xin, args.out, MODB + (size_t)l * 16 * 6144 + 2048};
            pg8::gemm_phase<pg8::EpiResid, pg8::DenseSched>(F.lds, 1024, 1024, S, E);
        }
        SEAM(pb + 4);
        if (PHON(8) && IN(pb + 5)) phase_router(F, args, l);
        SEAM(pb + 5);
        if (PHON(8) && IN(pb + 6)) { build_moe_table(F, l); phase_permute(F); }
        SEAM(pb + 6);
        if (PHON(9) && IN(pb + 7)) {
            build_moe_table(F, l);
            pg8::MoeSched1 S{(const char*)(F.ws + WS_HSORT), (const char*)(F.ws + WS_WGU) + (size_t)l * 16 * 1024 * 1024 * 2, (const LAS int*)(F.lds + 131072), F.G, (int)blockIdx.x};
            pg8::EpiHid E{(bf16_t*)(F.ws + WS_PROJ), (const float*)(F.ws + WS_LIST + 2 * MiB)};
            pg8::gemm_phase<pg8::EpiHid, pg8::MoeSched1>(F.lds, 1024, 1024, S, E);
        }
        SEAM(pb + 7);
        if (PHON(10) && IN(pb + 8)) {
            build_moe_table(F, l);
            pg8::MoeSched2 S{(const char*)(F.ws + WS_PROJ), (const char*)(F.ws + WS_WDT) + (size_t)l * 1024 * 8192 * 2, (const int*)(F.ws + WS_LIST + 1 * MiB), (const LAS int*)(F.lds + 131072), F.G, (int)blockIdx.x};
            pg8::EpiMoeOut E{args.out, MODB + (size_t)l * 16 * 6144 + 5120};
            pg8::gemm_phase<pg8::EpiMoeOut, pg8::MoeSched2>(F.lds, 1024, 8192, S, E);
        }
        SEAM(pb + 8);
    }
    if (PHON(11) && IN(37)) phase_final(F, args);
#undef IN
#undef SEAM
}

extern "C" void kernel_launch(void* const* d_in, const int* in_sizes, int n_in, void* d_out, int out_size, void* d_ws, size_t ws_size, hipStream_t stream) {
    static int grid = 0;
    if (grid == 0) {
        if (n_in != 27 || out_size != T * D || ws_size < WS_END) { fprintf(stderr, "kernel_launch: unexpected shapes (n_in %d out %d ws %zu)\n", n_in, out_size, ws_size); grid = -1; return; }
        int dev = 0, cus = 0, per_cu = 0;
        if (hipGetDevice(&dev) != hipSuccess || hipDeviceGetAttribute(&cus, hipDeviceAttributeMultiprocessorCount, dev) != hipSuccess) { grid = -1; return; }
        if (hipFuncSetAttribute((const void*)fwd_kernel, hipFuncAttributeMaxDynamicSharedMemorySize, LDS_BYTES) != hipSuccess) { fprintf(stderr, "kernel_launch: hipFuncSetAttribute failed\n"); grid = -1; return; }
        if (hipOccupancyMaxActiveBlocksPerMultiprocessor(&per_cu, (const void*)fwd_kernel, NTHREADS, LDS_BYTES) != hipSuccess || per_cu < 1) { fprintf(stderr, "kernel_launch: occupancy query says %d\n", per_cu); }
        (void)hipGetLastError();
        grid = cus;
    }
    if (grid < 0) return;
    (void)hipMemsetAsync((char*)d_ws + WS_CTL, 0, CTL_ZERO_BYTES, stream);
    Args a{};
    for (int i = 0; i < 27; ++i) a.in[i] = (const float*)d_in[i];
    a.out = (float*)d_out; a.ws = (unsigned char*)d_ws;
#ifndef MK_MULTI
    a.ph_lo = 0; a.ph_hi = NPHASE;
    hipLaunchKernelGGL(fwd_kernel, dim3(grid), dim3(NTHREADS), LDS_BYTES, stream, a);
#else
    for (int p = 0; p < NPHASE; ++p) { a.ph_lo = p; a.ph_hi = p + 1; hipLaunchKernelGGL(fwd_kernel, dim3(grid), dim3(NTHREADS), LDS_BYTES, stream, a); }
#endif
}
```

```cpp
#include <hip/hip_runtime.h>
#include <cstdio>
#include <cstdint>

#define LAS __attribute__((address_space(3)))
#define GAS __attribute__((address_space(1)))
typedef unsigned short bf16_t;
typedef short bf16x8 __attribute__((ext_vector_type(8)));
typedef float f32x4 __attribute__((ext_vector_type(4)));
typedef float f32x2 __attribute__((ext_vector_type(2)));
typedef float f32x16 __attribute__((ext_vector_type(16)));
typedef unsigned u32x4 __attribute__((ext_vector_type(4)));
typedef unsigned u32x2 __attribute__((ext_vector_type(2)));
typedef __bf16 bf16x2v __attribute__((ext_vector_type(2)));

constexpr int T = 65536, D = 1024, SEQ = 4096, NBATCH = 16, NL = 4, NPROJ = 2560, NEXP = 16, DE = 512, NCLS = 24;
constexpr float EPS = 1e-6f;
constexpr int NWAVES = 8, NTHREADS = 512;

constexpr size_t MiB = 1u << 20;
constexpr size_t WS_CTL = 0, CTL_ZERO_BYTES = 1 * MiB;
constexpr size_t WS_WIN = 2 * MiB;
constexpr size_t WS_WOUT = 22 * MiB;
constexpr size_t WS_WS = 30 * MiB;
constexpr size_t WS_MOD = 31 * MiB;
constexpr size_t WS_RW = 33 * MiB;
constexpr size_t WS_LIST = 34 * MiB;
constexpr size_t WS_WGU = 40 * MiB;
constexpr size_t WS_WDT = 168 * MiB;
constexpr size_t WS_HBUF = 232 * MiB;
constexpr size_t WS_MIX = 360 * MiB;
constexpr size_t WS_PROJ = 488 * MiB;
constexpr size_t WS_END = 808 * MiB;
constexpr int HID_ROWS = T + NCLS * 256;
constexpr size_t WS_HSORT = WS_PROJ + 160 * MiB;
constexpr int CW_BAR = 4096;
constexpr int CW_CNT = 8192;

constexpr int LDS_BYTES = 155648;
constexpr int MISC_OFF = LDS_BYTES - 1024;

__device__ __forceinline__ unsigned pk2(float a, float b) { f32x2 v = {a, b}; bf16x2v r = __builtin_convertvector(v, bf16x2v); return __builtin_bit_cast(unsigned, r); }
__device__ __forceinline__ float bf_lo(unsigned u) { return __uint_as_float(u << 16); }
__device__ __forceinline__ float bf_hi(unsigned u) { return __uint_as_float(u & 0xffff0000u); }
__device__ __forceinline__ float bf1(bf16_t b) { return __uint_as_float(((unsigned)b) << 16); }
template <int CTRL, int RM> __device__ __forceinline__ float dpp_mov0(float v) { return __builtin_bit_cast(float, __builtin_amdgcn_update_dpp(0, __builtin_bit_cast(int, v), CTRL, RM, 0xf, true)); }
template <int CTRL, int RM> __device__ __forceinline__ float dpp_movs(float v) { return __builtin_bit_cast(float, __builtin_amdgcn_update_dpp(__builtin_bit_cast(int, v), __builtin_bit_cast(int, v), CTRL, RM, 0xf, false)); }
__device__ __forceinline__ float wave_sum(float v) {
    v += dpp_mov0<0xB1, 0xf>(v); v += dpp_mov0<0x4E, 0xf>(v); v += dpp_mov0<0x141, 0xf>(v); v += dpp_mov0<0x140, 0xf>(v);
    v += dpp_mov0<0x142, 0xa>(v); v += dpp_mov0<0x143, 0xc>(v);
    return __builtin_bit_cast(float, __builtin_amdgcn_readlane(__builtin_bit_cast(int, v), 63));
}
__device__ __forceinline__ float wave_max(float v) {
    v = fmaxf(v, dpp_movs<0xB1, 0xf>(v)); v = fmaxf(v, dpp_movs<0x4E, 0xf>(v)); v = fmaxf(v, dpp_movs<0x141, 0xf>(v)); v = fmaxf(v, dpp_movs<0x140, 0xf>(v));
    v = fmaxf(v, dpp_movs<0x142, 0xa>(v)); v = fmaxf(v, dpp_movs<0x143, 0xc>(v));
    return __builtin_bit_cast(float, __builtin_amdgcn_readlane(__builtin_bit_cast(int, v), 63));
}
__device__ __forceinline__ float silu_f(float x) { return x / (1.f + __expf(-x)); }
__device__ __forceinline__ float sigmoid_f(float x) { return 1.f / (1.f + __expf(-x)); }
__device__ __forceinline__ float gelu_tanh(float x) {
    const float u = 0.7978845608028654f * (x + 0.044715f * x * x * x);
    const float e = __expf(2.f * u);
    const float th = 1.f - 2.f / (e + 1.f);
    return 0.5f * x * (1.f + th);
}
#define LDS_WAIT() asm volatile("s_waitcnt lgkmcnt(0)" ::: "memory")

#define XB_TMO      128
#define XB_XCNT(j)  (256  + 64 * (j))
#define XB_XSUB(j)  (1280 + 64 * (j))
#define XB_XGEN(j)  (2304 + 64 * (j))
#define XB_TOP      3328
#define XB_TOPGEN   3392
#define XCD_BAR_WORDS 3456
#define XB_SPIN_CAP (1u << 20)

__device__ __forceinline__ unsigned xb_ld(unsigned* p)              { return __hip_atomic_load(p, __ATOMIC_RELAXED, __HIP_MEMORY_SCOPE_AGENT); }
__device__ __forceinline__ unsigned xb_add(unsigned* p, unsigned v) { return __hip_atomic_fetch_add(p, v, __ATOMIC_RELAXED, __HIP_MEMORY_SCOPE_AGENT); }
__device__ __forceinline__ unsigned xb_xcc_id() { return (unsigned)__builtin_amdgcn_s_getreg((3 << 11) | 20) & 0xFu; }
#define XB_SPIN(cond, bar) do { unsigned _sp = 0; while (cond) { __builtin_amdgcn_s_sleep(1); \
    if ((++_sp & 255u) == 0u) { if (xb_ld(&(bar)[XB_TMO])) break; if (_sp > XB_SPIN_CAP) { atomicAdd(&(bar)[XB_TMO], 1u); break; } } } } while (0)

struct XcdBarrier { unsigned* bar; unsigned x; volatile LAS unsigned* st; };

__device__ __forceinline__ XcdBarrier xcd_barrier_post(unsigned* bar, volatile LAS unsigned* st) {
    XcdBarrier b; b.bar = bar; b.x = xb_xcc_id(); b.st = st;
    if (threadIdx.x == 0) (void)xb_add(&bar[XB_XCNT(b.x)], 1u);
    return b;
}
__device__ __forceinline__ void xcd_barrier_complete(unsigned* bar, unsigned x, unsigned& nloc, unsigned& nx) {
    const unsigned G = gridDim.x * gridDim.y * gridDim.z;
    unsigned sum, cnt, mine, sp = 0u;
    for (;;) {
        sum = 0u; cnt = 0u; mine = 0u;
#pragma unroll
        for (unsigned j = 0; j < 16; ++j) { const unsigned c = xb_ld(&bar[XB_XCNT(j)]); sum += c; cnt += (c > 0u) ? 1u : 0u; mine = (j == x) ? c : mine; }
        if (sum == G) break;
        __builtin_amdgcn_s_sleep(1);
        if ((++sp & 255u) == 0u) { if (xb_ld(&bar[XB_TMO])) break; if (sp > XB_SPIN_CAP) { atomicAdd(&bar[XB_TMO], 1u); break; } }
    }
    nloc = mine > 0u ? mine : 1u; nx = cnt > 0u ? cnt : 1u;
}
__device__ __forceinline__ void xcd_barrier(const XcdBarrier& b) {
    asm volatile("s_waitcnt vmcnt(0)" ::: "memory");
    __syncthreads();
    if (threadIdx.x == 0) {
        unsigned* bar = b.bar;
        __builtin_amdgcn_s_waitcnt(0);
        unsigned nloc = b.st[0], nx = b.st[1];
        if (nloc == 0u) { xcd_barrier_complete(bar, b.x, nloc, nx); b.st[0] = nloc; b.st[1] = nx; }
        const unsigned old = xb_add(&bar[XB_XSUB(b.x)], 1u);
        const unsigned gen = old / nloc;
        if (old + 1u == (gen + 1u) * nloc) {
            __builtin_amdgcn_fence(__ATOMIC_RELEASE, "agent");
            asm volatile("s_waitcnt vmcnt(0)" ::: "memory");
            const unsigned og = xb_add(&bar[XB_TOP], 1u);
            const unsigned tg = og / nx;
            if (og + 1u == (tg + 1u) * nx) xb_add(&bar[XB_TOPGEN], 1u);
            else XB_SPIN(xb_ld(&bar[XB_TOPGEN]) == tg, bar);
            __builtin_amdgcn_fence(__ATOMIC_ACQUIRE, "agent");
            xb_add(&bar[XB_XGEN(b.x)], 1u);
            asm volatile("s_waitcnt vmcnt(0)" ::: "memory");
        } else {
            XB_SPIN(xb_ld(&bar[XB_XGEN(b.x)]) == gen, bar);
            __builtin_amdgcn_fence(__ATOMIC_ACQUIRE, "agent");
            asm volatile("s_waitcnt vmcnt(0)" ::: "memory");
        }
    }
    __syncthreads();
}

namespace pg8 {
constexpr int BM = 256, BK = 64, HALF = 128, HTB = HALF * BK * 2, STAGE_BYTES = 8 * HTB, NXCD = 8, WGM = 8, KT = 16;
__device__ __forceinline__ int lds_byte(int r, int c) { const int st = (r >> 4) * 2 + (c >> 5), rr = r & 15, cc = c & 31, ob = rr * 64 + cc * 2; return st * 1024 + (ob ^ (((ob >> 9) & 1) << 5)); }
__device__ __forceinline__ void stage_rc(int b, int& R, int& C) { const int st = b / 1024, sb = b % 1024, swz = sb ^ (((sb >> 9) & 1) << 5); R = (st >> 1) * 16 + swz / 64; C = (st & 1) * 32 + (swz % 64) / 2; }
__device__ __forceinline__ int perm32(int rho) { const int n = rho >> 4, i = rho & 15; return 8 * (i >> 2) + 4 * n + (i & 3); }

struct Unit { const char* A; const char* B0; const char* B1; const int* list; int nvalid, r0, c0, aux; };

__device__ __forceinline__ bool static_tile(int i, int G, int c, int nM, int nN, int& pm, int& pn) {
    const int nwg = nM * nN; const long L = (long)i * G + c; if (L >= nwg) return false;
    int wgid = (int)L; { const int q = nwg / NXCD, r = nwg % NXCD, xcd = wgid % NXCD, off = wgid / NXCD; wgid = (xcd < r ? xcd * (q + 1) : r * (q + 1) + (xcd - r) * q) + off; }
    const int nig = WGM * nN, gid = wgid / nig, fm = gid * WGM, gsz = (nM - fm) < WGM ? (nM - fm) : WGM;
    pm = fm + ((wgid % nig) % gsz); pn = (wgid % nig) / gsz; return true;
}

template <class Epi, class Sched>
__device__ __forceinline__ void gemm_phase(LAS unsigned char* lds, const int lda, const int ldb, const Sched& S, const Epi& E) {
    int tid = threadIdx.x; asm volatile("" : "+v"(tid));
    const int wid = __builtin_amdgcn_readfirstlane(tid >> 6), lane = tid & 63, wr = wid >> 2, wc = wid & 3, fr = lane & 15, fq = lane >> 4;
    unsigned voffA[2], voffB[2];
#pragma unroll
    for (int i = 0; i < 2; ++i) { int R, C; stage_rc(tid * 16 + i * 8192, R, C); const int Rb = Epi::PERM ? ((R & ~31) + perm32(R & 31)) : R;
        voffA[i] = (unsigned)(R * lda + C) * 2u; voffB[i] = (unsigned)(Rb * ldb + C) * 2u; }
    const size_t kstep = (size_t)(BK * 2);
    const size_t hstepA = (size_t)HALF * lda * 2, hstepB = (size_t)HALF * ldb * 2;
    const unsigned ldsw = (unsigned)wid * 1024u;
    const int aoff = lds_byte(wr * 64 + fr, fq * 8), boff = lds_byte(wc * 32 + fr, fq * 8);
#define PG8_SA(b, h) (((b) * 2 + (h)) * HTB)
#define PG8_SB(b, h) ((4 + (b) * 2 + (h)) * HTB)
#define PG8_STAGE(bufoff, gbase, voff) do { _Pragma("unroll") for (int _i = 0; _i < 2; ++_i) \
        __builtin_amdgcn_global_load_lds((const unsigned*)((const char*)(gbase) + (voff)[_i]), (LAS unsigned*)(lds + (bufoff) + ldsw + _i * 8192), 16, 0, 0); } while (0)
#define PG8_LDA(dst, b, h) do { _Pragma("unroll") for (int m = 0; m < 4; ++m) _Pragma("unroll") for (int k = 0; k < 2; ++k) dst[m][k] = *(const LAS bf16x8*)(lds + PG8_SA(b, h) + aoff + m * 2048 + k * 1024); } while (0)
#define PG8_LDB(dst, b, h) do { _Pragma("unroll") for (int n = 0; n < 2; ++n) _Pragma("unroll") for (int k = 0; k < 2; ++k) dst[n][k] = *(const LAS bf16x8*)(lds + PG8_SB(b, h) + boff + n * 2048 + k * 1024); } while (0)
#define PG8_MMA(ai, bj, At, Bt) do { __builtin_amdgcn_s_setprio(1); _Pragma("unroll") for (int m = 0; m < 4; ++m) _Pragma("unroll") for (int n = 0; n < 2; ++n) _Pragma("unroll") for (int k = 0; k < 2; ++k) \
        acc[ai][bj][m][n] = __builtin_amdgcn_mfma_f32_16x16x32_bf16(Bt[n][k], At[m][k], acc[ai][bj][m][n], 0, 0, 0); __builtin_amdgcn_s_setprio(0); } while (0)
#define PG8_WAIT_V(n) asm volatile("s_waitcnt vmcnt(" #n ")" ::: "memory")
#define PG8_WAIT_L(n) asm volatile("s_waitcnt lgkmcnt(" #n ")" ::: "memory")
#define PG8_BAR __builtin_amdgcn_s_barrier()
#define PG8_SCHED __builtin_amdgcn_sched_barrier(0)
    Unit cur, nxt; int ui = 0;
    if (!S.next(0, cur)) return;
    f32x4 acc[2][2][4][2];
#pragma unroll
    for (int a = 0; a < 2; ++a)
#pragma unroll
        for (int b = 0; b < 2; ++b)
#pragma unroll
            for (int m = 0; m < 4; ++m)
#pragma unroll
                for (int n = 0; n < 2; ++n) acc[a][b][m][n] = (f32x4){0.f, 0.f, 0.f, 0.f};
    bf16x8 At[4][2], B0[2][2], B1[2][2];
    const char* cA = cur.A; const char* cB0 = cur.B0; const char* cB1 = cur.B1;
    PG8_STAGE(PG8_SB(0, 0), cB0, voffB); PG8_STAGE(PG8_SA(0, 0), cA, voffA); PG8_STAGE(PG8_SB(0, 1), cB0 + hstepB, voffB); PG8_STAGE(PG8_SA(0, 1), cA + hstepA, voffA);
    if (wr == 1) PG8_BAR;
    PG8_WAIT_V(4); PG8_BAR;
    PG8_STAGE(PG8_SB(1, 0), cB0 + kstep, voffB); PG8_STAGE(PG8_SA(1, 0), cA + kstep, voffA); PG8_STAGE(PG8_SB(1, 1), cB0 + hstepB + kstep, voffB);
    PG8_WAIT_V(6); PG8_BAR;
    for (;;) {
        const bool has_next = S.next(ui + 1, nxt);
        const char* nA = has_next ? nxt.A : cA; const char* nB = has_next ? nxt.B0 : cB0;
        for (int t = 0; t < KT; t += 2) {
            const bool last = (t == KT - 2);
            const char* a1 = cA + (size_t)(t + 1) * kstep;
            const char* a2 = last ? nA : cA + (size_t)(t + 2) * kstep;
            const char* b2 = last ? nB : ((t + 2 < 8) ? cB0 : cB1) + (size_t)(t + 2) * kstep;
            const char* a3 = a2 + kstep; const char* b3 = b2 + kstep;
            PG8_LDB(B0, 0, 0); PG8_SCHED; PG8_LDA(At, 0, 0); PG8_STAGE(PG8_SA(1, 1), a1 + hstepA, voffA);
            PG8_WAIT_L(8); PG8_BAR; PG8_WAIT_L(0); PG8_MMA(0, 0, At, B0); PG8_BAR; PG8_SCHED;
            PG8_LDB(B1, 0, 1); PG8_STAGE(PG8_SB(0, 0), b2, voffB);
            PG8_BAR; PG8_WAIT_L(0); PG8_MMA(0, 1, At, B1); PG8_BAR;
            PG8_LDA(At, 0, 1); PG8_STAGE(PG8_SA(0, 0), a2, voffA);
            PG8_BAR; PG8_WAIT_L(0); PG8_MMA(1, 0, At, B0); PG8_BAR; PG8_SCHED;
            PG8_STAGE(PG8_SB(0, 1), b2 + hstepB, voffB);
            PG8_WAIT_V(6); PG8_BAR; PG8_MMA(1, 1, At, B1); PG8_BAR;
            PG8_LDB(B0, 1, 0); PG8_SCHED; PG8_LDA(At, 1, 0); PG8_STAGE(PG8_SA(0, 1), a2 + hstepA, voffA);
            PG8_WAIT_L(8); PG8_BAR; PG8_WAIT_L(0); PG8_MMA(0, 0, At, B0); PG8_BAR; PG8_SCHED;
            PG8_LDB(B1, 1, 1); PG8_STAGE(PG8_SB(1, 0), b3, voffB);
            PG8_BAR; PG8_WAIT_L(0); PG8_MMA(0, 1, At, B1); PG8_BAR;
            PG8_LDA(At, 1, 1); PG8_STAGE(PG8_SA(1, 0), a3, voffA);
            PG8_BAR; PG8_WAIT_L(0); PG8_MMA(1, 0, At, B0); PG8_BAR; PG8_SCHED;
            PG8_STAGE(PG8_SB(1, 1), b3 + hstepB, voffB);
            PG8_WAIT_V(6); PG8_BAR; PG8_MMA(1, 1, At, B1); PG8_BAR;
        }
        E(acc, cur, wr, wc, fr, fq);
        if (!has_next) break;
#pragma unroll
        for (int a = 0; a < 2; ++a)
#pragma unroll
            for (int b = 0; b < 2; ++b)
#pragma unroll
                for (int m = 0; m < 4; ++m)
#pragma unroll
                    for (int n = 0; n < 2; ++n) acc[a][b][m][n] = (f32x4){0.f, 0.f, 0.f, 0.f};
        cur = nxt; cA = nA; cB0 = cur.B0; cB1 = cur.B1; ++ui;
    }
    PG8_WAIT_V(0);
    if (wr == 0) PG8_BAR;
    PG8_BAR;
#undef PG8_SA
#undef PG8_SB
#undef PG8_STAGE
#undef PG8_LDA
#undef PG8_LDB
#undef PG8_MMA
#undef PG8_WAIT_V
#undef PG8_WAIT_L
#undef PG8_BAR
#undef PG8_SCHED
}


struct EpiBf16Store {
    static constexpr bool PERM = true;
    bf16_t* O; int ldc;
    __device__ __forceinline__ void operator()(const f32x4 (&acc)[2][2][4][2], const Unit& u, int wr, int wc, int fr, int fq) const {
        const int row0 = u.r0 + wr * 64 + fr, col0 = u.c0 + wc * 32 + 8 * fq;
#pragma unroll
        for (int ai = 0; ai < 2; ++ai)
#pragma unroll
            for (int m = 0; m < 4; ++m) { bf16_t* rowp = O + (size_t)(row0 + ai * HALF + m * 16) * ldc + col0;
#pragma unroll
                for (int bj = 0; bj < 2; ++bj) { const f32x4 v0 = acc[ai][bj][m][0], v1 = acc[ai][bj][m][1];
                    u32x4 w; w.x = pk2(v0[0], v0[1]); w.y = pk2(v0[2], v0[3]); w.z = pk2(v1[0], v1[1]); w.w = pk2(v1[2], v1[3]);
                    *(u32x4*)(rowp + bj * HALF) = w; } }
    }
};
struct EpiDelta {
    static constexpr bool PERM = true;
    bf16_t* O; const float* gate;
    __device__ __forceinline__ void operator()(const f32x4 (&acc)[2][2][4][2], const Unit& u, int wr, int wc, int fr, int fq) const {
        const int row0 = u.r0 + wr * 64 + fr, col0 = u.c0 + wc * 32 + 8 * fq;
        const float* gp = gate + (size_t)(u.r0 >> 12) * 6144 + col0;
        f32x4 gv[2][2];
#pragma unroll
        for (int bj = 0; bj < 2; ++bj)
#pragma unroll
            for (int n = 0; n < 2; ++n) gv[bj][n] = *(const f32x4*)(gp + bj * HALF + 4 * n);
#pragma unroll
        for (int ai = 0; ai < 2; ++ai)
#pragma unroll
            for (int m = 0; m < 4; ++m) { bf16_t* rowp = O + (size_t)(row0 + ai * HALF + m * 16) * D + col0;
#pragma unroll
                for (int bj = 0; bj < 2; ++bj) { const f32x4 v0 = acc[ai][bj][m][0] * gv[bj][0], v1 = acc[ai][bj][m][1] * gv[bj][1];
                    u32x4 w; w.x = pk2(v0[0], v0[1]); w.y = pk2(v0[2], v0[3]); w.z = pk2(v1[0], v1[1]); w.w = pk2(v1[2], v1[3]);
                    *(u32x4*)(rowp + bj * HALF) = w; } }
    }
};
struct EpiHid {
    static constexpr bool PERM = true;
    bf16_t* H; const float* rw;
    __device__ __forceinline__ void operator()(const f32x4 (&acc)[2][2][4][2], const Unit& u, int wr, int wc, int fr, int fq) const {
        const int rl0 = wr * 64 + fr, col0 = u.c0 + wc * 32 + 8 * fq;
#pragma unroll
        for (int ai = 0; ai < 2; ++ai)
#pragma unroll
            for (int m = 0; m < 4; ++m) { const int rl = rl0 + ai * HALF + m * 16;
                float w = 0.f; if (rl < u.nvalid) w = rw[(size_t)(u.r0 + rl) * 2 + u.aux];
                const f32x4 g0 = acc[ai][0][m][0], g1 = acc[ai][0][m][1], u0 = acc[ai][1][m][0], u1 = acc[ai][1][m][1];
                float h[8];
#pragma unroll
                for (int j = 0; j < 4; ++j) { h[j] = silu_f(g0[j]) * u0[j] * w; h[4 + j] = silu_f(g1[j]) * u1[j] * w; }
                u32x4 o; o.x = pk2(h[0], h[1]); o.y = pk2(h[2], h[3]); o.z = pk2(h[4], h[5]); o.w = pk2(h[6], h[7]);
                *(u32x4*)(H + (size_t)(u.r0 + rl) * D + col0) = o; }
    }
};
struct DenseSched {
    const char* A; const char* Bt; int nM, nN, G, c, lda, ldb;
    __device__ __forceinline__ bool next(int i, Unit& u) const {
        int pm, pn; if (!static_tile(i, G, c, nM, nN, pm, pn)) return false;
        u.A = A + (size_t)pm * BM * lda * 2; u.B0 = Bt + (size_t)pn * BM * ldb * 2; u.B1 = u.B0; u.list = nullptr; u.nvalid = 256; u.r0 = pm * BM; u.c0 = pn * BM; u.aux = 0; return true;
    }
};
__device__ __forceinline__ void cls_experts(int cls, int& e_lo, int& e_hi) {
    const int g = cls / 6, p = cls % 6; const int lo = (p < 3) ? 0 : (p < 5 ? 1 : 2); const int hi = (p < 3) ? p + 1 : (p < 5 ? p - 1 : 3);
    e_lo = g * 4 + lo; e_hi = g * 4 + hi;
}
struct MoeSched1 {
    const char* A; const char* Wgu; const LAS int* tbl; int G, c;
    __device__ __forceinline__ bool next(int i, Unit& u) const {
        const int MT = tbl[24]; int mt, pn; if (!static_tile(i, G, c, MT, 8, mt, pn)) return false;
        int cls = 0;
#pragma unroll 1
        for (int k = 1; k < NCLS; ++k) if (tbl[k] <= mt) cls = k;
        const int ml = mt - tbl[cls]; int e_lo, e_hi; cls_experts(cls, e_lo, e_hi);
        const int e = (pn < 4) ? e_lo : e_hi;
        u.A = A + (size_t)mt * 256 * 1024 * 2; u.B0 = Wgu + ((size_t)e * 1024 + (size_t)(pn & 3) * 256) * 1024 * 2; u.B1 = u.B0; u.list = nullptr;
        const int rem = tbl[32 + cls] - ml * 256; u.nvalid = rem < 256 ? rem : 256; u.r0 = mt * 256; u.c0 = (pn >> 2) * 512 + (pn & 3) * 128; u.aux = pn >> 2; return true;
    }
};
struct MoeSched2 {
    const char* H; const char* Wdt; const int* slot_tok; const LAS int* tbl; int G, c;
    __device__ __forceinline__ bool next(int i, Unit& u) const {
        const int MT = tbl[24]; int mt, pn; if (!static_tile(i, G, c, MT, 4, mt, pn)) return false;
        int cls = 0;
#pragma unroll 1
        for (int k = 1; k < NCLS; ++k) if (tbl[k] <= mt) cls = k;
        const int ml = mt - tbl[cls]; int e_lo, e_hi; cls_experts(cls, e_lo, e_hi);
        u.A = H + (size_t)mt * 256 * 1024 * 2;
        const char* brow = Wdt + (size_t)pn * 256 * 8192 * 2;
        u.B0 = brow + (size_t)e_lo * 512 * 2; u.B1 = brow + (size_t)e_hi * 512 * 2 - 8 * 128; u.list = slot_tok + (size_t)mt * 256;
        const int rem = tbl[32 + cls] - ml * 256; u.nvalid = rem < 256 ? rem : 256; u.r0 = mt * 256; u.c0 = pn * 256; u.aux = 0; return true;
    }
};
}

struct Args { const float* in[27]; float* out; unsigned char* ws; int ph_lo, ph_hi; };

__device__ const unsigned char BUCKET[3][132] = {
 {0,1,2,3,4,5,6,7,8,9,10,11,12,13,14,15,16,16,16,16,16,16,17,17,17,17,17,17,17,17,18,18,18,18,18,18,18,18,18,18,19,19,19,19,19,19,19,19,19,19,19,19,19,19,20,20,20,20,20,20,20,20,20,20,20,20,20,20,20,20,20,20,20,21,21,21,21,21,21,21,21,21,21,21,21,21,21,21,21,21,21,21,21,21,21,21,21,21,21,22,22,22,22,22,22,22,22,22,22,22,22,22,22,22,22,22,22,22,22,22,22,22,22,22,22,22,22,22,22,0,0,0},
 {0,4,8,12,16,16,17,17,18,18,19,19,19,19,20,20,20,20,20,21,21,21,21,21,21,22,22,22,22,22,22,22,22,22,23,23,23,23,23,23,23,23,23,23,23,23,24,24,24,24,24,24,24,24,24,24,24,24,24,24,24,24,25,25,25,25,25,25,25,25,25,25,25,25,25,25,25,25,25,25,25,25,25,26,26,26,26,26,26,26,26,26,26,26,26,26,26,26,26,26,26,26,26,26,26,26,26,26,26,26,26,26,26,27,27,27,27,27,27,27,27,27,27,27,27,27,27,27,27,0,0,0},
 {0,16,18,19,20,21,21,22,22,23,23,23,24,24,24,24,25,25,25,25,25,26,26,26,26,26,26,26,26,27,27,27,27,27,27,27,27,27,27,28,28,28,28,28,28,28,28,28,28,28,28,28,29,29,29,29,29,29,29,29,29,29,29,29,29,29,29,29,29,29,30,30,30,30,30,30,30,30,30,30,30,30,30,30,30,30,30,30,30,30,30,30,30,30,30,31,31,31,31,31,31,31,31,31,31,31,31,31,31,31,31,31,31,31,31,31,31,31,31,31,31,31,31,31,31,31,31,31,31,0,0,0}};

struct Frame {
    LAS unsigned char* lds;
    int tid, lane, wave, vcu, G;
    unsigned char* ws;
};

__device__ __forceinline__ void frame_refresh(Frame& F) {
    int tid = threadIdx.x; asm volatile("" : "+v"(tid));
    F.tid = tid; F.lane = tid & 63; F.wave = __builtin_amdgcn_readfirstlane(tid >> 6);
}
__device__ __forceinline__ void transpose_item(const float* W, int srcN, int k0, int n0, bf16_t* dst, size_t dstride, LAS float* scr, int lane) {
#pragma unroll 8
    for (int i = 0; i < 32; ++i) { const int kk = 2 * i + (lane >> 5); scr[kk * 33 + (lane & 31)] = W[(size_t)(k0 + kk) * srcN + n0 + (lane & 31)]; }
    LDS_WAIT(); asm volatile("" ::: "memory");
    const int c = lane & 7;
#pragma unroll
    for (int j = 0; j < 4; ++j) { const int n = (lane >> 3) + 8 * j; const LAS float* s = scr + (8 * c) * 33 + n;
        u32x4 o; o.x = pk2(s[0 * 33], s[1 * 33]); o.y = pk2(s[2 * 33], s[3 * 33]); o.z = pk2(s[4 * 33], s[5 * 33]); o.w = pk2(s[6 * 33], s[7 * 33]);
        *(u32x4*)(dst + (size_t)n * dstride + 8 * c) = o; }
    LDS_WAIT(); asm volatile("" ::: "memory");
}

__device__ __forceinline__ void phase_prologue(Frame& F, const Args& a) {
    frame_refresh(F);
    LAS float* scr = (LAS float*)(F.lds + F.wave * 16384);
    const int gw = F.vcu * NWAVES + F.wave, NGW = F.G * NWAVES;
    bf16_t* WIN = (bf16_t*)(F.ws + WS_WIN); bf16_t* WOUT = (bf16_t*)(F.ws + WS_WOUT); bf16_t* WGU = (bf16_t*)(F.ws + WS_WGU); bf16_t* WDT = (bf16_t*)(F.ws + WS_WDT);
    constexpr int I_IN = 4 * 16 * 80, I_OUT = 4 * 16 * 32, I_G = 64 * 16 * 16, I_D = 64 * 8 * 32;
    constexpr int NITEMS = I_IN + I_OUT + 2 * I_G + I_D;
    for (int it = gw; it < NITEMS; it += NGW) {
        int r = it;
        if (r < I_IN) { const int l = r / 1280, q = r % 1280, kb = q / 80, nb = q % 80;
            const float* W = ((l & 1) ? a.in[13] : a.in[7]) + (size_t)(l >> 1) * 1024 * NPROJ;
            transpose_item(W, NPROJ, 64 * kb, 32 * nb, WIN + ((size_t)l * NPROJ + 32 * nb) * 1024 + 64 * kb, 1024, scr, F.lane); continue; }
        r -= I_IN;
        if (r < I_OUT) { const int l = r / 512, q = r % 512, kb = q / 32, nb = q % 32;
            const float* W = ((l & 1) ? a.in[14] : a.in[8]) + (size_t)(l >> 1) * 1024 * 1024;
            transpose_item(W, 1024, 64 * kb, 32 * nb, WOUT + ((size_t)l * 1024 + 32 * nb) * 1024 + 64 * kb, 1024, scr, F.lane); continue; }
        r -= I_OUT;
        if (r < 2 * I_G) { const int up = r / I_G, q0 = r % I_G, le = q0 / 256, q = q0 % 256, kb = q / 16, nb = q % 16;
            const float* W = (up ? a.in[24] : a.in[23]) + (size_t)le * 1024 * 512;
            const int n0 = 32 * nb, drow = 256 * (n0 >> 7) + 128 * up + (n0 & 127);
            transpose_item(W, 512, 64 * kb, n0, WGU + ((size_t)le * 1024 + drow) * 1024 + 64 * kb, 1024, scr, F.lane); continue; }
        r -= 2 * I_G;
        { const int le = r / 256, q = r % 256, kb = q / 32, nb = q % 32, l = le >> 4, e = le & 15;
            const float* W = a.in[25] + (size_t)le * 512 * 1024;
            transpose_item(W, 1024, 64 * kb, 32 * nb, WDT + ((size_t)l * 1024 + 32 * nb) * 8192 + e * 512 + 64 * kb, 8192, scr, F.lane); }
    }
    { bf16_t* WS = (bf16_t*)(F.ws + WS_WS); const float* src = a.in[11];
      for (int i = (F.vcu * NTHREADS + F.tid); i < 2 * 4 * 128 * 128; i += F.G * NTHREADS) { const int t = (i >> 7) & 127, s = i & 127; const float v = (s <= t) ? src[i] : 0.f; WS[i] = (bf16_t)(pk2(v, 0.f) & 0xffffu); } }
    __syncthreads();
    { LAS float* sc = (LAS float*)F.lds;
      LAS float* red = (LAS float*)(F.lds + 65536);
      const float* c = a.in[1];
      for (int i = F.tid; i < 16 * 1024; i += NTHREADS) sc[i] = silu_f(c[i]);
      __syncthreads();
      float* MOD = (float*)(F.ws + WS_MOD);
      for (int grp = F.vcu; grp < 4 * 96; grp += F.G) {
          const int l = grp / 96, n = (grp % 96) * 64 + F.lane;
          const float* w = a.in[5] + ((size_t)l * 1024 + F.wave * 128) * 6144 + n;
          float acc[16];
#pragma unroll
          for (int b = 0; b < 16; ++b) acc[b] = 0.f;
#pragma unroll 4
          for (int k = 0; k < 128; ++k) { const float wv = w[(size_t)k * 6144];
#pragma unroll
              for (int b = 0; b < 16; ++b) acc[b] += sc[b * 1024 + F.wave * 128 + k] * wv; }
#pragma unroll
          for (int b = 0; b < 16; ++b) red[(F.wave * 16 + b) * 64 + F.lane] = acc[b];
          __syncthreads();
#pragma unroll
          for (int bb = 0; bb < 2; ++bb) { const int b = F.wave * 2 + bb; float s = a.in[6][(size_t)l * 6144 + n];
#pragma unroll
              for (int w8 = 0; w8 < 8; ++w8) s += red[(w8 * 16 + b) * 64 + F.lane];
              MOD[((size_t)l * 16 + b) * 6144 + n] = s; }
          __syncthreads();
      }
    }
}

__device__ __forceinline__ void load_row(const float* xrow, int lane, f32x4 (&v)[4]) {
    const f32x4* xr = (const f32x4*)xrow + lane;
#pragma unroll
    for (int j = 0; j < 4; ++j) v[j] = xr[64 * j];
}
__device__ __forceinline__ float row_rstd(const f32x4 (&v)[4]) {
    float ss = 0.f;
#pragma unroll
    for (int j = 0; j < 4; ++j) ss += (v[j].x * v[j].x + v[j].y * v[j].y) + (v[j].z * v[j].z + v[j].w * v[j].w);
    return rsqrtf(wave_sum(ss) * (1.f / D) + EPS);
}
__device__ __forceinline__ void load_mod(const float* gam, const float* sh, const float* sc, int lane, f32x4 (&gp)[4], f32x4 (&shv)[4]) {
#pragma unroll
    for (int j = 0; j < 4; ++j) { const f32x4 g = ((const f32x4*)gam)[lane + 64 * j], s1 = ((const f32x4*)sc)[lane + 64 * j]; gp[j] = g * (1.f + s1); shv[j] = ((const f32x4*)sh)[lane + 64 * j]; }
}
__device__ __forceinline__ void store_row_bf16(bf16_t* orow, int lane, const f32x4 (&h)[4]) {
    u32x2* o = (u32x2*)orow + lane;
#pragma unroll
    for (int j = 0; j < 4; ++j) { u32x2 w; w.x = pk2(h[j].x, h[j].y); w.y = pk2(h[j].z, h[j].w); o[64 * j] = w; }
}

__device__ __forceinline__ void load_y(const bf16_t* yrow, int lane, u32x2 (&y)[4]) {
    const u32x2* yr = (const u32x2*)yrow + lane;
#pragma unroll
    for (int j = 0; j < 4; ++j) y[j] = yr[64 * j];
}
__device__ __forceinline__ void add_y(f32x4 (&x)[4], const u32x2 (&y)[4], const f32x4 (&g)[4]) {
#pragma unroll
    for (int j = 0; j < 4; ++j) { x[j].x += g[j].x * bf_lo(y[j].x); x[j].y += g[j].y * bf_hi(y[j].x); x[j].z += g[j].z * bf_lo(y[j].y); x[j].w += g[j].w * bf_hi(y[j].y); }
}
__device__ __forceinline__ void store_row_f32(float* xrow, int lane, const f32x4 (&v)[4]) {
    f32x4* xr = (f32x4*)xrow + lane;
#pragma unroll
    for (int j = 0; j < 4; ++j) xr[64 * j] = v[j];
}
__device__ __forceinline__ void phase_norm1(Frame& F, const Args& a, int l) {
    frame_refresh(F);
    const int gw = F.vcu * NWAVES + F.wave, NGW = F.G * NWAVES, lane = F.lane;
    const float* MOD = (const float*)(F.ws + WS_MOD) + (size_t)l * 16 * 6144;
    bf16_t* HB = (bf16_t*)(F.ws + WS_HBUF);
    const float* gam = a.in[3] + (size_t)l * D;
    const bool addy = l > 0;
    const float* xin = addy ? a.out : a.in[0];
    const bf16_t* Y2 = (const bf16_t*)(F.ws + WS_HSORT); const int* SLOTMAP = (const int*)(F.ws + WS_LIST + 3 * MiB);
    for (int blk = gw; blk < T / 32; blk += NGW) {
        const int row0 = blk * 32, b = row0 >> 12;
        f32x4 gp[4], shv[4], g2[4]; load_mod(gam, MOD + (size_t)b * 6144, MOD + (size_t)b * 6144 + 1024, lane, gp, shv);
        int slotv = 0;
        if (addy) { slotv = SLOTMAP[row0 + (lane & 31)];
#pragma unroll
            for (int j = 0; j < 4; ++j) g2[j] = ((const f32x4*)(MOD - 16 * 6144 + (size_t)b * 6144 + 5120))[lane + 64 * j]; }
        f32x4 xa[4], xb[4], na[4], nb[4]; u32x2 ya[4], yb[4], nya[4], nyb[4];
        load_row(xin + (size_t)row0 * D, lane, xa); load_row(xin + (size_t)(row0 + 1) * D, lane, xb);
        if (addy) { load_y(Y2 + (size_t)__builtin_amdgcn_readlane(slotv, 0) * D, lane, ya); load_y(Y2 + (size_t)__builtin_amdgcn_readlane(slotv, 1) * D, lane, yb); }
#pragma unroll 1
        for (int r = 0; r < 32; r += 2) {
            if (r + 2 < 32) { load_row(xin + (size_t)(row0 + r + 2) * D, lane, na); load_row(xin + (size_t)(row0 + r + 3) * D, lane, nb);
                if (addy) { load_y(Y2 + (size_t)__builtin_amdgcn_readlane(slotv, r + 2) * D, lane, nya); load_y(Y2 + (size_t)__builtin_amdgcn_readlane(slotv, r + 3) * D, lane, nyb); } }
            if (addy) { add_y(xa, ya, g2); add_y(xb, yb, g2); store_row_f32(a.out + (size_t)(row0 + r) * D, lane, xa); store_row_f32(a.out + (size_t)(row0 + r + 1) * D, lane, xb); }
            const float ra = row_rstd(xa), rb = row_rstd(xb);
#pragma unroll
            for (int j = 0; j < 4; ++j) { xa[j] = xa[j] * ra * gp[j] + shv[j]; xb[j] = xb[j] * rb * gp[j] + shv[j]; }
            store_row_bf16(HB + (size_t)(row0 + r) * D, lane, xa); store_row_bf16(HB + (size_t)(row0 + r + 1) * D, lane, xb);
#pragma unroll
            for (int j = 0; j < 4; ++j) { xa[j] = na[j]; xb[j] = nb[j]; ya[j] = nya[j]; yb[j] = nyb[j]; }
        }
    }
}

__device__ __forceinline__ void phase_dilated_naive(Frame& F, const Args& a) {
    frame_refresh(F);
    const int gw = F.vcu * NWAVES + F.wave, NGW = F.G * NWAVES, lane = F.lane;
    const bf16_t* P = (const bf16_t*)(F.ws + WS_PROJ); bf16_t* MIX = (bf16_t*)(F.ws + WS_MIX);
    const float* relb = a.in[2];
    for (int task = gw; task < T * 8; task += NGW) {
        const int row = task >> 3, hd = task & 7, t = row & (SEQ - 1);
        float q[64];
        { const u32x4* qp = (const u32x4*)(P + (size_t)row * NPROJ + hd * 64);
#pragma unroll
          for (int i = 0; i < 8; ++i) { const u32x4 w = qp[i]; q[8*i+0] = bf_lo(w.x) * 0.125f; q[8*i+1] = bf_hi(w.x) * 0.125f; q[8*i+2] = bf_lo(w.y) * 0.125f; q[8*i+3] = bf_hi(w.y) * 0.125f;
              q[8*i+4] = bf_lo(w.z) * 0.125f; q[8*i+5] = bf_hi(w.z) * 0.125f; q[8*i+6] = bf_lo(w.w) * 0.125f; q[8*i+7] = bf_hi(w.w) * 0.125f; } }
        float sc[3][3]; float mx = -1e30f;
#pragma unroll
        for (int br = 0; br < 3; ++br) { const int d = (br == 0) ? 1 : (br == 1 ? 4 : 16);
#pragma unroll
            for (int rnd = 0; rnd < 3; ++rnd) { const int j = lane + 64 * rnd; const bool valid = (j <= 128) && (t - j * d >= 0);
                float s = -1e30f;
                if (valid) { const u32x4* kp = (const u32x4*)(P + (size_t)(row - j * d) * NPROJ + 512 + hd * 64); float dot = 0.f;
#pragma unroll
                    for (int i = 0; i < 8; ++i) { const u32x4 w = kp[i]; dot += q[8*i+0] * bf_lo(w.x) + q[8*i+1] * bf_hi(w.x) + q[8*i+2] * bf_lo(w.y) + q[8*i+3] * bf_hi(w.y)
                            + q[8*i+4] * bf_lo(w.z) + q[8*i+5] * bf_hi(w.z) + q[8*i+6] * bf_lo(w.w) + q[8*i+7] * bf_hi(w.w); }
                    s = dot + relb[(int)BUCKET[br][j] * 8 + hd]; }
                sc[br][rnd] = s; mx = fmaxf(mx, s); } }
        mx = wave_max(mx);
        float lsum = 0.f;
#pragma unroll
        for (int br = 0; br < 3; ++br)
#pragma unroll
            for (int rnd = 0; rnd < 3; ++rnd) { const float p = (sc[br][rnd] > -1e29f) ? __expf(sc[br][rnd] - mx) : 0.f; sc[br][rnd] = p; lsum += p; }
        lsum = wave_sum(lsum);
        float acc = 0.f;
#pragma unroll
        for (int br = 0; br < 3; ++br) { const int d = (br == 0) ? 1 : (br == 1 ? 4 : 16);
#pragma unroll
            for (int rnd = 0; rnd < 3; ++rnd) { const int nj = (rnd == 2) ? 1 : 64;
                for (int jj = 0; jj < nj; ++jj) { const int j = jj + 64 * rnd; const float p = __shfl(sc[br][rnd], jj);
                    if (t - j * d >= 0) acc += p * bf1(P[(size_t)(row - j * d) * NPROJ + 1024 + hd * 64 + lane]); } } }
        const float o = acc / lsum;
        MIX[(size_t)row * D + hd * 64 + lane] = (bf16_t)(pk2(o, 0.f) & 0xffffu);
    }
}

typedef short v4i16_t __attribute__((ext_vector_type(4)));
__device__ __forceinline__ v4i16_t tr_read8(const LAS char* p) { return __builtin_amdgcn_ds_read_tr16_b64_v4i16((LAS v4i16_t*)p); }
struct KVRegs { u32x4 k[4]; u32x4 v[4]; };
template <int KSTRIDE>
__device__ __forceinline__ void kv_load(KVRegs& R, const bf16_t* Pb, int koff, int voff, int tb, int lane) {
    const int r32 = lane & 31, hh = lane >> 5;
    int kt = tb + KSTRIDE * r32; kt = kt < 0 ? 0 : (kt > SEQ - 1 ? SEQ - 1 : kt);
    const bf16_t* kp = Pb + (size_t)kt * NPROJ + koff + 8 * hh;
#pragma unroll
    for (int s4 = 0; s4 < 4; ++s4) R.k[s4] = *(const u32x4*)(kp + 16 * s4);
#pragma unroll
    for (int i = 0; i < 4; ++i) { int vt = tb + KSTRIDE * (8 * i + (lane >> 3)); vt = vt < 0 ? 0 : (vt > SEQ - 1 ? SEQ - 1 : vt);
        R.v[i] = *(const u32x4*)(Pb + (size_t)vt * NPROJ + voff + 8 * (lane & 7)); }
}
__device__ __forceinline__ void v_stage(const KVRegs& R, LAS char* vimg, int lane) {
#pragma unroll
    for (int i = 0; i < 4; ++i) { const int key = 8 * i + (lane >> 3), c8 = lane & 7; *(LAS u32x4*)(vimg + (c8 >> 2) * 2048 + key * 64 + (c8 & 3) * 16) = R.v[i]; }
}
__device__ __forceinline__ void pv_mma(f32x16 (&O)[2], const bf16x8 (&pk)[2], const LAS char* vimg, int lane) {
    const int hh = lane >> 5;
    const LAS char* vb = vimg + (4 * hh + ((lane & 15) >> 2)) * 64 + ((lane >> 4) & 1) * 32 + (lane & 3) * 8;
#pragma unroll
    for (int dh = 0; dh < 2; ++dh)
#pragma unroll
        for (int s4 = 0; s4 < 2; ++s4) {
            const v4i16_t lo = tr_read8(vb + dh * 2048 + (16 * s4) * 64), hi = tr_read8(vb + dh * 2048 + (16 * s4 + 8) * 64);
            bf16x8 af; af[0] = lo[0]; af[1] = lo[1]; af[2] = lo[2]; af[3] = lo[3]; af[4] = hi[0]; af[5] = hi[1]; af[6] = hi[2]; af[7] = hi[3];
            O[dh] = __builtin_amdgcn_mfma_f32_32x32x16_bf16(af, pk[s4], O[dh], 0, 0, 0);
        }
}
__device__ __forceinline__ void pack_p(const float (&p)[16], bf16x8 (&pk)[2]) {
#pragma unroll
    for (int s4 = 0; s4 < 2; ++s4) { u32x4 w; w.x = pk2(p[8 * s4 + 0], p[8 * s4 + 1]); w.y = pk2(p[8 * s4 + 2], p[8 * s4 + 3]); w.z = pk2(p[8 * s4 + 4], p[8 * s4 + 5]); w.w = pk2(p[8 * s4 + 6], p[8 * s4 + 7]);
        pk[s4] = __builtin_bit_cast(bf16x8, w); }
}
__device__ __forceinline__ void store_ot(const f32x16 (&O)[2], float sc, bf16_t* orow, int lane) {
    const int hh = lane >> 5;
#pragma unroll
    for (int dh = 0; dh < 2; ++dh)
#pragma unroll
        for (int g = 0; g < 4; ++g) { u32x2 w; w.x = pk2(O[dh][4 * g] * sc, O[dh][4 * g + 1] * sc); w.y = pk2(O[dh][4 * g + 2] * sc, O[dh][4 * g + 3] * sc);
            *(u32x2*)(orow + 32 * dh + 8 * g + 4 * hh) = w; }
}

template <int KSTRIDE, int SHIFT, int NT>
__device__ __forceinline__ void dil_tiles(const bf16_t* Pb, int hd, int tq, int kbase, const LAS float* btab, LAS char* vimg, int lane,
                                          const bf16x8 (&qf)[4], float& m, float& l, f32x16 (&O)[2]) {
    const int hh = lane >> 5;
    int ti0 = 0;
    if (kbase + KSTRIDE * 31 < 0) ti0 = (-(kbase + KSTRIDE * 31) + KSTRIDE * 32 - 1) / (KSTRIDE * 32);
    const int lim = tq < 128 * KSTRIDE ? tq : 128 * KSTRIDE;
    KVRegs C, N;
    kv_load<KSTRIDE>(C, Pb, 512 + hd * 64, 1024 + hd * 64, kbase + KSTRIDE * 32 * ti0, lane);
#pragma unroll 1
    for (int ti = ti0; ti < NT; ++ti) {
        const int tb = kbase + KSTRIDE * 32 * ti;
        if (ti + 1 < NT) kv_load<KSTRIDE>(N, Pb, 512 + hd * 64, 1024 + hd * 64, tb + KSTRIDE * 32, lane);
        f32x16 S;
#pragma unroll
        for (int i = 0; i < 16; ++i) S[i] = 0.f;
#pragma unroll
        for (int s4 = 0; s4 < 4; ++s4) S = __builtin_amdgcn_mfma_f32_32x32x16_bf16(__builtin_bit_cast(bf16x8, C.k[s4]), qf[s4], S, 0, 0, 0);
        v_stage(C, vimg, lane);
        const int dist0 = tq - tb - KSTRIDE * 4 * hh;
        float sv[16]; float smax = -1e30f;
#pragma unroll
        for (int i = 0; i < 16; ++i) { const int dist = dist0 - KSTRIDE * ((i & 3) + 8 * (i >> 2)); const bool valid = (unsigned)dist <= (unsigned)lim;
            const float bias = btab[valid ? (dist >> SHIFT) : 0];
            sv[i] = valid ? (S[i] * 0.125f + bias) : -1e30f; smax = fmaxf(smax, sv[i]); }
        smax = fmaxf(smax, __shfl_xor(smax, 32));
        const float mn = fmaxf(m, smax);
        const float alpha = __expf(m - mn);
        float p[16]; float ps = 0.f;
#pragma unroll
        for (int i = 0; i < 16; ++i) { p[i] = (sv[i] > -1e29f) ? __expf(sv[i] - mn) : 0.f; ps += p[i]; }
        l = l * alpha + ps; m = mn;
#pragma unroll
        for (int dh = 0; dh < 2; ++dh)
#pragma unroll
            for (int i = 0; i < 16; ++i) O[dh][i] *= alpha;
        bf16x8 pk[2]; pack_p(p, pk);
        pv_mma(O, pk, vimg, lane);
        C = N;
    }
}
__device__ __forceinline__ void phase_dilated(Frame& F, const Args& a) {
    frame_refresh(F);
    const int gw = F.vcu * NWAVES + F.wave, NGW = F.G * NWAVES, lane = F.lane;
    const bf16_t* P = (const bf16_t*)(F.ws + WS_PROJ); bf16_t* MIX = (bf16_t*)(F.ws + WS_MIX);
    LAS float* btab = (LAS float*)(F.lds + 32768);
    for (int i = F.tid; i < 8 * 3 * 132; i += NTHREADS) { const int h = i / 396, rem = i % 396, br = rem / 132, sd = rem % 132; btab[i] = a.in[2][(int)BUCKET[br][sd] * 8 + h]; }
    __syncthreads();
    LAS char* vimg = (LAS char*)F.lds + F.wave * 4096;
    for (int wt = gw; wt < 16384; wt += NGW) {
        const int r = wt & 15, T0 = ((wt >> 4) & 7) * 512, hd = (wt >> 7) & 7, b = wt >> 10;
        const int tq = T0 + r + 16 * (lane & 31), hh = lane >> 5;
        const bf16_t* Pb = P + (size_t)b * SEQ * NPROJ;
        bf16x8 qf[4];
#pragma unroll
        for (int s4 = 0; s4 < 4; ++s4) qf[s4] = *(const bf16x8*)(Pb + (size_t)tq * NPROJ + hd * 64 + 16 * s4 + 8 * hh);
        float m = -1e30f, l = 0.f; f32x16 O[2];
#pragma unroll
        for (int i = 0; i < 16; ++i) { O[0][i] = 0.f; O[1][i] = 0.f; }
        dil_tiles<1, 0, 20>(Pb, hd, tq, T0 + r - 128, btab + (hd * 3 + 0) * 132, vimg, lane, qf, m, l, O);
        dil_tiles<4, 2, 8>(Pb, hd, tq, T0 + r - 512, btab + (hd * 3 + 1) * 132, vimg, lane, qf, m, l, O);
        dil_tiles<16, 4, 5>(Pb, hd, tq, T0 + r - 2048, btab + (hd * 3 + 2) * 132, vimg, lane, qf, m, l, O);
        const float lt = l + __shfl_xor(l, 32);
        store_ot(O, 1.f / lt, MIX + ((size_t)b * SEQ + tq) * D + hd * 64, lane);
    }
}

constexpr int DK_PITCH = 144, DL_K = 0, DL_V = 384 * DK_PITCH, DL_VH = 384 * 64, DL_BT = DL_V + 2 * DL_VH;
struct DilUnit { int b, hd, p, d, sh, res, S0; };
__device__ __forceinline__ void dil_decode(int u, DilUnit& U) {
    U.p = u >> 11; const int v = u & 2047, idx = v & 15; U.hd = (v >> 4) & 7; U.b = v >> 7;
    U.sh = 2 * U.p; U.d = 1 << U.sh;
    const int lb = 4 - U.sh;
    U.res = idx >> lb; U.S0 = (idx & ((1 << lb) - 1)) * 256;
}
struct DilRegs { u32x4 k[6]; u32x4 v[6]; bf16x8 q[4]; };
__device__ __forceinline__ void dil_load(DilRegs& R, const bf16_t* P, const DilUnit& U, int tid) {
    const bf16_t* Pb = P + (size_t)U.b * SEQ * NPROJ;
#pragma unroll
    for (int i = 0; i < 6; ++i) { const int q = tid + 512 * i, key = q >> 3, c8 = q & 7; int sub = U.S0 - 128 + key; sub = sub < 0 ? 0 : sub;
        const bf16_t* rp = Pb + (size_t)(U.res + (sub << U.sh)) * NPROJ + U.hd * 64 + 8 * c8;
        R.k[i] = *(const u32x4*)(rp + 512); R.v[i] = *(const u32x4*)(rp + 1024); }
    const int lane = tid & 63, w = tid >> 6, qs = U.S0 + 32 * w + (lane & 31);
    const bf16_t* qp = Pb + (size_t)(U.res + (qs << U.sh)) * NPROJ + U.hd * 64 + 8 * (lane >> 5);
#pragma unroll
    for (int s4 = 0; s4 < 4; ++s4) R.q[s4] = *(const bf16x8*)(qp + 16 * s4);
}
__device__ __forceinline__ void dil_stage(const DilRegs& R, LAS char* lds, int tid) {
#pragma unroll
    for (int i = 0; i < 6; ++i) { const int q = tid + 512 * i, key = q >> 3, c8 = q & 7;
        *(LAS u32x4*)(lds + DL_K + key * DK_PITCH + c8 * 16) = R.k[i];
        *(LAS u32x4*)(lds + DL_V + (c8 >> 2) * DL_VH + key * 64 + (c8 & 3) * 16) = R.v[i]; }
}
__device__ __forceinline__ void phase_dilated2(Frame& F, const Args& a) {
    frame_refresh(F);
    const int tid = F.tid, lane = F.lane, wave = F.wave, r32 = lane & 31, hh = lane >> 5;
    const bf16_t* P = (const bf16_t*)(F.ws + WS_PROJ);
    bf16_t* OP0 = (bf16_t*)(F.ws + WS_MIX); bf16_t* OP12 = (bf16_t*)(F.ws + WS_HBUF); float* LSE = (float*)(F.ws + WS_LIST);
    LAS char* lds = (LAS char*)F.lds;
    LAS float* btab = (LAS float*)(lds + DL_BT);
    for (int i = tid; i < 8 * 3 * 132; i += NTHREADS) { const int h = i / 396, rem = i % 396, br = rem / 132, sd = rem % 132; btab[i] = a.in[2][(int)BUCKET[br][sd] * 8 + h]; }
    DilRegs R; DilUnit U, NU;
    int u = F.vcu;
    if (u < 6144) { dil_decode(u, U); dil_load(R, P, U, tid); }
    for (; u < 6144; u += F.G) {
        __syncthreads();
        dil_stage(R, lds, tid);
        bf16x8 qf[4];
#pragma unroll
        for (int s4 = 0; s4 < 4; ++s4) qf[s4] = R.q[s4];
        __syncthreads();
        const int un = u + F.G;
        if (un < 6144) { dil_decode(un, NU); dil_load(R, P, NU, tid); }
        const int qs = U.S0 + 32 * wave + r32;
        const int lim = qs < 128 ? qs : 128;
        const LAS float* bt = btab + (U.hd * 3 + U.p) * 132;
        float m = -1e30f, l = 0.f; f32x16 O[2];
#pragma unroll
        for (int i = 0; i < 16; ++i) { O[0][i] = 0.f; O[1][i] = 0.f; }
#pragma unroll 1
        for (int j = 0; j < 5; ++j) {
            const int kb = 32 * (wave + j);
            if (U.S0 - 128 + kb + 31 < 0) continue;
            f32x16 S;
#pragma unroll
            for (int i = 0; i < 16; ++i) S[i] = 0.f;
            const LAS char* kp = lds + DL_K + (kb + r32) * DK_PITCH + 16 * hh;
#pragma unroll
            for (int s4 = 0; s4 < 4; ++s4) S = __builtin_amdgcn_mfma_f32_32x32x16_bf16(*(const LAS bf16x8*)(kp + 32 * s4), qf[s4], S, 0, 0, 0);
            const int dist0 = 128 + r32 - 32 * j - 4 * hh;
            float sv[16]; float smax = -1e30f;
            float bv[16];
#pragma unroll
            for (int i = 0; i < 16; ++i) { const unsigned ud = (unsigned)(dist0 - ((i & 3) + 8 * (i >> 2))); bv[i] = bt[ud < 132u ? ud : 131u]; }
#pragma unroll
            for (int i = 0; i < 16; ++i) { const int dist = dist0 - ((i & 3) + 8 * (i >> 2)); const bool valid = (unsigned)dist <= (unsigned)lim;
                sv[i] = valid ? (S[i] * 0.125f + bv[i]) : -1e30f; smax = fmaxf(smax, sv[i]); }
            smax = fmaxf(smax, __shfl_xor(smax, 32));
            const float mn = fmaxf(m, smax);
            const float alpha = __expf(m - mn);
            float p[16]; float ps = 0.f;
#pragma unroll
            for (int i = 0; i < 16; ++i) { p[i] = (sv[i] > -1e29f) ? __expf(sv[i] - mn) : 0.f; ps += p[i]; }
            l = l * alpha + ps; m = mn;
#pragma unroll
            for (int dh = 0; dh < 2; ++dh)
#pragma unroll
                for (int i = 0; i < 16; ++i) O[dh][i] *= alpha;
            bf16x8 pk[2]; pack_p(p, pk);
            const LAS char* vb = lds + DL_V + (kb + 4 * hh + ((lane & 15) >> 2)) * 64 + ((lane >> 4) & 1) * 32 + (lane & 3) * 8;
#pragma unroll
            for (int dh = 0; dh < 2; ++dh)
#pragma unroll
                for (int s4 = 0; s4 < 2; ++s4) {
                    const v4i16_t lo = tr_read8(vb + dh * DL_VH + (16 * s4) * 64), hi = tr_read8(vb + dh * DL_VH + (16 * s4 + 8) * 64);
                    bf16x8 af; af[0] = lo[0]; af[1] = lo[1]; af[2] = lo[2]; af[3] = lo[3]; af[4] = hi[0]; af[5] = hi[1]; af[6] = hi[2]; af[7] = hi[3];
                    O[dh] = __builtin_amdgcn_mfma_f32_32x32x16_bf16(af, pk[s4], O[dh], 0, 0, 0);
                }
        }
        const float lt = l + __shfl_xor(l, 32);
        const size_t row = (size_t)U.b * SEQ + U.res + ((size_t)qs << U.sh);
        bf16_t* orow = (U.p == 0) ? (OP0 + row * D + U.hd * 64) : (OP12 + ((size_t)(U.p - 1) * T + row) * 512 + U.hd * 64);
        store_ot(O, 1.f / lt, orow, lane);
        if (hh == 0) LSE[((size_t)U.p * T + row) * 8 + U.hd] = m + __logf(lt);
        U = NU;
    }
}
__device__ __forceinline__ void phase_dil_combine(Frame& F) {
    frame_refresh(F);
    const int gw = F.vcu * NWAVES + F.wave, NGW = F.G * NWAVES, lane = F.lane;
    bf16_t* OP0 = (bf16_t*)(F.ws + WS_MIX); const bf16_t* OP12 = (const bf16_t*)(F.ws + WS_HBUF); const float* LSE = (const float*)(F.ws + WS_LIST);
    for (int blk = gw; blk < T / 32; blk += NGW) {
#pragma unroll 1
        for (int r = 0; r < 32; r += 2) {
            u32x4 o[2][3]; float ls[2][3];
#pragma unroll
            for (int q = 0; q < 2; ++q) { const size_t row = (size_t)blk * 32 + r + q;
                o[q][0] = *(const u32x4*)(OP0 + row * D + 8 * lane); o[q][1] = *(const u32x4*)(OP12 + row * 512 + 8 * lane); o[q][2] = *(const u32x4*)(OP12 + ((size_t)T + row) * 512 + 8 * lane);
#pragma unroll
                for (int p = 0; p < 3; ++p) ls[q][p] = LSE[((size_t)p * T + row) * 8 + (lane >> 3)]; }
#pragma unroll
            for (int q = 0; q < 2; ++q) { const size_t row = (size_t)blk * 32 + r + q;
                const float M = fmaxf(ls[q][0], fmaxf(ls[q][1], ls[q][2]));
                float w0 = __expf(ls[q][0] - M), w1 = __expf(ls[q][1] - M), w2 = __expf(ls[q][2] - M); const float inv = 1.f / (w0 + w1 + w2); w0 *= inv; w1 *= inv; w2 *= inv;
                u32x4 res;
#pragma unroll
                for (int e = 0; e < 4; ++e) { const unsigned a0 = o[q][0][e], a1 = o[q][1][e], a2 = o[q][2][e];
                    res[e] = pk2(bf_lo(a0) * w0 + bf_lo(a1) * w1 + bf_lo(a2) * w2, bf_hi(a0) * w0 + bf_hi(a1) * w1 + bf_hi(a2) * w2); }
                *(u32x4*)(OP0 + row * D + 8 * lane) = res; }
        }
    }
}

__device__ __forceinline__ void phase_stick(Frame& F) {
    frame_refresh(F);
    const int gw = F.vcu * NWAVES + F.wave, NGW = F.G * NWAVES, lane = F.lane;
    const bf16_t* P = (const bf16_t*)(F.ws + WS_PROJ); bf16_t* MIX = (bf16_t*)(F.ws + WS_MIX);
    LAS char* vimg = (LAS char*)F.lds + F.wave * 4096;
    for (int wt = gw; wt < 16384; wt += NGW) {
        const int qt = wt & 127, hd = (wt >> 7) & 7, b = wt >> 10;
        const int tq = qt * 32 + (lane & 31), hh = lane >> 5;
        const bf16_t* Pb = P + (size_t)b * SEQ * NPROJ;
        bf16x8 qf[4];
#pragma unroll
        for (int s4 = 0; s4 < 4; ++s4) qf[s4] = *(const bf16x8*)(Pb + (size_t)tq * NPROJ + 1024 + hd * 64 + 16 * s4 + 8 * hh);
        float carry = 0.f; f32x16 O[2];
#pragma unroll
        for (int i = 0; i < 16; ++i) { O[0][i] = 0.f; O[1][i] = 0.f; }
        KVRegs C, N;
        kv_load<1>(C, Pb, 1536 + hd * 64, 2048 + hd * 64, qt * 32, lane);
#pragma unroll 1
        for (int kt = qt; kt >= 0; --kt) {
            const int tb = kt * 32;
            if (kt > 0) kv_load<1>(N, Pb, 1536 + hd * 64, 2048 + hd * 64, tb - 32, lane);
            f32x16 S;
#pragma unroll
            for (int i = 0; i < 16; ++i) S[i] = 0.f;
#pragma unroll
            for (int s4 = 0; s4 < 4; ++s4) S = __builtin_amdgcn_mfma_f32_32x32x16_bf16(__builtin_bit_cast(bf16x8, C.k[s4]), qf[s4], S, 0, 0, 0);
            v_stage(C, vimg, lane);
            const int dist0 = tq - tb - 4 * hh;
            float lk[16], ls[16];
#pragma unroll
            for (int i = 0; i < 16; ++i) { const int dist = dist0 - ((i & 3) + 8 * (i >> 2)); const bool valid = dist > 0;
                const float z = S[i] * 0.125f;
                const float sp = fmaxf(z, 0.f) + __logf(1.f + __expf(-fabsf(z)));
                lk[i] = valid ? -sp : 0.f; ls[i] = valid ? (z - sp) : -1e30f; }
            float G[4], PG[4];
#pragma unroll
            for (int g = 0; g < 4; ++g) { G[g] = (lk[4 * g] + lk[4 * g + 1]) + (lk[4 * g + 2] + lk[4 * g + 3]); PG[g] = __shfl_xor(G[g], 32); }
            float after[4];
            { float run = 0.f;
#pragma unroll
              for (int g = 3; g >= 0; --g) { after[g] = run + (hh == 0 ? PG[g] : 0.f); run += G[g] + PG[g]; }
              float p[16];
#pragma unroll
              for (int g = 0; g < 4; ++g) { const float b3 = carry + after[g], b2 = b3 + lk[4 * g + 3], b1 = b2 + lk[4 * g + 2], b0 = b1 + lk[4 * g + 1];
                  p[4 * g + 3] = __expf(ls[4 * g + 3] + b3); p[4 * g + 2] = __expf(ls[4 * g + 2] + b2); p[4 * g + 1] = __expf(ls[4 * g + 1] + b1); p[4 * g] = __expf(ls[4 * g] + b0); }
              carry += run;
              bf16x8 pk[2]; pack_p(p, pk);
              pv_mma(O, pk, vimg, lane);
            }
            if (__all(carry < -110.f)) break;
            C = N;
        }
        store_ot(O, 1.f, MIX + ((size_t)b * SEQ + tq) * D + 512 + hd * 64, lane);
    }
}

__device__ __forceinline__ void phase_gmlp(Frame& F, const Args& a, int j2) {
    frame_refresh(F);
    const bf16_t* P = (const bf16_t*)(F.ws + WS_PROJ); bf16_t* MIX = (bf16_t*)(F.ws + WS_MIX);
    const bf16_t* WSM = (const bf16_t*)(F.ws + WS_WS) + (size_t)j2 * 4 * 128 * 128;
    const float* lng = a.in[9] + (size_t)j2 * 512; const float* lnb = a.in[10] + (size_t)j2 * 512; const float* bs = a.in[12] + (size_t)j2 * 4 * 128;
    constexpr int VP = 136;
    LAS bf16_t* vT = (LAS bf16_t*)F.lds;
    const int lane = F.lane, wave = F.wave;
    for (int ch = F.vcu; ch < T / 128; ch += F.G) {
        const int row0 = ch * 128;
        float lg[8], lb[8];
#pragma unroll
        for (int i = 0; i < 8; ++i) { lg[i] = lng[8 * lane + i]; lb[i] = lnb[8 * lane + i]; }
        for (int tt = 0; tt < 16; ++tt) { const int tl = wave * 16 + tt;
            const u32x4 w = *(const u32x4*)(P + (size_t)(row0 + tl) * NPROJ + 2048 + 8 * lane);
            float g[8]; g[0] = gelu_tanh(bf_lo(w.x)); g[1] = gelu_tanh(bf_hi(w.x)); g[2] = gelu_tanh(bf_lo(w.y)); g[3] = gelu_tanh(bf_hi(w.y));
            g[4] = gelu_tanh(bf_lo(w.z)); g[5] = gelu_tanh(bf_hi(w.z)); g[6] = gelu_tanh(bf_lo(w.w)); g[7] = gelu_tanh(bf_hi(w.w));
            float s = 0.f;
#pragma unroll
            for (int i = 0; i < 8; ++i) s += g[i];
            const float mu = wave_sum(s) * (1.f / 512.f); float s2 = 0.f;
#pragma unroll
            for (int i = 0; i < 8; ++i) { g[i] -= mu; s2 += g[i] * g[i]; }
            const float rstd = rsqrtf(wave_sum(s2) * (1.f / 512.f) + EPS);
#pragma unroll
            for (int i = 0; i < 8; ++i) { const float v = g[i] * rstd * lg[i] + lb[i]; vT[(8 * lane + i) * VP + tl] = (bf16_t)(pk2(v, 0.f) & 0xffffu); }
        }
        __syncthreads();
        const int g = wave >> 1, r32 = lane & 31, hh = lane >> 5;
        for (int ti = 0; ti < 2; ++ti) { const int tm = (wave & 1) + 2 * ti;
            f32x16 accv[4];
#pragma unroll
            for (int c4 = 0; c4 < 4; ++c4)
#pragma unroll
                for (int i = 0; i < 16; ++i) accv[c4][i] = 0.f;
            const int nks = 2 * (tm + 1);
            for (int ks = 0; ks < nks; ++ks) {
                const bf16x8 af = *(const bf16x8*)(WSM + ((size_t)g * 128 + tm * 32 + r32) * 128 + ks * 16 + 8 * hh);
#pragma unroll
                for (int c4 = 0; c4 < 4; ++c4) { const bf16x8 bfv = *(const LAS bf16x8*)(vT + (g * 128 + c4 * 32 + r32) * VP + ks * 16 + 8 * hh);
                    accv[c4] = __builtin_amdgcn_mfma_f32_32x32x16_bf16(af, bfv, accv[c4], 0, 0, 0); }
            }
#pragma unroll
            for (int i = 0; i < 16; ++i) { const int tl = tm * 32 + (i & 3) + 8 * (i >> 2) + 4 * hh; const float bsv = bs[g * 128 + tl];
#pragma unroll
                for (int c4 = 0; c4 < 4; ++c4) { const int chn = g * 128 + c4 * 32 + r32;
                    const float u = gelu_tanh(bf1(P[(size_t)(row0 + tl) * NPROJ + 1536 + chn]));
                    const float o = u * (accv[c4][i] + bsv);
                    MIX[(size_t)(row0 + tl) * D + 512 + chn] = (bf16_t)(pk2(o, 0.f) & 0xffffu); } }
        }
        __syncthreads();
    }
}

template <bool OUT>
__device__ __forceinline__ void conv_chunk(const bf16_t* P, int row0, int tseq0, int tl0, int c0, float (&x0)[32], float (&x1)[32], const float (&w0)[31], const float (&w1)[31], float bd0, float bd1, LAS float* tile) {
#pragma unroll
    for (int i = 0; i < 32; ++i) { const int tl = tl0 + i;
        float h0 = 0.f, h1 = 0.f;
        if (tseq0 + tl >= 0) { const bf16_t* pr = P + (size_t)(row0 + tl) * NPROJ; const unsigned av = *(const unsigned*)(pr + c0), gv = *(const unsigned*)(pr + 512 + c0);
            h0 = bf_lo(av) * sigmoid_f(bf_lo(gv)); h1 = bf_hi(av) * sigmoid_f(bf_hi(gv)); }
        x0[i] = h0; x1[i] = h1;
        if (OUT) { float o0 = bd0, o1 = bd1;
#pragma unroll
            for (int j = 0; j < 31; ++j) { o0 += w0[j] * x0[(i + 2 + j) & 31]; o1 += w1[j] * x1[(i + 2 + j) & 31]; }
            *(LAS f32x2*)(tile + i * 512 + c0) = (f32x2){o0, o1}; }
    }
}
__device__ __forceinline__ void phase_conv(Frame& F, const Args& a, int j2) {
    frame_refresh(F);
    const bf16_t* P = (const bf16_t*)(F.ws + WS_PROJ); bf16_t* MIX = (bf16_t*)(F.ws + WS_MIX);
    const float* wdw = a.in[15] + (size_t)j2 * 31 * 512; const float* bdw = a.in[16] + (size_t)j2 * 512;
    const float* lng = a.in[17] + (size_t)j2 * 512; const float* lnb = a.in[18] + (size_t)j2 * 512;
    const int half = F.tid >> 8, ht = F.tid & 255, c0 = 2 * ht;
    LAS float* tile = (LAS float*)F.lds + half * (32 * 512);
    float w0[31], w1[31];
#pragma unroll
    for (int j = 0; j < 31; ++j) { w0[j] = wdw[j * 512 + c0]; w1[j] = wdw[j * 512 + c0 + 1]; }
    const float bd0 = bdw[c0], bd1 = bdw[c0 + 1];
    const int wih = F.wave & 3;
    for (int s0 = F.vcu * 2; s0 < T / 128; s0 += F.G * 2) {
        const int seg = s0 + half;
        const int row0 = seg * 128, tseq0 = row0 & (SEQ - 1);
        float x0[32], x1[32];
        conv_chunk<false>(P, row0, tseq0, -32, c0, x0, x1, w0, w1, bd0, bd1, tile);
#pragma unroll 1
        for (int cb = 0; cb < 4; ++cb) {
            conv_chunk<true>(P, row0, tseq0, cb * 32, c0, x0, x1, w0, w1, bd0, bd1, tile);
            __syncthreads();
            for (int rr = wih; rr < 32; rr += 4) { const LAS float* tr = tile + rr * 512 + 8 * F.lane; float v[8]; float s = 0.f;
#pragma unroll
                for (int e = 0; e < 8; ++e) { v[e] = tr[e]; s += v[e]; }
                const float mu = wave_sum(s) * (1.f / 512.f); float s2 = 0.f;
#pragma unroll
                for (int e = 0; e < 8; ++e) { v[e] -= mu; s2 += v[e] * v[e]; }
                const float rstd = rsqrtf(wave_sum(s2) * (1.f / 512.f) + EPS);
                float o[8];
#pragma unroll
                for (int e = 0; e < 8; ++e) o[e] = silu_f(v[e] * rstd * lng[8 * F.lane + e] + lnb[8 * F.lane + e]);
                u32x4 ow; ow.x = pk2(o[0], o[1]); ow.y = pk2(o[2], o[3]); ow.z = pk2(o[4], o[5]); ow.w = pk2(o[6], o[7]);
                *(u32x4*)(MIX + (size_t)(row0 + cb * 32 + rr) * D + 8 * F.lane) = ow; }
            __syncthreads();
        }
    }
}

__device__ __forceinline__ void phase_stick_naive(Frame& F) {
    frame_refresh(F);
    const int gw = F.vcu * NWAVES + F.wave, NGW = F.G * NWAVES, lane = F.lane;
    const bf16_t* P = (const bf16_t*)(F.ws + WS_PROJ); bf16_t* MIX = (bf16_t*)(F.ws + WS_MIX);
    for (int task = gw; task < T * 8; task += NGW) {
        const int row = task >> 3, hd = task & 7, t = row & (SEQ - 1);
        float q[64];
        { const u32x4* qp = (const u32x4*)(P + (size_t)row * NPROJ + 1024 + hd * 64);
#pragma unroll
          for (int i = 0; i < 8; ++i) { const u32x4 w = qp[i]; q[8*i+0] = bf_lo(w.x) * 0.125f; q[8*i+1] = bf_hi(w.x) * 0.125f; q[8*i+2] = bf_lo(w.y) * 0.125f; q[8*i+3] = bf_hi(w.y) * 0.125f;
              q[8*i+4] = bf_lo(w.z) * 0.125f; q[8*i+5] = bf_hi(w.z) * 0.125f; q[8*i+6] = bf_lo(w.w) * 0.125f; q[8*i+7] = bf_hi(w.w) * 0.125f; } }
        float acc = 0.f, carry = 0.f;
        for (int r0 = 0; r0 < t; r0 += 64) {
            const int dist = r0 + lane + 1; const bool valid = dist <= t;
            float lk = 0.f, ls = 0.f;
            if (valid) { const u32x4* kp = (const u32x4*)(P + (size_t)(row - dist) * NPROJ + 1536 + hd * 64); float z = 0.f;
#pragma unroll
                for (int i = 0; i < 8; ++i) { const u32x4 w = kp[i]; z += q[8*i+0] * bf_lo(w.x) + q[8*i+1] * bf_hi(w.x) + q[8*i+2] * bf_lo(w.y) + q[8*i+3] * bf_hi(w.y)
                        + q[8*i+4] * bf_lo(w.z) + q[8*i+5] * bf_hi(w.z) + q[8*i+6] * bf_lo(w.w) + q[8*i+7] * bf_hi(w.w); }
                const float sp = fmaxf(z, 0.f) + __logf(1.f + __expf(-fabsf(z)));
                lk = -sp; ls = z - sp; }
            float incl = lk;
#pragma unroll
            for (int o = 1; o < 64; o <<= 1) { const float n = __shfl_up(incl, o); if (lane >= o) incl += n; }
            const float between = carry + incl - lk;
            const float att = valid ? __expf(ls + between) : 0.f;
            carry += __shfl(incl, 63);
            const int nj = (t - r0) < 64 ? (t - r0) : 64;
            for (int jj = 0; jj < nj; ++jj) { const float p = __shfl(att, jj); acc += p * bf1(P[(size_t)(row - (r0 + jj + 1)) * NPROJ + 2048 + hd * 64 + lane]); }
            if (carry < -110.f) break;
        }
        MIX[(size_t)row * D + 512 + hd * 64 + lane] = (bf16_t)(pk2(acc, 0.f) & 0xffffu);
    }
}

__device__ __forceinline__ void phase_router(Frame& F, const Args& a, int l, const float* xin) {
    frame_refresh(F);
    LAS float* wl = (LAS float*)F.lds;
    LAS int* cls_s = (LAS int*)(F.lds + 81920);
    LAS int* pos_s = cls_s + 256;
    LAS int* lcnt = pos_s + 256;
    LAS int* lbase = lcnt + 32;
    const float* wg = a.in[19] + (size_t)l * 1024 * 4; const float* wrt = a.in[21] + (size_t)l * 4 * 1024 * 4;
    for (int i = F.tid; i < 20 * 1024; i += NTHREADS) { const int c = i >> 10, k = i & 1023; wl[i] = (c < 4) ? wg[k * 4 + c] : wrt[((size_t)((c - 4) >> 2) * 1024 + k) * 4 + ((c - 4) & 3)]; }
    __syncthreads();
    const float* MOD = (const float*)(F.ws + WS_MOD) + (size_t)l * 16 * 6144;
    const float* gam = a.in[4] + (size_t)l * D; const float* bg = a.in[20] + l * 4; const float* br = a.in[22] + l * 16;
    bf16_t* HB = (bf16_t*)(F.ws + WS_HBUF); float* RW = (float*)(F.ws + WS_RW); int* SINFO = (int*)(F.ws + WS_LIST);
    unsigned* cnt = (unsigned*)(F.ws + WS_CTL) + CW_CNT + l * NCLS * 64;
    const float* x = xin;
    const f32x4 one4[4] = {{1.f, 1.f, 1.f, 1.f}, {1.f, 1.f, 1.f, 1.f}, {1.f, 1.f, 1.f, 1.f}, {1.f, 1.f, 1.f, 1.f}};
    const int lane = F.lane;
    for (int rb = F.vcu; rb < T / 256; rb += F.G) {
        if (F.tid < 32) lcnt[F.tid] = 0;
        __syncthreads();
        const int rowb = rb * 256 + F.wave * 32, b = rowb >> 12;
        f32x4 gp[4], shv[4]; load_mod(gam, MOD + (size_t)b * 6144 + 3072, MOD + (size_t)b * 6144 + 4096, lane, gp, shv);
        f32x4 h0[4], h1[4], n0[4], n1[4]; u32x2 d0[4], d1[4], nd0[4], nd1[4];
        load_row(x + (size_t)rowb * D, lane, h0); load_row(x + (size_t)(rowb + 1) * D, lane, h1);
        load_y(HB + (size_t)rowb * D, lane, d0); load_y(HB + (size_t)(rowb + 1) * D, lane, d1);
#pragma unroll 1
        for (int it = 0; it < 16; ++it) {
            const int rl0 = F.wave * 32 + it * 2, row0 = rb * 256 + rl0;
            if (it + 1 < 16) { load_row(x + (size_t)(row0 + 2) * D, lane, n0); load_row(x + (size_t)(row0 + 3) * D, lane, n1);
                load_y(HB + (size_t)(row0 + 2) * D, lane, nd0); load_y(HB + (size_t)(row0 + 3) * D, lane, nd1); }
            add_y(h0, d0, one4); add_y(h1, d1, one4);
            store_row_f32(a.out + (size_t)row0 * D, lane, h0); store_row_f32(a.out + (size_t)(row0 + 1) * D, lane, h1);
            const float r0 = row_rstd(h0), r1 = row_rstd(h1);
#pragma unroll
            for (int j = 0; j < 4; ++j) { h0[j] = h0[j] * r0 * gp[j] + shv[j]; h1[j] = h1[j] * r1 * gp[j] + shv[j]; }
            store_row_bf16(HB + (size_t)row0 * D, lane, h0); store_row_bf16(HB + (size_t)(row0 + 1) * D, lane, h1);
            float lg[2][20];
#pragma unroll
            for (int c = 0; c < 20; ++c) { float s0 = 0.f, s1 = 0.f;
#pragma unroll
                for (int j = 0; j < 4; ++j) { const f32x4 w = *(const LAS f32x4*)(wl + c * 1024 + 4 * lane + 256 * j);
                    s0 += h0[j].x * w.x + h0[j].y * w.y + h0[j].z * w.z + h0[j].w * w.w;
                    s1 += h1[j].x * w.x + h1[j].y * w.y + h1[j].z * w.z + h1[j].w * w.w; }
                lg[0][c] = wave_sum(s0); lg[1][c] = wave_sum(s1); }
#pragma unroll
            for (int r = 0; r < 2; ++r) {
                float gl[4];
#pragma unroll
                for (int i = 0; i < 4; ++i) gl[i] = lg[r][i] + bg[i];
                int gi = 0; float gm = gl[0];
#pragma unroll
                for (int i = 1; i < 4; ++i) if (gl[i] > gm) { gm = gl[i]; gi = i; }
                float gs = 0.f;
#pragma unroll
                for (int i = 0; i < 4; ++i) gs += __expf(gl[i] - gm);
                const float gwt = 1.f / gs;
                float el[4];
#pragma unroll
                for (int e = 0; e < 4; ++e) { const float v = (gi == 0) ? lg[r][4 + e] : (gi == 1) ? lg[r][8 + e] : (gi == 2) ? lg[r][12 + e] : lg[r][16 + e]; el[e] = v + br[gi * 4 + e]; }
                int ea = 0; float va = el[0];
#pragma unroll
                for (int e = 1; e < 4; ++e) if (el[e] > va) { va = el[e]; ea = e; }
                int eb = -1; float vb = -3.0e38f;
#pragma unroll
                for (int e = 0; e < 4; ++e) if (e != ea && el[e] > vb) { vb = el[e]; eb = e; }
                const float wa = 1.f / (1.f + __expf(vb - va)), wb = 1.f - wa;
                const int lo = ea < eb ? ea : eb, hi = ea < eb ? eb : ea;
                const int pidx = (lo == 0) ? hi - 1 : (lo == 1 ? hi + 1 : 5);
                const int cls = gi * 6 + pidx;
                const float wlo = gwt * (ea == lo ? wa : wb), whi = gwt * (ea == lo ? wb : wa);
                if (lane == 0) { cls_s[rl0 + r] = cls; *(f32x2*)(RW + (size_t)(row0 + r) * 2) = (f32x2){wlo, whi}; }
            }
#pragma unroll
            for (int j = 0; j < 4; ++j) { h0[j] = n0[j]; h1[j] = n1[j]; d0[j] = nd0[j]; d1[j] = nd1[j]; }
        }
        __syncthreads();
        if (F.tid < 256) pos_s[F.tid] = atomicAdd((int*)&lcnt[cls_s[F.tid]], 1);
        __syncthreads();
        if (F.tid < NCLS) lbase[F.tid] = (int)__hip_atomic_fetch_add(cnt + F.tid * 64, (unsigned)lcnt[F.tid], __ATOMIC_RELAXED, __HIP_MEMORY_SCOPE_AGENT);
        __syncthreads();
        if (F.tid < 256) { const int c = cls_s[F.tid]; SINFO[rb * 256 + F.tid] = (c << 16) | (lbase[c] + pos_s[F.tid]); }
        __syncthreads();
    }
}

__device__ __forceinline__ void build_moe_table(Frame& F, int l) {
    frame_refresh(F);
    LAS int* tbl = (LAS int*)(F.lds + 131072);
    unsigned* cnt = (unsigned*)(F.ws + WS_CTL) + CW_CNT + l * NCLS * 64;
    if (F.tid == 0) { int acc = 0;
        for (int c = 0; c < NCLS; ++c) { const int n = (int)__hip_atomic_load(cnt + c * 64, __ATOMIC_RELAXED, __HIP_MEMORY_SCOPE_AGENT); tbl[c] = acc; tbl[32 + c] = n; acc += (n + 255) >> 8; }
        tbl[24] = acc; }
    __syncthreads();
}

__device__ __forceinline__ void phase_permute(Frame& F) {
    const LAS int* tbl = (const LAS int*)(F.lds + 131072);
    const int gw = F.vcu * NWAVES + F.wave, NGW = F.G * NWAVES, lane = F.lane;
    const int* SINFO = (const int*)(F.ws + WS_LIST); int* STOK = (int*)(F.ws + WS_LIST + 1 * MiB); float* RWS = (float*)(F.ws + WS_LIST + 2 * MiB);
    const float* RW = (const float*)(F.ws + WS_RW); int* SLOTMAP = (int*)(F.ws + WS_LIST + 3 * MiB);
    const bf16_t* HB = (const bf16_t*)(F.ws + WS_HBUF); bf16_t* HS = (bf16_t*)(F.ws + WS_HSORT);
    for (int blk = gw; blk < T / 32; blk += NGW) {
        const int row0 = blk * 32;
        int slotv = 0;
        if (lane < 32) { const int si = SINFO[row0 + lane]; slotv = tbl[si >> 16] * 256 + (si & 0xffff);
            SLOTMAP[row0 + lane] = slotv; STOK[slotv] = row0 + lane; *(f32x2*)(RWS + (size_t)slotv * 2) = *(const f32x2*)(RW + (size_t)(row0 + lane) * 2); }
#pragma unroll 1
        for (int r = 0; r < 32; r += 4) {
            u32x4 v[4][2];
#pragma unroll
            for (int u = 0; u < 4; ++u) { const u32x4* src = (const u32x4*)(HB + (size_t)(row0 + r + u) * D) + lane; v[u][0] = src[0]; v[u][1] = src[64]; }
#pragma unroll
            for (int u = 0; u < 4; ++u) { const int slot = __builtin_amdgcn_readlane(slotv, r + u); u32x4* dst = (u32x4*)(HS + (size_t)slot * D) + lane; dst[0] = v[u][0]; dst[64] = v[u][1]; }
        }
    }
}

__device__ __forceinline__ void phase_final(Frame& F, const Args& a) {
    frame_refresh(F);
    const int gw = F.vcu * NWAVES + F.wave, NGW = F.G * NWAVES, lane = F.lane;
    const float* MOD = (const float*)(F.ws + WS_MOD) + (size_t)3 * 16 * 6144;
    const bf16_t* Y2 = (const bf16_t*)(F.ws + WS_HSORT); const int* SLOTMAP = (const int*)(F.ws + WS_LIST + 3 * MiB);
    f32x4 g4[4];
#pragma unroll
    for (int j = 0; j < 4; ++j) g4[j] = ((const f32x4*)a.in[26])[lane + 64 * j];
    for (int blk = gw; blk < T / 32; blk += NGW) {
        const int row0 = blk * 32, b = row0 >> 12;
        f32x4 g2[4];
#pragma unroll
        for (int j = 0; j < 4; ++j) g2[j] = ((const f32x4*)(MOD + (size_t)b * 6144 + 5120))[lane + 64 * j];
        const int slotv = SLOTMAP[row0 + (lane & 31)];
        f32x4 xa[4], xb[4], na[4], nb[4]; u32x2 ya[4], yb[4], nya[4], nyb[4];
        load_row(a.out + (size_t)row0 * D, lane, xa); load_row(a.out + (size_t)(row0 + 1) * D, lane, xb);
        load_y(Y2 + (size_t)__builtin_amdgcn_readlane(slotv, 0) * D, lane, ya); load_y(Y2 + (size_t)__builtin_amdgcn_readlane(slotv, 1) * D, lane, yb);
#pragma unroll 1
        for (int r = 0; r < 32; r += 2) {
            if (r + 2 < 32) { load_row(a.out + (size_t)(row0 + r + 2) * D, lane, na); load_row(a.out + (size_t)(row0 + r + 3) * D, lane, nb);
                load_y(Y2 + (size_t)__builtin_amdgcn_readlane(slotv, r + 2) * D, lane, nya); load_y(Y2 + (size_t)__builtin_amdgcn_readlane(slotv, r + 3) * D, lane, nyb); }
            add_y(xa, ya, g2); add_y(xb, yb, g2);
            const float ra = row_rstd(xa), rb = row_rstd(xb);
            f32x4* oa = (f32x4*)(a.out + (size_t)(row0 + r) * D) + lane; f32x4* ob = (f32x4*)(a.out + (size_t)(row0 + r + 1) * D) + lane;
#pragma unroll
            for (int j = 0; j < 4; ++j) { oa[64 * j] = xa[j] * ra * g4[j]; ob[64 * j] = xb[j] * rb * g4[j]; }
#pragma unroll
            for (int j = 0; j < 4; ++j) { xa[j] = na[j]; xb[j] = nb[j]; ya[j] = nya[j]; yb[j] = nyb[j]; }
        }
    }
}

constexpr int NPHASE = 38;
#ifndef PHMASK
#define PHMASK 0xFFFFu
#endif
#define PHON(b) ((PHMASK >> (b)) & 1u)
#ifndef REPMASK
#define REPMASK 0u
#endif
#ifndef REPN
#define REPN 1
#endif
#define NREP(b) (((REPMASK >> (b)) & 1u) ? (1 + REPN) : 1)

__global__ void __launch_bounds__(NTHREADS, 2) fwd_kernel(Args args) {
    extern __shared__ __attribute__((aligned(16))) unsigned char lds_raw[];
    Frame F;
    F.lds = (LAS unsigned char*)lds_raw;
    F.tid = threadIdx.x; F.lane = F.tid & 63; F.wave = __builtin_amdgcn_readfirstlane(F.tid >> 6);
    F.G = gridDim.x; { const int bx = blockIdx.x; F.vcu = (F.G % 8 == 0) ? (bx % 8) * (F.G / 8) + bx / 8 : bx; }
    F.ws = args.ws;
    volatile LAS unsigned* MISC = (volatile LAS unsigned*)(F.lds + MISC_OFF);
    for (int u = F.tid; u < 256; u += NTHREADS) MISC[u] = 0u;
    __syncthreads();
    unsigned* ctl = (unsigned*)(F.ws + WS_CTL);
    const int lo = args.ph_lo, hi = args.ph_hi;
    const bool multi = (hi - lo) > 1;
    XcdBarrier bar; bar.bar = ctl + CW_BAR; bar.x = 0; bar.st = nullptr;
    if (multi) bar = xcd_barrier_post(ctl + CW_BAR, MISC + 8);
#define IN(k) (lo <= (k) && (k) < hi)
#define SEAM(k) do { if (IN(k) && IN((k) + 1)) xcd_barrier(bar); } while (0)

    if (PHON(0) && IN(0)) { for (int rep = 0; rep < NREP(0); ++rep) { phase_prologue(F, args); __syncthreads(); } }
    SEAM(0);

    const float* MODB = (const float*)(F.ws + WS_MOD);
#pragma unroll 1
    for (int l = 0; l < NL; ++l) {
        const int pb = 1 + 9 * l;
        const float* xin = (l == 0) ? args.in[0] : args.out;
        if (PHON(1) && IN(pb + 0)) phase_norm1(F, args, l);
        SEAM(pb + 0);
        if (PHON(2) && IN(pb + 1)) {
            pg8::DenseSched S{(const char*)(F.ws + WS_HBUF), (const char*)(F.ws + WS_WIN) + (size_t)l * NPROJ * 1024 * 2, T / 256, NPROJ / 256, F.G, (int)blockIdx.x, 1024, 1024};
            pg8::EpiBf16Store E{(bf16_t*)(F.ws + WS_PROJ), NPROJ};
            for (int rep = 0; rep < NREP(2); ++rep) pg8::gemm_phase<pg8::EpiBf16Store, pg8::DenseSched>(F.lds, 1024, 1024, S, E);
        }
        SEAM(pb + 1);
        if (IN(pb + 2)) { if (l & 1) { if (PHON(3)) for (int rep = 0; rep < NREP(3); ++rep) { phase_conv(F, args, l >> 1); __syncthreads(); } } else { if (PHON(4)) for (int rep = 0; rep < NREP(4); ++rep) { phase_dilated2(F, args); __syncthreads(); } } }
        SEAM(pb + 2);
        if (IN(pb + 3)) { if (l & 1) { if (PHON(5)) for (int rep = 0; rep < NREP(5); ++rep) { phase_stick(F); __syncthreads(); } } else { if (PHON(6)) for (int rep = 0; rep < NREP(6); ++rep) { phase_gmlp(F, args, l >> 1); __syncthreads(); } if (PHON(4)) phase_dil_combine(F); } }
        SEAM(pb + 3);
        if (PHON(7) && IN(pb + 4)) {
            pg8::DenseSched S{(const char*)(F.ws + WS_MIX), (const char*)(F.ws + WS_WOUT) + (size_t)l * 1024 * 1024 * 2, T / 256, D / 256, F.G, (int)blockIdx.x, 1024, 1024};
            pg8::EpiDelta E{(bf16_t*)(F.ws + WS_HBUF), MODB + (size_t)l * 16 * 6144 + 2048};
            for (int rep = 0; rep < NREP(7); ++rep) pg8::gemm_phase<pg8::EpiDelta, pg8::DenseSched>(F.lds, 1024, 1024, S, E);
        }
        SEAM(pb + 4);
        if (PHON(8) && IN(pb + 5)) phase_router(F, args, l, xin);
        SEAM(pb + 5);
        if (PHON(8) && IN(pb + 6)) { build_moe_table(F, l); phase_permute(F); }
        SEAM(pb + 6);
        if (PHON(9) && IN(pb + 7)) {
            build_moe_table(F, l);
            pg8::MoeSched1 S{(const char*)(F.ws + WS_HSORT), (const char*)(F.ws + WS_WGU) + (size_t)l * 16 * 1024 * 1024 * 2, (const LAS int*)(F.lds + 131072), F.G, (int)blockIdx.x};
            pg8::EpiHid E{(bf16_t*)(F.ws + WS_PROJ), (const float*)(F.ws + WS_LIST + 2 * MiB)};
            for (int rep = 0; rep < NREP(9); ++rep) pg8::gemm_phase<pg8::EpiHid, pg8::MoeSched1>(F.lds, 1024, 1024, S, E);
        }
        SEAM(pb + 7);
        if (PHON(10) && IN(pb + 8)) {
            build_moe_table(F, l);
            pg8::MoeSched2 S{(const char*)(F.ws + WS_PROJ), (const char*)(F.ws + WS_WDT) + (size_t)l * 1024 * 8192 * 2, (const int*)(F.ws + WS_LIST + 1 * MiB), (const LAS int*)(F.lds + 131072), F.G, (int)blockIdx.x};
            pg8::EpiBf16Store E{(bf16_t*)(F.ws + WS_HSORT), D};
            for (int rep = 0; rep < NREP(10); ++rep) pg8::gemm_phase<pg8::EpiBf16Store, pg8::MoeSched2>(F.lds, 1024, 8192, S, E);
        }
        SEAM(pb + 8);
    }
    if (PHON(11) && IN(37)) phase_final(F, args);
#undef IN
#undef SEAM
}

extern "C" void kernel_launch(void* const* d_in, const int* in_sizes, int n_in, void* d_out, int out_size, void* d_ws, size_t ws_size, hipStream_t stream) {
    static int grid = 0;
    if (grid == 0) {
        if (n_in != 27 || out_size != T * D || ws_size < WS_END) { fprintf(stderr, "kernel_launch: unexpected shapes (n_in %d out %d ws %zu)\n", n_in, out_size, ws_size); grid = -1; return; }
        int dev = 0, cus = 0, per_cu = 0;
        if (hipGetDevice(&dev) != hipSuccess || hipDeviceGetAttribute(&cus, hipDeviceAttributeMultiprocessorCount, dev) != hipSuccess) { grid = -1; return; }
        if (hipFuncSetAttribute((const void*)fwd_kernel, hipFuncAttributeMaxDynamicSharedMemorySize, LDS_BYTES) != hipSuccess) { fprintf(stderr, "kernel_launch: hipFuncSetAttribute failed\n"); grid = -1; return; }
        if (hipOccupancyMaxActiveBlocksPerMultiprocessor(&per_cu, (const void*)fwd_kernel, NTHREADS, LDS_BYTES) != hipSuccess || per_cu < 1) { fprintf(stderr, "kernel_launch: occupancy query says %d\n", per_cu); }
        (void)hipGetLastError();
        grid = cus;
    }
    if (grid < 0) return;
    (void)hipMemsetAsync((char*)d_ws + WS_CTL, 0, CTL_ZERO_BYTES, stream);
    Args a{};
    for (int i = 0; i < 27; ++i) a.in[i] = (const float*)d_in[i];
    a.out = (float*)d_out; a.ws = (unsigned char*)d_ws;
#ifndef MK_MULTI
    a.ph_lo = 0; a.ph_hi = NPHASE;
    hipLaunchKernelGGL(fwd_kernel, dim3(grid), dim3(NTHREADS), LDS_BYTES, stream, a);
#else
    for (int p = 0; p < NPHASE; ++p) { a.ph_lo = p; a.ph_hi = p + 1; hipLaunchKernelGGL(fwd_kernel, dim3(grid), dim3(NTHREADS), LDS_BYTES, stream, a); }
#endif
}
```

```cpp
#include <hip/hip_runtime.h>
#include <cstdio>
#include <cstdint>

#define LAS __attribute__((address_space(3)))
#define GAS __attribute__((address_space(1)))
typedef unsigned short bf16_t;
typedef short bf16x8 __attribute__((ext_vector_type(8)));
typedef float f32x4 __attribute__((ext_vector_type(4)));
typedef float f32x2 __attribute__((ext_vector_type(2)));
typedef float f32x16 __attribute__((ext_vector_type(16)));
typedef unsigned u32x4 __attribute__((ext_vector_type(4)));
typedef unsigned u32x2 __attribute__((ext_vector_type(2)));
typedef __bf16 bf16x2v __attribute__((ext_vector_type(2)));

constexpr int T = 65536, D = 1024, SEQ = 4096, NBATCH = 16, NL = 4, NPROJ = 2560, NEXP = 16, DE = 512, NCLS = 24;
constexpr float EPS = 1e-6f;
constexpr int NWAVES = 8, NTHREADS = 512;
constexpr float SC_H2 = 4.f, SC_WGU = 128.f, SC_HID = 8.f, SC_WD = 64.f;

constexpr size_t MiB = 1u << 20;
constexpr size_t WS_CTL = 0, CTL_ZERO_BYTES = 1 * MiB;
constexpr size_t WS_WIN = 2 * MiB;
constexpr size_t WS_WOUT = 22 * MiB;
constexpr size_t WS_WS = 30 * MiB;
constexpr size_t WS_MOD = 31 * MiB;
constexpr size_t WS_RW = 33 * MiB;
constexpr size_t WS_LIST = 34 * MiB;
constexpr size_t WS_WGU = 40 * MiB;
constexpr size_t WS_WDT = 168 * MiB;
constexpr size_t WS_HBUF = 232 * MiB;
constexpr size_t WS_MIX = 360 * MiB;
constexpr size_t WS_PROJ = 488 * MiB;
constexpr size_t WS_XB = 808 * MiB;
constexpr size_t WS_END = 936 * MiB;
constexpr int HID_ROWS = T + NCLS * 256;
constexpr size_t WS_TLIST = WS_PROJ + 80 * MiB;
constexpr size_t WS_H8 = WS_MIX;
constexpr size_t WS_HSORT = WS_PROJ + 160 * MiB;
constexpr int CW_BAR = 4096;
constexpr int CW_CNT = 8192;

constexpr int LDS_BYTES = 155648;
constexpr int MISC_OFF = LDS_BYTES - 1024;

__device__ __forceinline__ unsigned pk2(float a, float b) { f32x2 v = {a, b}; bf16x2v r = __builtin_convertvector(v, bf16x2v); return __builtin_bit_cast(unsigned, r); }
__device__ __forceinline__ float bf_lo(unsigned u) { return __uint_as_float(u << 16); }
__device__ __forceinline__ float bf_hi(unsigned u) { return __uint_as_float(u & 0xffff0000u); }
__device__ __forceinline__ float bf1(bf16_t b) { return __uint_as_float(((unsigned)b) << 16); }
template <int CTRL, int RM> __device__ __forceinline__ float dpp_mov0(float v) { return __builtin_bit_cast(float, __builtin_amdgcn_update_dpp(0, __builtin_bit_cast(int, v), CTRL, RM, 0xf, true)); }
__device__ __forceinline__ float wave_sum(float v) {
    v += dpp_mov0<0xB1, 0xf>(v); v += dpp_mov0<0x4E, 0xf>(v); v += dpp_mov0<0x141, 0xf>(v); v += dpp_mov0<0x140, 0xf>(v);
    v += dpp_mov0<0x142, 0xa>(v); v += dpp_mov0<0x143, 0xc>(v);
    return __builtin_bit_cast(float, __builtin_amdgcn_readlane(__builtin_bit_cast(int, v), 63));
}
__device__ __forceinline__ float frcp(float x) { return __builtin_amdgcn_rcpf(x); }
__device__ __forceinline__ float silu_f(float x) { return x * frcp(1.f + __expf(-x)); }
__device__ __forceinline__ float sigmoid_f(float x) { return frcp(1.f + __expf(-x)); }
__device__ __forceinline__ float gelu_tanh(float x) {
    const float u = 0.7978845608028654f * (x + 0.044715f * x * x * x);
    const float e = __expf(2.f * u);
    const float th = 1.f - 2.f * frcp(e + 1.f);
    return 0.5f * x * (1.f + th);
}
__device__ __forceinline__ unsigned pk_fp8x4(float a, float b, float c, float d) {
    a = fminf(fmaxf(a, -448.f), 448.f); b = fminf(fmaxf(b, -448.f), 448.f); c = fminf(fmaxf(c, -448.f), 448.f); d = fminf(fmaxf(d, -448.f), 448.f);
    unsigned w = 0; w = __builtin_amdgcn_cvt_pk_fp8_f32(a, b, w, false); w = __builtin_amdgcn_cvt_pk_fp8_f32(c, d, w, true); return w;
}
#define LDS_WAIT() asm volatile("s_waitcnt lgkmcnt(0)" ::: "memory")

#define XB_TMO      128
#define XB_XCNT(j)  (256  + 64 * (j))
#define XB_XSUB(j)  (1280 + 64 * (j))
#define XB_XGEN(j)  (2304 + 64 * (j))
#define XB_TOP      3328
#define XB_TOPGEN   3392
#define XCD_BAR_WORDS 3456
#define XB_SPIN_CAP (1u << 20)

__device__ __forceinline__ unsigned xb_ld(unsigned* p)              { return __hip_atomic_load(p, __ATOMIC_RELAXED, __HIP_MEMORY_SCOPE_AGENT); }
__device__ __forceinline__ unsigned xb_add(unsigned* p, unsigned v) { return __hip_atomic_fetch_add(p, v, __ATOMIC_RELAXED, __HIP_MEMORY_SCOPE_AGENT); }
__device__ __forceinline__ unsigned xb_xcc_id() { return (unsigned)__builtin_amdgcn_s_getreg((3 << 11) | 20) & 0xFu; }
#define XB_SPIN(cond, bar) do { unsigned _sp = 0; while (cond) { __builtin_amdgcn_s_sleep(1); \
    if ((++_sp & 255u) == 0u) { if (xb_ld(&(bar)[XB_TMO])) break; if (_sp > XB_SPIN_CAP) { atomicAdd(&(bar)[XB_TMO], 1u); break; } } } } while (0)

struct XcdBarrier { unsigned* bar; unsigned x; volatile LAS unsigned* st; };

__device__ __forceinline__ XcdBarrier xcd_barrier_post(unsigned* bar, volatile LAS unsigned* st) {
    XcdBarrier b; b.bar = bar; b.x = xb_xcc_id(); b.st = st;
    if (threadIdx.x == 0) (void)xb_add(&bar[XB_XCNT(b.x)], 1u);
    return b;
}
__device__ __forceinline__ void xcd_barrier_complete(unsigned* bar, unsigned x, unsigned& nloc, unsigned& nx) {
    const unsigned G = gridDim.x * gridDim.y * gridDim.z;
    unsigned sum, cnt, mine, sp = 0u;
    for (;;) {
        sum = 0u; cnt = 0u; mine = 0u;
#pragma unroll
        for (unsigned j = 0; j < 16; ++j) { const unsigned c = xb_ld(&bar[XB_XCNT(j)]); sum += c; cnt += (c > 0u) ? 1u : 0u; mine = (j == x) ? c : mine; }
        if (sum == G) break;
        __builtin_amdgcn_s_sleep(1);
        if ((++sp & 255u) == 0u) { if (xb_ld(&bar[XB_TMO])) break; if (sp > XB_SPIN_CAP) { atomicAdd(&bar[XB_TMO], 1u); break; } }
    }
    nloc = mine > 0u ? mine : 1u; nx = cnt > 0u ? cnt : 1u;
}
__device__ __forceinline__ void xcd_barrier(const XcdBarrier& b) {
    asm volatile("s_waitcnt vmcnt(0)" ::: "memory");
    __syncthreads();
    if (threadIdx.x == 0) {
        unsigned* bar = b.bar;
        __builtin_amdgcn_s_waitcnt(0);
        unsigned nloc = b.st[0], nx = b.st[1];
        if (nloc == 0u) { xcd_barrier_complete(bar, b.x, nloc, nx); b.st[0] = nloc; b.st[1] = nx; }
        const unsigned old = xb_add(&bar[XB_XSUB(b.x)], 1u);
        const unsigned gen = old / nloc;
        if (old + 1u == (gen + 1u) * nloc) {
            __builtin_amdgcn_fence(__ATOMIC_RELEASE, "agent");
            asm volatile("s_waitcnt vmcnt(0)" ::: "memory");
            const unsigned og = xb_add(&bar[XB_TOP], 1u);
            const unsigned tg = og / nx;
            if (og + 1u == (tg + 1u) * nx) xb_add(&bar[XB_TOPGEN], 1u);
            else XB_SPIN(xb_ld(&bar[XB_TOPGEN]) == tg, bar);
            __builtin_amdgcn_fence(__ATOMIC_ACQUIRE, "agent");
            xb_add(&bar[XB_XGEN(b.x)], 1u);
            asm volatile("s_waitcnt vmcnt(0)" ::: "memory");
        } else {
            XB_SPIN(xb_ld(&bar[XB_XGEN(b.x)]) == gen, bar);
            __builtin_amdgcn_fence(__ATOMIC_ACQUIRE, "agent");
            asm volatile("s_waitcnt vmcnt(0)" ::: "memory");
        }
    }
    __syncthreads();
}

namespace pg8 {
constexpr int BM = 256, BK = 64, HALF = 128, HTB = HALF * BK * 2, STAGE_BYTES = 8 * HTB, NXCD = 8, WGM = 8, KT = 16;
__device__ __forceinline__ int lds_byte(int r, int c) { const int st = (r >> 4) * 2 + (c >> 5), rr = r & 15, cc = c & 31, ob = rr * 64 + cc * 2; return st * 1024 + (ob ^ (((ob >> 9) & 1) << 5)); }
__device__ __forceinline__ void stage_rc(int b, int& R, int& C) { const int st = b / 1024, sb = b % 1024, swz = sb ^ (((sb >> 9) & 1) << 5); R = (st >> 1) * 16 + swz / 64; C = (st & 1) * 32 + (swz % 64) / 2; }
__device__ __forceinline__ int perm32(int rho) { const int n = rho >> 4, i = rho & 15; return 8 * (i >> 2) + 4 * n + (i & 3); }

struct Unit { int A, B0, B1; int listoff; int nvalid, r0, c0, aux; };

__device__ __forceinline__ bool static_tile(int i, int G, int c, int nM, int nN, int& pm, int& pn) {
    const int nwg = nM * nN; const long L = (long)i * G + c; if (L >= nwg) return false;
    int wgid = (int)L; { const int q = nwg / NXCD, r = nwg % NXCD, xcd = wgid % NXCD, off = wgid / NXCD; wgid = (xcd < r ? xcd * (q + 1) : r * (q + 1) + (xcd - r) * q) + off; }
    const int nig = WGM * nN, gid = wgid / nig, fm = gid * WGM, gsz = (nM - fm) < WGM ? (nM - fm) : WGM;
    pm = fm + ((wgid % nig) % gsz); pn = (wgid % nig) / gsz; return true;
}

typedef int v8i_t __attribute__((ext_vector_type(8)));
typedef int v4i_t __attribute__((ext_vector_type(4)));
template <class Epi, class Sched, bool F8, bool GATHER = false>
__device__ __forceinline__ void gemm_phase(LAS unsigned char* lds, const int lda, const int ldb, const Sched& S, const Epi& E) {
    constexpr int KTN = F8 ? 8 : 16, KSPL = KTN / 2;
    int tid = threadIdx.x; asm volatile("" : "+v"(tid));
    const int wid = __builtin_amdgcn_readfirstlane(tid >> 6), lane = tid & 63, wr = wid >> 2, wc = wid & 3, fr = lane & 15, fq = lane >> 4;
    unsigned voffA[2], voffB[2], vg[2][2];
#pragma unroll
    for (int i = 0; i < 2; ++i) { int R, C; stage_rc(tid * 16 + i * 8192, R, C); const int Rb = Epi::PERM ? ((R & ~31) + perm32(R & 31)) : R;
        voffA[i] = (unsigned)(R * lda + C * 2); voffB[i] = (unsigned)(Rb * ldb + C * 2); }
    LAS int* toks = (LAS int*)(lds + 131072 + 4096);
#define PG8_TOKDMA(un, slot) do { if (GATHER && wid == 0) __builtin_amdgcn_raw_ptr_buffer_load_lds(rsL, (LAS void*)(toks + (slot) * 256), 16, lane * 16, (un).listoff, 0, 0); } while (0)
#define PG8_VG(un, slot) do { _Pragma("unroll") for (int _i = 0; _i < 2; ++_i) { int _R, _C; stage_rc(tid * 16 + _i * 8192, _R, _C); \
        _Pragma("unroll") for (int _h = 0; _h < 2; ++_h) { const int _idx = _h * HALF + _R; int _tok = toks[(slot) * 256 + _idx]; _tok = (_idx < (un).nvalid) ? _tok : 0; \
            vg[_h][_i] = (unsigned)(_tok * lda + _C * 2); } } } while (0)
    const int kstep = BK * 2;
    const int hstepA = HALF * lda, hstepB = HALF * ldb;
    const unsigned ldsw = (unsigned)wid * 1024u;
    int aoffk[2], boffk[2];
#pragma unroll
    for (int k = 0; k < 2; ++k) { aoffk[k] = F8 ? lds_byte(wr * 64 + fr, fq * 16 + 8 * k) : lds_byte(wr * 64 + fr, fq * 8 + 32 * k);
        boffk[k] = F8 ? lds_byte(wc * 32 + fr, fq * 16 + 8 * k) : lds_byte(wc * 32 + fr, fq * 8 + 32 * k); }
#define PG8_SA(b, h) (((b) * 2 + (h)) * HTB)
#define PG8_SB(b, h) ((4 + (b) * 2 + (h)) * HTB)
    const __amdgpu_buffer_rsrc_t rsA = __builtin_amdgcn_make_buffer_rsrc((void*)S.Abase, 0, 0x7fffffff, 0x00020000), rsB = __builtin_amdgcn_make_buffer_rsrc((void*)S.Bbase, 0, 0x7fffffff, 0x00020000);
#define PG8_STAGE_X(rs, bufoff, soff, voff) do { _Pragma("unroll") for (int _i = 0; _i < 2; ++_i) \
        __builtin_amdgcn_raw_ptr_buffer_load_lds(rs, (LAS void*)(lds + (bufoff) + ldsw + _i * 8192), 16, (int)(voff)[_i], (int)(soff), 0, 0); } while (0)
    __amdgpu_buffer_rsrc_t rsL = rsA; if constexpr (GATHER) rsL = __builtin_amdgcn_make_buffer_rsrc((void*)S.Lbase, 0, 0x7fffffff, 0x00020000);
#define PG8_STAGE_A(bufoff, soff) PG8_STAGE_X(rsA, bufoff, soff, voffA)
#define PG8_STAGE_AH(bufoff, soff, h) do { if constexpr (GATHER) PG8_STAGE_X(rsA, bufoff, soff, vg[h]); else PG8_STAGE_X(rsA, bufoff, (soff) + (h) * hstepA, voffA); } while (0)
#define PG8_STAGE_B(bufoff, soff) PG8_STAGE_X(rsB, bufoff, soff, voffB)
#define PG8_RD(off) (*(const LAS v4i_t*)(lds + (off)))
#define PG8_LDA(dst, b, h) do { _Pragma("unroll") for (int m = 0; m < 4; ++m) { \
        if constexpr (F8) dst##8[m] = __builtin_shufflevector(PG8_RD(PG8_SA(b, h) + aoffk[0] + m * 2048), PG8_RD(PG8_SA(b, h) + aoffk[1] + m * 2048), 0, 1, 2, 3, 4, 5, 6, 7); \
        else { _Pragma("unroll") for (int k = 0; k < 2; ++k) dst[m][k] = *(const LAS bf16x8*)(lds + PG8_SA(b, h) + aoffk[k] + m * 2048); } } } while (0)
#define PG8_LDB(dst, b, h) do { _Pragma("unroll") for (int n = 0; n < 2; ++n) { \
        if constexpr (F8) dst##8[n] = __builtin_shufflevector(PG8_RD(PG8_SB(b, h) + boffk[0] + n * 2048), PG8_RD(PG8_SB(b, h) + boffk[1] + n * 2048), 0, 1, 2, 3, 4, 5, 6, 7); \
        else { _Pragma("unroll") for (int k = 0; k < 2; ++k) dst[n][k] = *(const LAS bf16x8*)(lds + PG8_SB(b, h) + boffk[k] + n * 2048); } } } while (0)
#define PG8_MMA(ai, bj, At, Bt) do { __builtin_amdgcn_s_setprio(1); _Pragma("unroll") for (int m = 0; m < 4; ++m) _Pragma("unroll") for (int n = 0; n < 2; ++n) { \
        if constexpr (F8) asm volatile("s_nop 1\n\tv_mfma_scale_f32_16x16x128_f8f6f4 %0, %1, %2, %0, %3, %3 op_sel_hi:[0,0,0]" : "+v"(acc[ai][bj][m][n]) : "v"(Bt##8[n]), "v"(At##8[m]), "v"(f8scale)); \
        else { _Pragma("unroll") for (int k = 0; k < 2; ++k) acc[ai][bj][m][n] = __builtin_amdgcn_mfma_f32_16x16x32_bf16(Bt[n][k], At[m][k], acc[ai][bj][m][n], 0, 0, 0); } } \
        __builtin_amdgcn_s_setprio(0); } while (0)
#define PG8_WAIT_V(n) asm volatile("s_waitcnt vmcnt(" #n ")" ::: "memory")
#define PG8_WAIT_L(n) asm volatile("s_waitcnt lgkmcnt(" #n ")" ::: "memory")
#define PG8_BAR __builtin_amdgcn_s_barrier()
#define PG8_SCHED __builtin_amdgcn_sched_barrier(0)
    Unit cur, nxt; int ui = 0;
    if (!S.next(0, cur)) return;
    f32x4 acc[2][2][4][2];
#pragma unroll
    for (int a = 0; a < 2; ++a)
#pragma unroll
        for (int b = 0; b < 2; ++b)
#pragma unroll
            for (int m = 0; m < 4; ++m)
#pragma unroll
                for (int n = 0; n < 2; ++n) acc[a][b][m][n] = (f32x4){0.f, 0.f, 0.f, 0.f};
    int f8scale = 0x7f7f7f7f; asm volatile("" : "+v"(f8scale));
    bf16x8 At[4][2], B0[2][2], B1[2][2]; v8i_t At8[4], B08[2], B18[2];
    int cA = cur.A, cB0 = cur.B0, cB1 = cur.B1;
    if constexpr (GATHER) { PG8_TOKDMA(cur, 0); PG8_WAIT_V(0); __syncthreads(); PG8_VG(cur, 0); }
    PG8_STAGE_B(PG8_SB(0, 0), cB0); PG8_STAGE_AH(PG8_SA(0, 0), cA, 0); PG8_STAGE_B(PG8_SB(0, 1), cB0 + hstepB); PG8_STAGE_AH(PG8_SA(0, 1), cA, 1);
    if (wr == 1) PG8_BAR;
    PG8_WAIT_V(4); PG8_BAR;
    PG8_STAGE_B(PG8_SB(1, 0), cB0 + kstep); PG8_STAGE_AH(PG8_SA(1, 0), cA + kstep, 0); PG8_STAGE_B(PG8_SB(1, 1), cB0 + hstepB + kstep);
    PG8_WAIT_V(6); PG8_BAR;
    for (;;) {
        const bool has_next = S.next(ui + 1, nxt);
        const int nA = has_next ? nxt.A : cA, nB = has_next ? nxt.B0 : cB0;
        const int tslot = ui % 3, nslot = (ui + 1) % 3;
        if (has_next) PG8_TOKDMA(nxt, nslot);
#pragma unroll 1
        for (int t = 0; t < KTN; t += 2) {
            const bool last = (t == KTN - 2);
            const int a1 = cA + (t + 1) * kstep;
            const int a2 = last ? nA : cA + (t + 2) * kstep;
            const int b2 = last ? nB : ((t + 2 < KSPL) ? cB0 : cB1) + (t + 2) * kstep;
            const int a3 = a2 + kstep, b3 = b2 + kstep;
            PG8_LDB(B0, 0, 0); PG8_SCHED; PG8_LDA(At, 0, 0); PG8_STAGE_AH(PG8_SA(1, 1), a1, 1);
            if constexpr (GATHER) { if (last && has_next) PG8_VG(nxt, nslot); }
            PG8_WAIT_L(8); PG8_BAR; PG8_WAIT_L(0); PG8_MMA(0, 0, At, B0); PG8_BAR; PG8_SCHED;
            PG8_LDB(B1, 0, 1); PG8_STAGE_B(PG8_SB(0, 0), b2);
            PG8_BAR; PG8_WAIT_L(0); PG8_MMA(0, 1, At, B1); PG8_BAR;
            PG8_LDA(At, 0, 1); PG8_STAGE_AH(PG8_SA(0, 0), a2, 0);
            PG8_BAR; PG8_WAIT_L(0); PG8_MMA(1, 0, At, B0); PG8_BAR; PG8_SCHED;
            PG8_STAGE_B(PG8_SB(0, 1), b2 + hstepB);
            PG8_WAIT_V(6); PG8_BAR; PG8_MMA(1, 1, At, B1); PG8_BAR;
            PG8_LDB(B0, 1, 0); PG8_SCHED; PG8_LDA(At, 1, 0); PG8_STAGE_AH(PG8_SA(0, 1), a2, 1);
            PG8_WAIT_L(8); PG8_BAR; PG8_WAIT_L(0); PG8_MMA(0, 0, At, B0); PG8_BAR; PG8_SCHED;
            PG8_LDB(B1, 1, 1); PG8_STAGE_B(PG8_SB(1, 0), b3);
            PG8_BAR; PG8_WAIT_L(0); PG8_MMA(0, 1, At, B1); PG8_BAR;
            PG8_LDA(At, 1, 1); PG8_STAGE_AH(PG8_SA(1, 0), a3, 0);
            PG8_BAR; PG8_WAIT_L(0); PG8_MMA(1, 0, At, B0); PG8_BAR; PG8_SCHED;
            PG8_STAGE_B(PG8_SB(1, 1), b3 + hstepB);
            PG8_WAIT_V(6); PG8_BAR; PG8_MMA(1, 1, At, B1); PG8_BAR;
        }
        if constexpr (F8) asm volatile("s_nop 15\n\ts_nop 15" ::: "memory");
        E(acc, cur, wr, wc, fr, fq, toks + tslot * 256);
        if (!has_next) break;
#pragma unroll
        for (int a = 0; a < 2; ++a)
#pragma unroll
            for (int b = 0; b < 2; ++b)
#pragma unroll
                for (int m = 0; m < 4; ++m)
#pragma unroll
                    for (int n = 0; n < 2; ++n) acc[a][b][m][n] = (f32x4){0.f, 0.f, 0.f, 0.f};
        cur = nxt; cA = nA; cB0 = cur.B0; cB1 = cur.B1; ++ui;
    }
    PG8_WAIT_V(0);
    if (wr == 0) PG8_BAR;
    PG8_BAR;
#undef PG8_SA
#undef PG8_SB
#undef PG8_STAGE_X
#undef PG8_STAGE_A
#undef PG8_STAGE_B
#undef PG8_STAGE_AH
#undef PG8_TOKDMA
#undef PG8_VG
#undef PG8_LDA
#undef PG8_LDB
#undef PG8_MMA
#undef PG8_RD
#undef PG8_WAIT_V
#undef PG8_WAIT_L
#undef PG8_BAR
#undef PG8_SCHED
}


struct EpiBf16Store {
    static constexpr bool PERM = true;
    bf16_t* O; int ldc; float sc;
    __device__ __forceinline__ void operator()(const f32x4 (&acc)[2][2][4][2], const Unit& u, int wr, int wc, int fr, int fq, const LAS int* toks) const {
        const int row0 = u.r0 + wr * 64 + fr, col0 = u.c0 + wc * 32 + 8 * fq;
#pragma unroll
        for (int ai = 0; ai < 2; ++ai)
#pragma unroll
            for (int m = 0; m < 4; ++m) { bf16_t* rowp = O + (size_t)(row0 + ai * HALF + m * 16) * ldc + col0;
#pragma unroll
                for (int bj = 0; bj < 2; ++bj) { const f32x4 v0 = acc[ai][bj][m][0] * sc, v1 = acc[ai][bj][m][1] * sc;
                    u32x4 w; w.x = pk2(v0[0], v0[1]); w.y = pk2(v0[2], v0[3]); w.z = pk2(v1[0], v1[1]); w.w = pk2(v1[2], v1[3]);
                    *(u32x4*)(rowp + bj * HALF) = w; } }
    }
};
struct EpiDelta {
    static constexpr bool PERM = true;
    bf16_t* O; const float* gate;
    __device__ __forceinline__ void operator()(const f32x4 (&acc)[2][2][4][2], const Unit& u, int wr, int wc, int fr, int fq, const LAS int* toks) const {
        const int row0 = u.r0 + wr * 64 + fr, col0 = u.c0 + wc * 32 + 8 * fq;
        const float* gp = gate + (size_t)(u.r0 >> 12) * 6144 + col0;
        f32x4 gv[2][2];
#pragma unroll
        for (int bj = 0; bj < 2; ++bj)
#pragma unroll
            for (int n = 0; n < 2; ++n) gv[bj][n] = *(const f32x4*)(gp + bj * HALF + 4 * n);
#pragma unroll
        for (int ai = 0; ai < 2; ++ai)
#pragma unroll
            for (int m = 0; m < 4; ++m) { bf16_t* rowp = O + (size_t)(row0 + ai * HALF + m * 16) * D + col0;
#pragma unroll
                for (int bj = 0; bj < 2; ++bj) { const f32x4 v0 = acc[ai][bj][m][0] * gv[bj][0], v1 = acc[ai][bj][m][1] * gv[bj][1];
                    u32x4 w; w.x = pk2(v0[0], v0[1]); w.y = pk2(v0[2], v0[3]); w.z = pk2(v1[0], v1[1]); w.w = pk2(v1[2], v1[3]);
                    *(u32x4*)(rowp + bj * HALF) = w; } }
    }
};
struct EpiHid {
    static constexpr bool PERM = true;
    unsigned char* H; const float* rw; float isc, osc;
    __device__ __forceinline__ void operator()(const f32x4 (&acc)[2][2][4][2], const Unit& u, int wr, int wc, int fr, int fq, const LAS int* toks) const {
        const int rl0 = wr * 64 + fr, col0 = u.c0 + wc * 32 + 8 * fq;
#pragma unroll
        for (int ai = 0; ai < 2; ++ai)
#pragma unroll
            for (int m = 0; m < 4; ++m) { const int rl = rl0 + ai * HALF + m * 16;
                float w = 0.f; if (rl < u.nvalid) w = rw[(size_t)toks[rl] * 2 + u.aux] * osc * isc;
                const f32x4 g0 = acc[ai][0][m][0] * isc, g1 = acc[ai][0][m][1] * isc, u0 = acc[ai][1][m][0], u1 = acc[ai][1][m][1];
                float h[8];
#pragma unroll
                for (int j = 0; j < 4; ++j) { h[j] = silu_f(g0[j]) * u0[j] * w; h[4 + j] = silu_f(g1[j]) * u1[j] * w; }
                u32x2 o; o.x = pk_fp8x4(h[0], h[1], h[2], h[3]); o.y = pk_fp8x4(h[4], h[5], h[6], h[7]);
                *(u32x2*)(H + (size_t)(u.r0 + rl) * D + col0) = o; }
    }
};

struct DenseSched {
    const char* Abase; const char* Bbase; int nM, nN, G, c, lda, ldb;
    __device__ __forceinline__ bool next(int i, Unit& u) const {
        int pm, pn; if (!static_tile(i, G, c, nM, nN, pm, pn)) return false;
        u.A = pm * BM * lda; u.B0 = pn * BM * ldb; u.B1 = u.B0; u.listoff = 0; u.nvalid = 256; u.r0 = pm * BM; u.c0 = pn * BM; u.aux = 0; return true;
    }
};
__device__ __forceinline__ void cls_experts(int cls, int& e_lo, int& e_hi) {
    const int g = cls / 6, p = cls % 6; const int lo = (p < 3) ? 0 : (p < 5 ? 1 : 2); const int hi = (p < 3) ? p + 1 : (p < 5 ? p - 1 : 3);
    e_lo = g * 4 + lo; e_hi = g * 4 + hi;
}
struct MoeSched1 {
    const char* Abase; const char* Bbase; const char* Lbase; const LAS int* tbl; int G, c;
    __device__ __forceinline__ bool next(int i, Unit& u) const {
        const int MT = tbl[24]; int mt, pn; if (!static_tile(i, G, c, MT, 8, mt, pn)) return false;
        const int cls = tbl[64 + mt];
        const int ml = mt - tbl[cls]; int e_lo, e_hi; cls_experts(cls, e_lo, e_hi);
        const int e = (pn < 4) ? e_lo : e_hi;
        u.A = 0; u.B0 = (e * 1024 + (pn & 3) * 256) * 1024; u.B1 = u.B0; u.listoff = (cls * T + ml * 256) * 4;
        const int rem = tbl[32 + cls] - ml * 256; u.nvalid = rem < 256 ? rem : 256; u.r0 = mt * 256; u.c0 = (pn >> 2) * 512 + (pn & 3) * 128; u.aux = pn >> 2; return true;
    }
};
struct MoeSched2 {
    const char* Abase; const char* Bbase; const LAS int* tbl; int G, c;
    __device__ __forceinline__ bool next(int i, Unit& u) const {
        const int MT = tbl[24]; int mt, pn; if (!static_tile(i, G, c, MT, 4, mt, pn)) return false;
        const int cls = tbl[64 + mt];
        const int ml = mt - tbl[cls]; int e_lo, e_hi; cls_experts(cls, e_lo, e_hi);
        u.A = mt * 256 * 1024;
        const int brow = pn * 256 * 8192;
        u.B0 = brow + e_lo * 512; u.B1 = brow + e_hi * 512 - 4 * 128; u.listoff = 0;
        const int rem = tbl[32 + cls] - ml * 256; u.nvalid = rem < 256 ? rem : 256; u.r0 = mt * 256; u.c0 = pn * 256; u.aux = 0; return true;
    }
};
}

struct Args { const float* in[27]; float* out; unsigned char* ws; int ph_lo, ph_hi; };

__device__ const unsigned char BUCKET[3][132] = {
 {0,1,2,3,4,5,6,7,8,9,10,11,12,13,14,15,16,16,16,16,16,16,17,17,17,17,17,17,17,17,18,18,18,18,18,18,18,18,18,18,19,19,19,19,19,19,19,19,19,19,19,19,19,19,20,20,20,20,20,20,20,20,20,20,20,20,20,20,20,20,20,20,20,21,21,21,21,21,21,21,21,21,21,21,21,21,21,21,21,21,21,21,21,21,21,21,21,21,21,22,22,22,22,22,22,22,22,22,22,22,22,22,22,22,22,22,22,22,22,22,22,22,22,22,22,22,22,22,22,0,0,0},
 {0,4,8,12,16,16,17,17,18,18,19,19,19,19,20,20,20,20,20,21,21,21,21,21,21,22,22,22,22,22,22,22,22,22,23,23,23,23,23,23,23,23,23,23,23,23,24,24,24,24,24,24,24,24,24,24,24,24,24,24,24,24,25,25,25,25,25,25,25,25,25,25,25,25,25,25,25,25,25,25,25,25,25,26,26,26,26,26,26,26,26,26,26,26,26,26,26,26,26,26,26,26,26,26,26,26,26,26,26,26,26,26,26,27,27,27,27,27,27,27,27,27,27,27,27,27,27,27,27,0,0,0},
 {0,16,18,19,20,21,21,22,22,23,23,23,24,24,24,24,25,25,25,25,25,26,26,26,26,26,26,26,26,27,27,27,27,27,27,27,27,27,27,28,28,28,28,28,28,28,28,28,28,28,28,28,29,29,29,29,29,29,29,29,29,29,29,29,29,29,29,29,29,29,30,30,30,30,30,30,30,30,30,30,30,30,30,30,30,30,30,30,30,30,30,30,30,30,30,31,31,31,31,31,31,31,31,31,31,31,31,31,31,31,31,31,31,31,31,31,31,31,31,31,31,31,31,31,31,31,31,31,31,0,0,0}};

struct Frame {
    LAS unsigned char* lds;
    int tid, lane, wave, vcu, G;
    unsigned char* ws;
};

__device__ __forceinline__ void frame_refresh(Frame& F) {
    int tid = threadIdx.x; asm volatile("" : "+v"(tid));
    F.tid = tid; F.lane = tid & 63; F.wave = __builtin_amdgcn_readfirstlane(tid >> 6);
}
__device__ __forceinline__ void transpose_item(const float* W, int srcN, int k0, int n0, bf16_t* dst, size_t dstride, LAS float* scr, int lane) {
#pragma unroll 8
    for (int i = 0; i < 32; ++i) { const int kk = 2 * i + (lane >> 5); scr[kk * 33 + (lane & 31)] = W[(size_t)(k0 + kk) * srcN + n0 + (lane & 31)]; }
    LDS_WAIT(); asm volatile("" ::: "memory");
    const int c = lane & 7;
#pragma unroll
    for (int j = 0; j < 4; ++j) { const int n = (lane >> 3) + 8 * j; const LAS float* s = scr + (8 * c) * 33 + n;
        u32x4 o; o.x = pk2(s[0 * 33], s[1 * 33]); o.y = pk2(s[2 * 33], s[3 * 33]); o.z = pk2(s[4 * 33], s[5 * 33]); o.w = pk2(s[6 * 33], s[7 * 33]);
        *(u32x4*)(dst + (size_t)n * dstride + 8 * c) = o; }
    LDS_WAIT(); asm volatile("" ::: "memory");
}

__device__ __forceinline__ void transpose_item_f8(const float* W, int srcN, int k0, int n0, unsigned char* dst, size_t dstride, LAS float* scr, int lane, float sc) {
#pragma unroll 8
    for (int i = 0; i < 32; ++i) { const int kk = 2 * i + (lane >> 5); scr[kk * 33 + (lane & 31)] = W[(size_t)(k0 + kk) * srcN + n0 + (lane & 31)]; }
    LDS_WAIT(); asm volatile("" ::: "memory");
    const int c = lane & 7;
#pragma unroll
    for (int j = 0; j < 4; ++j) { const int n = (lane >> 3) + 8 * j; const LAS float* s = scr + (8 * c) * 33 + n;
        u32x2 o; o.x = pk_fp8x4(s[0 * 33] * sc, s[1 * 33] * sc, s[2 * 33] * sc, s[3 * 33] * sc); o.y = pk_fp8x4(s[4 * 33] * sc, s[5 * 33] * sc, s[6 * 33] * sc, s[7 * 33] * sc);
        *(u32x2*)(dst + (size_t)n * dstride + 8 * c) = o; }
    LDS_WAIT(); asm volatile("" ::: "memory");
}
__device__ __forceinline__ void phase_prologue(Frame& F, const Args& a) {
    frame_refresh(F);
    LAS float* scr = (LAS float*)(F.lds + F.wave * 16384);
    const int gw = F.vcu * NWAVES + F.wave, NGW = F.G * NWAVES;
    bf16_t* WIN = (bf16_t*)(F.ws + WS_WIN); bf16_t* WOUT = (bf16_t*)(F.ws + WS_WOUT); unsigned char* WGU = F.ws + WS_WGU; unsigned char* WDT = F.ws + WS_WDT;
    constexpr int I_IN = 4 * 16 * 80, I_OUT = 4 * 16 * 32, I_G = 64 * 16 * 16, I_D = 64 * 8 * 32;
    constexpr int NITEMS = I_IN + I_OUT + 2 * I_G + I_D;
    for (int it = gw; it < NITEMS; it += NGW) {
        int r = it;
        if (r < I_IN) { const int l = r / 1280, q = r % 1280, kb = q / 80, nb = q % 80;
            const float* W = ((l & 1) ? a.in[13] : a.in[7]) + (size_t)(l >> 1) * 1024 * NPROJ;
            transpose_item(W, NPROJ, 64 * kb, 32 * nb, WIN + ((size_t)l * NPROJ + 32 * nb) * 1024 + 64 * kb, 1024, scr, F.lane); continue; }
        r -= I_IN;
        if (r < I_OUT) { const int l = r / 512, q = r % 512, kb = q / 32, nb = q % 32;
            const float* W = ((l & 1) ? a.in[14] : a.in[8]) + (size_t)(l >> 1) * 1024 * 1024;
            transpose_item(W, 1024, 64 * kb, 32 * nb, WOUT + ((size_t)l * 1024 + 32 * nb) * 1024 + 64 * kb, 1024, scr, F.lane); continue; }
        r -= I_OUT;
        if (r < 2 * I_G) { const int up = r / I_G, q0 = r % I_G, le = q0 / 256, q = q0 % 256, kb = q / 16, nb = q % 16;
            const float* W = (up ? a.in[24] : a.in[23]) + (size_t)le * 1024 * 512;
            const int n0 = 32 * nb, drow = 256 * (n0 >> 7) + 128 * up + (n0 & 127);
            transpose_item_f8(W, 512, 64 * kb, n0, WGU + ((size_t)le * 1024 + drow) * 1024 + 64 * kb, 1024, scr, F.lane, SC_WGU); continue; }
        r -= 2 * I_G;
        { const int le = r / 256, q = r % 256, kb = q / 32, nb = q % 32, l = le >> 4, e = le & 15;
            const float* W = a.in[25] + (size_t)le * 512 * 1024;
            transpose_item_f8(W, 1024, 64 * kb, 32 * nb, WDT + ((size_t)l * 1024 + 32 * nb) * 8192 + e * 512 + 64 * kb, 8192, scr, F.lane, SC_WD); }
    }
    { bf16_t* WS = (bf16_t*)(F.ws + WS_WS); const float* src = a.in[11];
      for (int i = (F.vcu * NTHREADS + F.tid); i < 2 * 4 * 128 * 128; i += F.G * NTHREADS) { const int t = (i >> 7) & 127, s = i & 127; const float v = (s <= t) ? src[i] : 0.f; WS[i] = (bf16_t)(pk2(v, 0.f) & 0xffffu); } }
    __syncthreads();
    { LAS float* sc = (LAS float*)F.lds;
      LAS float* red = (LAS float*)(F.lds + 65536);
      const float* c = a.in[1];
      for (int i = F.tid; i < 16 * 1024; i += NTHREADS) sc[i] = silu_f(c[i]);
      __syncthreads();
      float* MOD = (float*)(F.ws + WS_MOD);
      for (int grp = F.vcu; grp < 4 * 96; grp += F.G) {
          const int l = grp / 96, n = (grp % 96) * 64 + F.lane;
          const float* w = a.in[5] + ((size_t)l * 1024 + F.wave * 128) * 6144 + n;
          float acc[16];
#pragma unroll
          for (int b = 0; b < 16; ++b) acc[b] = 0.f;
#pragma unroll 4
          for (int k = 0; k < 128; ++k) { const float wv = w[(size_t)k * 6144];
#pragma unroll
              for (int b = 0; b < 16; ++b) acc[b] += sc[b * 1024 + F.wave * 128 + k] * wv; }
#pragma unroll
          for (int b = 0; b < 16; ++b) red[(F.wave * 16 + b) * 64 + F.lane] = acc[b];
          __syncthreads();
#pragma unroll
          for (int bb = 0; bb < 2; ++bb) { const int b = F.wave * 2 + bb; float s = a.in[6][(size_t)l * 6144 + n];
#pragma unroll
              for (int w8 = 0; w8 < 8; ++w8) s += red[(w8 * 16 + b) * 64 + F.lane];
              MOD[((size_t)l * 16 + b) * 6144 + n] = s; }
          __syncthreads();
      }
    }
}

__device__ __forceinline__ void load_row(const float* xrow, int lane, f32x4 (&v)[4]) {
    const f32x4* xr = (const f32x4*)xrow + lane;
#pragma unroll
    for (int j = 0; j < 4; ++j) v[j] = xr[64 * j];
}
__device__ __forceinline__ float row_rstd(const f32x4 (&v)[4]) {
    float ss = 0.f;
#pragma unroll
    for (int j = 0; j < 4; ++j) ss += (v[j].x * v[j].x + v[j].y * v[j].y) + (v[j].z * v[j].z + v[j].w * v[j].w);
    return rsqrtf(wave_sum(ss) * (1.f / D) + EPS);
}
__device__ __forceinline__ void load_mod(const float* gam, const float* sh, const float* sc, int lane, f32x4 (&gp)[4], f32x4 (&shv)[4]) {
#pragma unroll
    for (int j = 0; j < 4; ++j) { const f32x4 g = ((const f32x4*)gam)[lane + 64 * j], s1 = ((const f32x4*)sc)[lane + 64 * j]; gp[j] = g * (1.f + s1); shv[j] = ((const f32x4*)sh)[lane + 64 * j]; }
}
__device__ __forceinline__ void store_row_bf16(bf16_t* orow, int lane, const f32x4 (&h)[4]) {
    u32x2* o = (u32x2*)orow + lane;
#pragma unroll
    for (int j = 0; j < 4; ++j) { u32x2 w; w.x = pk2(h[j].x, h[j].y); w.y = pk2(h[j].z, h[j].w); o[64 * j] = w; }
}

__device__ __forceinline__ void load_y(const bf16_t* yrow, int lane, u32x2 (&y)[4]) {
    const u32x2* yr = (const u32x2*)yrow + lane;
#pragma unroll
    for (int j = 0; j < 4; ++j) y[j] = yr[64 * j];
}
__device__ __forceinline__ void add_y(f32x4 (&x)[4], const u32x2 (&y)[4], const f32x4 (&g)[4]) {
#pragma unroll
    for (int j = 0; j < 4; ++j) { x[j].x += g[j].x * bf_lo(y[j].x); x[j].y += g[j].y * bf_hi(y[j].x); x[j].z += g[j].z * bf_lo(y[j].y); x[j].w += g[j].w * bf_hi(y[j].y); }
}
__device__ __forceinline__ void store_row_fp8(unsigned char* orow, int lane, const f32x4 (&h)[4], float sc) {
    unsigned* o = (unsigned*)orow + lane;
#pragma unroll
    for (int j = 0; j < 4; ++j) o[64 * j] = pk_fp8x4(h[j].x * sc, h[j].y * sc, h[j].z * sc, h[j].w * sc);
}
__device__ __forceinline__ void load_row_bf(const bf16_t* xrow, int lane, f32x4 (&v)[4]) {
    const u32x2* xr = (const u32x2*)xrow + lane;
#pragma unroll
    for (int j = 0; j < 4; ++j) { const u32x2 w = xr[64 * j]; v[j] = (f32x4){bf_lo(w.x), bf_hi(w.x), bf_lo(w.y), bf_hi(w.y)}; }
}
__device__ __forceinline__ void store_row_f32(float* xrow, int lane, const f32x4 (&v)[4]) {
    f32x4* xr = (f32x4*)xrow + lane;
#pragma unroll
    for (int j = 0; j < 4; ++j) xr[64 * j] = v[j];
}
__device__ __forceinline__ void phase_norm1(Frame& F, const Args& a, int l) {
    frame_refresh(F);
    const int gw = F.vcu * NWAVES + F.wave, NGW = F.G * NWAVES, lane = F.lane;
    const float* MOD = (const float*)(F.ws + WS_MOD) + (size_t)l * 16 * 6144;
    bf16_t* HB = (bf16_t*)(F.ws + WS_HBUF);
    const float* gam = a.in[3] + (size_t)l * D;
    const bool addy = l > 0;
    const float* xin = a.in[0]; bf16_t* XB = (bf16_t*)(F.ws + WS_XB);
    const bf16_t* Y2 = (const bf16_t*)(F.ws + WS_HSORT); const int* SINFO = (const int*)(F.ws + WS_LIST);
    const LAS int* tbl = (const LAS int*)(F.lds + 131072);
    for (int blk = gw; blk < T / 32; blk += NGW) {
        const int row0 = blk * 32, b = row0 >> 12;
        f32x4 gp[4], shv[4], g2[4]; load_mod(gam, MOD + (size_t)b * 6144, MOD + (size_t)b * 6144 + 1024, lane, gp, shv);
        int slotv = 0;
        if (addy) { const int si = SINFO[row0 + (lane & 31)]; slotv = tbl[si >> 16] * 256 + (si & 0xffff);
#pragma unroll
            for (int j = 0; j < 4; ++j) g2[j] = ((const f32x4*)(MOD - 16 * 6144 + (size_t)b * 6144 + 5120))[lane + 64 * j]; }
        f32x4 xa[4], xb[4], na[4], nb[4]; u32x2 ya[4], yb[4], nya[4], nyb[4];
        if (addy) { load_row_bf(XB + (size_t)row0 * D, lane, xa); load_row_bf(XB + (size_t)(row0 + 1) * D, lane, xb); } else { load_row(xin + (size_t)row0 * D, lane, xa); load_row(xin + (size_t)(row0 + 1) * D, lane, xb); }
        if (addy) { load_y(Y2 + (size_t)__builtin_amdgcn_readlane(slotv, 0) * D, lane, ya); load_y(Y2 + (size_t)__builtin_amdgcn_readlane(slotv, 1) * D, lane, yb); }
#pragma unroll 1
        for (int r = 0; r < 32; r += 2) {
            if (r + 2 < 32) { if (addy) { load_row_bf(XB + (size_t)(row0 + r + 2) * D, lane, na); load_row_bf(XB + (size_t)(row0 + r + 3) * D, lane, nb); } else { load_row(xin + (size_t)(row0 + r + 2) * D, lane, na); load_row(xin + (size_t)(row0 + r + 3) * D, lane, nb); }
                if (addy) { load_y(Y2 + (size_t)__builtin_amdgcn_readlane(slotv, r + 2) * D, lane, nya); load_y(Y2 + (size_t)__builtin_amdgcn_readlane(slotv, r + 3) * D, lane, nyb); } }
            if (addy) { add_y(xa, ya, g2); add_y(xb, yb, g2); store_row_bf16(XB + (size_t)(row0 + r) * D, lane, xa); store_row_bf16(XB + (size_t)(row0 + r + 1) * D, lane, xb); }
            const float ra = row_rstd(xa), rb = row_rstd(xb);
#pragma unroll
            for (int j = 0; j < 4; ++j) { xa[j] = xa[j] * ra * gp[j] + shv[j]; xb[j] = xb[j] * rb * gp[j] + shv[j]; }
            store_row_bf16(HB + (size_t)(row0 + r) * D, lane, xa); store_row_bf16(HB + (size_t)(row0 + r + 1) * D, lane, xb);
#pragma unroll
            for (int j = 0; j < 4; ++j) { xa[j] = na[j]; xb[j] = nb[j]; ya[j] = nya[j]; yb[j] = nyb[j]; }
        }
    }
}

__device__ __forceinline__ float xor32(float v) {
    const unsigned u = __float_as_uint(v);
    auto rr = __builtin_amdgcn_permlane32_swap(u, u, false, false);
    return __uint_as_float((threadIdx.x & 32) ? rr[0] : rr[1]);
}
typedef short v4i16_t __attribute__((ext_vector_type(4)));
__device__ __forceinline__ v4i16_t tr_read8(const LAS char* p) { return __builtin_amdgcn_ds_read_tr16_b64_v4i16((LAS v4i16_t*)p); }
__device__ __forceinline__ void pv_mma(f32x16 (&O)[2], const bf16x8 (&pk)[2], const LAS char* vimg, int lane) {
    const int hh = lane >> 5;
    const LAS char* vb = vimg + (4 * hh + ((lane & 15) >> 2)) * 64 + ((lane >> 4) & 1) * 32 + (lane & 3) * 8;
#pragma unroll
    for (int dh = 0; dh < 2; ++dh)
#pragma unroll
        for (int s4 = 0; s4 < 2; ++s4) {
            const v4i16_t lo = tr_read8(vb + dh * 2048 + (16 * s4) * 64), hi = tr_read8(vb + dh * 2048 + (16 * s4 + 8) * 64);
            bf16x8 af; af[0] = lo[0]; af[1] = lo[1]; af[2] = lo[2]; af[3] = lo[3]; af[4] = hi[0]; af[5] = hi[1]; af[6] = hi[2]; af[7] = hi[3];
            O[dh] = __builtin_amdgcn_mfma_f32_32x32x16_bf16(af, pk[s4], O[dh], 0, 0, 0);
        }
}
__device__ __forceinline__ void pack_p(const float (&p)[16], bf16x8 (&pk)[2]) {
#pragma unroll
    for (int s4 = 0; s4 < 2; ++s4) { u32x4 w; w.x = pk2(p[8 * s4 + 0], p[8 * s4 + 1]); w.y = pk2(p[8 * s4 + 2], p[8 * s4 + 3]); w.z = pk2(p[8 * s4 + 4], p[8 * s4 + 5]); w.w = pk2(p[8 * s4 + 6], p[8 * s4 + 7]);
        pk[s4] = __builtin_bit_cast(bf16x8, w); }
}
__device__ __forceinline__ void store_ot(const f32x16 (&O)[2], float sc, bf16_t* orow, int lane) {
    const int hh = lane >> 5;
#pragma unroll
    for (int dh = 0; dh < 2; ++dh)
#pragma unroll
        for (int g = 0; g < 4; ++g) { u32x2 w; w.x = pk2(O[dh][4 * g] * sc, O[dh][4 * g + 1] * sc); w.y = pk2(O[dh][4 * g + 2] * sc, O[dh][4 * g + 3] * sc);
            *(u32x2*)(orow + 32 * dh + 8 * g + 4 * hh) = w; }
}

constexpr int DK_PITCH = 144, DL_K = 0, DL_V = 384 * DK_PITCH, DL_VH = 384 * 64, DL_BT = DL_V + 2 * DL_VH;
struct DilUnit { int b, hd, p, d, sh, res, S0; };
__device__ __forceinline__ void dil_decode(int u, DilUnit& U) {
    const int pair = u / 48, k = u % 48; U.p = k >> 4; const int idx = k & 15; U.hd = pair & 7; U.b = pair >> 3;
    U.sh = 2 * U.p; U.d = 1 << U.sh;
    const int lb = 4 - U.sh;
    U.res = idx >> lb; U.S0 = (idx & ((1 << lb) - 1)) * 256;
}
struct DilRegs { u32x4 k[6]; u32x4 v[6]; bf16x8 q[4]; };
__device__ __forceinline__ void dil_load(DilRegs& R, const bf16_t* P, const DilUnit& U, int tid) {
    const bf16_t* Pb = P + (size_t)U.b * SEQ * NPROJ;
#pragma unroll
    for (int i = 0; i < 6; ++i) { const int q = tid + 512 * i, key = q >> 3, c8 = q & 7; int sub = U.S0 - 128 + key; sub = sub < 0 ? 0 : sub;
        const bf16_t* rp = Pb + (size_t)(U.res + (sub << U.sh)) * NPROJ + U.hd * 64 + 8 * c8;
        R.k[i] = *(const u32x4*)(rp + 512); R.v[i] = *(const u32x4*)(rp + 1024); }
    const int lane = tid & 63, w = tid >> 6, qs = U.S0 + 32 * w + (lane & 31);
    const bf16_t* qp = Pb + (size_t)(U.res + (qs << U.sh)) * NPROJ + U.hd * 64 + 8 * (lane >> 5);
#pragma unroll
    for (int s4 = 0; s4 < 4; ++s4) R.q[s4] = *(const bf16x8*)(qp + 16 * s4);
}
__device__ __forceinline__ void dil_stage(const DilRegs& R, LAS char* lds, int tid) {
#pragma unroll
    for (int i = 0; i < 6; ++i) { const int q = tid + 512 * i, key = q >> 3, c8 = q & 7;
        *(LAS u32x4*)(lds + DL_K + key * DK_PITCH + c8 * 16) = R.k[i];
        *(LAS u32x4*)(lds + DL_V + (c8 >> 2) * DL_VH + key * 64 + (c8 & 3) * 16) = R.v[i]; }
}
__device__ __forceinline__ void phase_dilated2(Frame& F, const Args& a) {
    frame_refresh(F);
    const int tid = F.tid, lane = F.lane, wave = F.wave, r32 = lane & 31, hh = lane >> 5;
    const bf16_t* P = (const bf16_t*)(F.ws + WS_PROJ);
    bf16_t* OP0 = (bf16_t*)(F.ws + WS_MIX); bf16_t* OP12 = (bf16_t*)(F.ws + WS_HBUF); float* LSE = (float*)(F.ws + WS_LIST);
    LAS char* lds = (LAS char*)F.lds;
    LAS float* btab = (LAS float*)(lds + DL_BT);
    for (int i = tid; i < 8 * 3 * 132; i += NTHREADS) { const int h = i / 396, rem = i % 396, br = rem / 132, sd = rem % 132; btab[i] = a.in[2][(int)BUCKET[br][sd] * 8 + h]; }
    DilRegs R; DilUnit U, NU;
    const bool xl = (F.G == 256); const int xq = F.vcu >> 5, xj = F.vcu & 31; const int nmine = xl ? 24 : (6144 - F.vcu + F.G - 1) / F.G;
#define DIL_UNIT(i) (xl ? ((xq * 16 + 2 * ((i) / 3)) * 48 + xj + 32 * ((i) % 3)) : (F.vcu + (i) * F.G))
    if (nmine > 0) { dil_decode(DIL_UNIT(0), U); dil_load(R, P, U, tid); }
    for (int it = 0; it < nmine; ++it) {
        __syncthreads();
        dil_stage(R, lds, tid);
        bf16x8 qf[4];
#pragma unroll
        for (int s4 = 0; s4 < 4; ++s4) qf[s4] = R.q[s4];
        __syncthreads();
        if (it + 1 < nmine) { dil_decode(DIL_UNIT(it + 1), NU); dil_load(R, P, NU, tid); }
        const int qs = U.S0 + 32 * wave + r32;
        const int lim = qs < 128 ? qs : 128;
        const LAS float* bt = btab + (U.hd * 3 + U.p) * 132;
        float m = -1e30f, l = 0.f; f32x16 O[2];
#pragma unroll
        for (int i = 0; i < 16; ++i) { O[0][i] = 0.f; O[1][i] = 0.f; }
#pragma unroll 1
        for (int j = 0; j < 5; ++j) {
            const int kb = 32 * (wave + j);
            if (U.S0 - 128 + kb + 31 < 0) continue;
            f32x16 S;
#pragma unroll
            for (int i = 0; i < 16; ++i) S[i] = 0.f;
            const LAS char* kp = lds + DL_K + (kb + r32) * DK_PITCH + 16 * hh;
#pragma unroll
            for (int s4 = 0; s4 < 4; ++s4) S = __builtin_amdgcn_mfma_f32_32x32x16_bf16(*(const LAS bf16x8*)(kp + 32 * s4), qf[s4], S, 0, 0, 0);
            const int dist0 = 128 + r32 - 32 * j - 4 * hh;
            float sv[16]; float smax = -1e30f;
            float bv[16];
#pragma unroll
            for (int i = 0; i < 16; ++i) { const unsigned ud = (unsigned)(dist0 - ((i & 3) + 8 * (i >> 2))); bv[i] = bt[ud < 132u ? ud : 131u]; }
#pragma unroll
            for (int i = 0; i < 16; ++i) { const int dist = dist0 - ((i & 3) + 8 * (i >> 2)); const bool valid = (unsigned)dist <= (unsigned)lim;
                sv[i] = valid ? (S[i] * 0.125f + bv[i]) : -1e30f; smax = fmaxf(smax, sv[i]); }
            smax = fmaxf(smax, xor32(smax));
            const float mn = fmaxf(m, smax);
            const float alpha = __expf(m - mn);
            float p[16]; float ps = 0.f;
#pragma unroll
            for (int i = 0; i < 16; ++i) { p[i] = (sv[i] > -1e29f) ? __expf(sv[i] - mn) : 0.f; ps += p[i]; }
            l = l * alpha + ps; m = mn;
#pragma unroll
            for (int dh = 0; dh < 2; ++dh)
#pragma unroll
                for (int i = 0; i < 16; ++i) O[dh][i] *= alpha;
            bf16x8 pk[2]; pack_p(p, pk);
            const LAS char* vb = lds + DL_V + (kb + 4 * hh + ((lane & 15) >> 2)) * 64 + ((lane >> 4) & 1) * 32 + (lane & 3) * 8;
#pragma unroll
            for (int dh = 0; dh < 2; ++dh)
#pragma unroll
                for (int s4 = 0; s4 < 2; ++s4) {
                    const v4i16_t lo = tr_read8(vb + dh * DL_VH + (16 * s4) * 64), hi = tr_read8(vb + dh * DL_VH + (16 * s4 + 8) * 64);
                    bf16x8 af; af[0] = lo[0]; af[1] = lo[1]; af[2] = lo[2]; af[3] = lo[3]; af[4] = hi[0]; af[5] = hi[1]; af[6] = hi[2]; af[7] = hi[3];
                    O[dh] = __builtin_amdgcn_mfma_f32_32x32x16_bf16(af, pk[s4], O[dh], 0, 0, 0);
                }
        }
        const float lt = l + xor32(l);
        const size_t row = (size_t)U.b * SEQ + U.res + ((size_t)qs << U.sh);
        bf16_t* orow = (U.p == 0) ? (OP0 + row * D + U.hd * 64) : (OP12 + ((size_t)(U.p - 1) * T + row) * 512 + U.hd * 64);
        store_ot(O, frcp(lt), orow, lane);
        if (hh == 0) LSE[((size_t)U.p * T + row) * 8 + U.hd] = m + __logf(lt);
        U = NU;
    }
}
__device__ __forceinline__ void phase_dil_combine(Frame& F) {
    frame_refresh(F);
    const int gw = F.vcu * NWAVES + F.wave, NGW = F.G * NWAVES, lane = F.lane;
    bf16_t* OP0 = (bf16_t*)(F.ws + WS_MIX); const bf16_t* OP12 = (const bf16_t*)(F.ws + WS_HBUF); const float* LSE = (const float*)(F.ws + WS_LIST);
    for (int blk = gw; blk < T / 32; blk += NGW) {
#pragma unroll 1
        for (int r = 0; r < 32; r += 2) {
            u32x4 o[2][3]; float ls[2][3];
#pragma unroll
            for (int q = 0; q < 2; ++q) { const size_t row = (size_t)blk * 32 + r + q;
                o[q][0] = *(const u32x4*)(OP0 + row * D + 8 * lane); o[q][1] = *(const u32x4*)(OP12 + row * 512 + 8 * lane); o[q][2] = *(const u32x4*)(OP12 + ((size_t)T + row) * 512 + 8 * lane);
#pragma unroll
                for (int p = 0; p < 3; ++p) ls[q][p] = LSE[((size_t)p * T + row) * 8 + (lane >> 3)]; }
#pragma unroll
            for (int q = 0; q < 2; ++q) { const size_t row = (size_t)blk * 32 + r + q;
                const float M = fmaxf(ls[q][0], fmaxf(ls[q][1], ls[q][2]));
                float w0 = __expf(ls[q][0] - M), w1 = __expf(ls[q][1] - M), w2 = __expf(ls[q][2] - M); const float inv = frcp(w0 + w1 + w2); w0 *= inv; w1 *= inv; w2 *= inv;
                u32x4 res;
#pragma unroll
                for (int e = 0; e < 4; ++e) { const unsigned a0 = o[q][0][e], a1 = o[q][1][e], a2 = o[q][2][e];
                    res[e] = pk2(bf_lo(a0) * w0 + bf_lo(a1) * w1 + bf_lo(a2) * w2, bf_hi(a0) * w0 + bf_hi(a1) * w1 + bf_hi(a2) * w2); }
                *(u32x4*)(OP0 + row * D + 8 * lane) = res; }
        }
    }
}

struct KRegs { u32x4 k[4]; };
__device__ __forceinline__ void stick_req_k(KRegs& R, const bf16_t* Pb, int ko, int tb, int lane) {
    const int r32 = lane & 31, hh = lane >> 5;
    int kt = tb + r32; kt = kt < 0 ? 0 : kt;
    const bf16_t* kp = Pb + (size_t)kt * NPROJ + ko + 8 * hh;
#pragma unroll
    for (int s4 = 0; s4 < 4; ++s4) R.k[s4] = *(const u32x4*)(kp + 16 * s4);
}
__device__ __forceinline__ void stick_req_v(const __amdgpu_buffer_rsrc_t rs, int vo, int tb, LAS char* slot, int lane) {
#pragma unroll
    for (int dh = 0; dh < 2; ++dh)
#pragma unroll
        for (int kh = 0; kh < 2; ++kh) { int vt = tb + 16 * kh + (lane >> 2); vt = vt < 0 ? 0 : vt;
            __builtin_amdgcn_raw_ptr_buffer_load_lds(rs, (LAS void*)(slot + dh * 2048 + kh * 1024), 16, (vt * NPROJ + vo + dh * 32 + 8 * (lane & 3)) * 2, 0, 0, 0); }
}
__device__ __forceinline__ void stick_req(KRegs& R, const bf16_t* Pb, const __amdgpu_buffer_rsrc_t rs, int ko, int vo, int tb, LAS char* slot, int lane) {
    stick_req_k(R, Pb, ko, tb, lane); stick_req_v(rs, vo, tb, slot, lane);
}
__device__ __forceinline__ bool stick_tile(const KRegs& C, int tb, int tq, int lane, const bf16x8 (&qf)[4], float& carry, f32x16 (&O)[2], const LAS char* vimg, int nwait) {
    const int hh = lane >> 5;
    f32x16 S;
#pragma unroll
    for (int i = 0; i < 16; ++i) S[i] = 0.f;
#pragma unroll
    for (int s4 = 0; s4 < 4; ++s4) S = __builtin_amdgcn_mfma_f32_32x32x16_bf16(__builtin_bit_cast(bf16x8, C.k[s4]), qf[s4], S, 0, 0, 0);
    const int dist0 = tq - tb - 4 * hh;
    float lk[16];
#pragma unroll
    for (int i = 0; i < 16; ++i) { const int dist = dist0 - ((i & 3) + 8 * (i >> 2)); const bool valid = dist > 0;
        const float z = S[i] * 0.125f;
        const float sp = fmaxf(z, 0.f) + __logf(1.f + __expf(-fabsf(z)));
        lk[i] = valid ? -sp : 0.f; S[i] = valid ? (z - sp) : -1e30f; }
    float G[4], PG[4];
#pragma unroll
    for (int g = 0; g < 4; ++g) { G[g] = (lk[4 * g] + lk[4 * g + 1]) + (lk[4 * g + 2] + lk[4 * g + 3]); PG[g] = xor32(G[g]); }
    float after[4]; float run = 0.f;
#pragma unroll
    for (int g = 3; g >= 0; --g) { after[g] = run + (hh == 0 ? PG[g] : 0.f); run += G[g] + PG[g]; }
    float p[16];
#pragma unroll
    for (int g = 0; g < 4; ++g) { const float b3 = carry + after[g], b2 = b3 + lk[4 * g + 3], b1 = b2 + lk[4 * g + 2], b0 = b1 + lk[4 * g + 1];
        p[4 * g + 3] = __expf(S[4 * g + 3] + b3); p[4 * g + 2] = __expf(S[4 * g + 2] + b2); p[4 * g + 1] = __expf(S[4 * g + 1] + b1); p[4 * g] = __expf(S[4 * g] + b0); }
    carry += run;
    bf16x8 pk[2]; pack_p(p, pk);
    if (nwait >= 16) asm volatile("s_waitcnt vmcnt(16)" ::: "memory"); else if (nwait >= 8) asm volatile("s_waitcnt vmcnt(8)" ::: "memory"); else asm volatile("s_waitcnt vmcnt(0)" ::: "memory");
    pv_mma(O, pk, vimg, lane);
    return __all(carry < -110.f) != 0;
}
__device__ __forceinline__ void phase_stick(Frame& F) {
    frame_refresh(F);
    const int gw = F.vcu * NWAVES + F.wave, NGW = F.G * NWAVES, lane = F.lane, hh = lane >> 5;
    const bf16_t* P = (const bf16_t*)(F.ws + WS_PROJ); bf16_t* MIX = (bf16_t*)(F.ws + WS_MIX);
    LAS char* ring = (LAS char*)F.lds + F.wave * 12288;
    int wt = gw;
    bf16x8 qf[4]; KRegs R0, R1, R2;
    if (wt < 16384) { const int qt = wt & 127, hd = (wt >> 7) & 7, b = wt >> 10; const bf16_t* Pb = P + (size_t)b * SEQ * NPROJ;
#pragma unroll
        for (int s4 = 0; s4 < 4; ++s4) qf[s4] = *(const bf16x8*)(Pb + (size_t)(qt * 32 + (lane & 31)) * NPROJ + 1024 + hd * 64 + 16 * s4 + 8 * hh);
        stick_req_k(R0, Pb, 1536 + hd * 64, qt * 32, lane); stick_req_k(R1, Pb, 1536 + hd * 64, qt * 32 - 32, lane); }
    asm volatile("s_waitcnt lgkmcnt(0)" ::: "memory");
    for (; wt < 16384; wt += NGW) {
        const int qt = wt & 127, hd = (wt >> 7) & 7, b = wt >> 10;
        const int tq = qt * 32 + (lane & 31);
        const bf16_t* Pb = P + (size_t)b * SEQ * NPROJ;
        const __amdgpu_buffer_rsrc_t rs = __builtin_amdgcn_make_buffer_rsrc((void*)Pb, 0, 0x7fffffff, 0x00020000);
        const int ko = 1536 + hd * 64, vo = 2048 + hd * 64;
        float carry = 0.f; f32x16 O[2];
#pragma unroll
        for (int i = 0; i < 16; ++i) { O[0][i] = 0.f; O[1][i] = 0.f; }
        stick_req_v(rs, vo, qt * 32, ring, lane);
        if (qt >= 1) stick_req_v(rs, vo, qt * 32 - 32, ring + 4096, lane);
#pragma unroll 1
        for (int kt = qt; kt >= 0; kt -= 3) {
            if (kt >= 2) stick_req(R2, Pb, rs, ko, vo, (kt - 2) * 32, ring + 8192, lane);
            if (stick_tile(R0, kt * 32, tq, lane, qf, carry, O, ring, kt == qt ? (kt >= 2 ? 12 : (kt >= 1 ? 4 : 0)) : (kt >= 2 ? 16 : (kt >= 1 ? 8 : 0)))) break;
            if (kt < 1) break;
            if (kt >= 3) stick_req(R0, Pb, rs, ko, vo, (kt - 3) * 32, ring, lane);
            if (stick_tile(R1, (kt - 1) * 32, tq, lane, qf, carry, O, ring + 4096, kt >= 3 ? 16 : (kt >= 2 ? 8 : 0))) break;
            if (kt < 2) break;
            if (kt >= 4) stick_req(R1, Pb, rs, ko, vo, (kt - 4) * 32, ring + 4096, lane);
            if (stick_tile(R2, (kt - 2) * 32, tq, lane, qf, carry, O, ring + 8192, kt >= 4 ? 16 : (kt >= 3 ? 8 : 0))) break;
        }
        const int wn = wt + NGW;
        asm volatile("" ::: "memory");
        if (wn < 16384) { const int qn = wn & 127, hn = (wn >> 7) & 7, bn = wn >> 10; const bf16_t* Pn = P + (size_t)bn * SEQ * NPROJ;
#pragma unroll
            for (int s4 = 0; s4 < 4; ++s4) qf[s4] = *(const bf16x8*)(Pn + (size_t)(qn * 32 + (lane & 31)) * NPROJ + 1024 + hn * 64 + 16 * s4 + 8 * hh);
            stick_req_k(R0, Pn, 1536 + hn * 64, qn * 32, lane); stick_req_k(R1, Pn, 1536 + hn * 64, qn * 32 - 32, lane); }
        asm volatile("" ::: "memory");
        store_ot(O, 1.f, MIX + ((size_t)b * SEQ + tq) * D + 512 + hd * 64, lane);
        asm volatile("s_waitcnt vmcnt(20) lgkmcnt(0)" ::: "memory");
    }
}

__device__ __forceinline__ void phase_gmlp(Frame& F, const Args& a, int j2) {
    frame_refresh(F);
    const bf16_t* P = (const bf16_t*)(F.ws + WS_PROJ); bf16_t* MIX = (bf16_t*)(F.ws + WS_MIX);
    const bf16_t* WSM = (const bf16_t*)(F.ws + WS_WS) + (size_t)j2 * 4 * 128 * 128;
    const float* lng = a.in[9] + (size_t)j2 * 512; const float* lnb = a.in[10] + (size_t)j2 * 512; const float* bs = a.in[12] + (size_t)j2 * 4 * 128;
    constexpr int VP = 136;
    LAS bf16_t* vT = (LAS bf16_t*)F.lds;
    const int lane = F.lane, wave = F.wave;
    for (int ch = F.vcu; ch < T / 128; ch += F.G) {
        const int row0 = ch * 128;
        float lg[8], lb[8];
#pragma unroll
        for (int i = 0; i < 8; ++i) { lg[i] = lng[8 * lane + i]; lb[i] = lnb[8 * lane + i]; }
        u32x4 wv[16];
#pragma unroll
        for (int tt = 0; tt < 16; ++tt) wv[tt] = *(const u32x4*)(P + (size_t)(row0 + wave * 16 + tt) * NPROJ + 2048 + 8 * lane);
#pragma unroll
        for (int tt = 0; tt < 16; ++tt) asm volatile("" : "+v"(wv[tt]));
#pragma unroll
        for (int tt = 0; tt < 16; ++tt) { const int tl = wave * 16 + tt;
            const u32x4 w = wv[tt];
            float g[8]; g[0] = gelu_tanh(bf_lo(w.x)); g[1] = gelu_tanh(bf_hi(w.x)); g[2] = gelu_tanh(bf_lo(w.y)); g[3] = gelu_tanh(bf_hi(w.y));
            g[4] = gelu_tanh(bf_lo(w.z)); g[5] = gelu_tanh(bf_hi(w.z)); g[6] = gelu_tanh(bf_lo(w.w)); g[7] = gelu_tanh(bf_hi(w.w));
            float s = 0.f;
#pragma unroll
            for (int i = 0; i < 8; ++i) s += g[i];
            const float mu = wave_sum(s) * (1.f / 512.f); float s2 = 0.f;
#pragma unroll
            for (int i = 0; i < 8; ++i) { g[i] -= mu; s2 += g[i] * g[i]; }
            const float rstd = rsqrtf(wave_sum(s2) * (1.f / 512.f) + EPS);
#pragma unroll
            for (int i = 0; i < 8; ++i) { const float v = g[i] * rstd * lg[i] + lb[i]; vT[(8 * lane + i) * VP + tl] = (bf16_t)(pk2(v, 0.f) & 0xffffu); }
        }
        __syncthreads();
        const int g = wave >> 1, r32 = lane & 31, hh = lane >> 5;
        f32x16 accv[2][4];
#pragma unroll
        for (int ti = 0; ti < 2; ++ti) { const int tm = (wave & 1) + 2 * ti;
#pragma unroll
            for (int c4 = 0; c4 < 4; ++c4)
#pragma unroll
                for (int i = 0; i < 16; ++i) accv[ti][c4][i] = 0.f;
            const int nks = 2 * (tm + 1);
            bf16x8 afr[8];
#pragma unroll
            for (int ks = 0; ks < 8; ++ks) { const int kc = ks < nks ? ks : 0; afr[ks] = *(const bf16x8*)(WSM + ((size_t)g * 128 + tm * 32 + r32) * 128 + kc * 16 + 8 * hh); }
#pragma unroll
            for (int ks = 0; ks < 8; ++ks) asm volatile("" : "+v"(afr[ks]));
#pragma unroll
            for (int ks = 0; ks < 8; ++ks) { if (ks < nks) {
#pragma unroll
                for (int c4 = 0; c4 < 4; ++c4) { const bf16x8 bfv = *(const LAS bf16x8*)(vT + (g * 128 + c4 * 32 + r32) * VP + ks * 16 + 8 * hh);
                    accv[ti][c4] = __builtin_amdgcn_mfma_f32_32x32x16_bf16(afr[ks], bfv, accv[ti][c4], 0, 0, 0); } } }
        }
        __syncthreads();
        constexpr int OP = 520;
        LAS bf16_t* outL = (LAS bf16_t*)F.lds;
#pragma unroll
        for (int ti = 0; ti < 2; ++ti) { const int tm = (wave & 1) + 2 * ti;
#pragma unroll
            for (int i = 0; i < 16; ++i) { const int tl = tm * 32 + (i & 3) + 8 * (i >> 2) + 4 * hh; const float bsv = bs[g * 128 + tl];
#pragma unroll
                for (int c4 = 0; c4 < 4; ++c4) outL[tl * OP + g * 128 + c4 * 32 + r32] = (bf16_t)(pk2(accv[ti][c4][i] + bsv, 0.f) & 0xffffu); } }
        __syncthreads();
        { u32x4 uv[16];
#pragma unroll
          for (int tt = 0; tt < 16; ++tt) uv[tt] = *(const u32x4*)(P + (size_t)(row0 + wave * 16 + tt) * NPROJ + 1536 + 8 * lane);
#pragma unroll
          for (int tt = 0; tt < 16; ++tt) asm volatile("" : "+v"(uv[tt]));
#pragma unroll
          for (int tt = 0; tt < 16; ++tt) { const int tl = wave * 16 + tt; const u32x4 m = *(const LAS u32x4*)(outL + tl * OP + 8 * lane); const u32x4 u = uv[tt];
              u32x4 o;
#pragma unroll
              for (int e = 0; e < 4; ++e) o[e] = pk2(gelu_tanh(bf_lo(u[e])) * bf_lo(m[e]), gelu_tanh(bf_hi(u[e])) * bf_hi(m[e]));
              *(u32x4*)(MIX + (size_t)(row0 + tl) * D + 512 + 8 * lane) = o; } }
        __syncthreads();
    }
}

template <bool OUT>
__device__ __forceinline__ void conv_chunk(const bf16_t* P, int row0, int tseq0, int tl0, int c0, float (&x0)[32], float (&x1)[32], const float (&w0)[31], const float (&w1)[31], float bd0, float bd1, LAS float* tile) {
    unsigned av[32], gv[32];
#pragma unroll
    for (int i = 0; i < 32; ++i) { int tl = tl0 + i; tl = (tseq0 + tl < 0) ? -tseq0 : tl;
        const bf16_t* pr = P + (size_t)(row0 + tl) * NPROJ; av[i] = *(const unsigned*)(pr + c0); gv[i] = *(const unsigned*)(pr + 512 + c0); }
#pragma unroll
    for (int i = 0; i < 32; ++i) asm volatile("" : "+v"(av[i]), "+v"(gv[i]));
#pragma unroll
    for (int i = 0; i < 32; ++i) { const int tl = tl0 + i; const bool ok = (tseq0 + tl >= 0);
        const float h0 = ok ? bf_lo(av[i]) * sigmoid_f(bf_lo(gv[i])) : 0.f, h1 = ok ? bf_hi(av[i]) * sigmoid_f(bf_hi(gv[i])) : 0.f;
        x0[i] = h0; x1[i] = h1;
        if (OUT) { float o0 = bd0, o1 = bd1;
#pragma unroll
            for (int j = 0; j < 31; ++j) { o0 += w0[j] * x0[(i + 2 + j) & 31]; o1 += w1[j] * x1[(i + 2 + j) & 31]; }
            *(LAS f32x2*)(tile + i * 512 + c0) = (f32x2){o0, o1}; }
    }
}
__device__ __forceinline__ void phase_conv(Frame& F, const Args& a, int j2) {
    frame_refresh(F);
    const bf16_t* P = (const bf16_t*)(F.ws + WS_PROJ); bf16_t* MIX = (bf16_t*)(F.ws + WS_MIX);
    const float* wdw = a.in[15] + (size_t)j2 * 31 * 512; const float* bdw = a.in[16] + (size_t)j2 * 512;
    const float* lng = a.in[17] + (size_t)j2 * 512; const float* lnb = a.in[18] + (size_t)j2 * 512;
    const int half = F.tid >> 8, ht = F.tid & 255, c0 = 2 * ht;
    LAS float* tile = (LAS float*)F.lds + half * (32 * 512);
    float w0[31], w1[31];
#pragma unroll
    for (int j = 0; j < 31; ++j) { w0[j] = wdw[j * 512 + c0]; w1[j] = wdw[j * 512 + c0 + 1]; }
    const float bd0 = bdw[c0], bd1 = bdw[c0 + 1];
    const int wih = F.wave & 3;
    for (int s0 = F.vcu * 2; s0 < T / 128; s0 += F.G * 2) {
        const int seg = s0 + half;
        const int row0 = seg * 128, tseq0 = row0 & (SEQ - 1);
        float x0[32], x1[32];
        conv_chunk<false>(P, row0, tseq0, -32, c0, x0, x1, w0, w1, bd0, bd1, tile);
#pragma unroll 1
        for (int cb = 0; cb < 4; ++cb) {
            conv_chunk<true>(P, row0, tseq0, cb * 32, c0, x0, x1, w0, w1, bd0, bd1, tile);
            __syncthreads();
            for (int rr = wih; rr < 32; rr += 4) { const LAS float* tr = tile + rr * 512 + 8 * F.lane; float v[8]; float s = 0.f;
#pragma unroll
                for (int e = 0; e < 8; ++e) { v[e] = tr[e]; s += v[e]; }
                const float mu = wave_sum(s) * (1.f / 512.f); float s2 = 0.f;
#pragma unroll
                for (int e = 0; e < 8; ++e) { v[e] -= mu; s2 += v[e] * v[e]; }
                const float rstd = rsqrtf(wave_sum(s2) * (1.f / 512.f) + EPS);
                float o[8];
#pragma unroll
                for (int e = 0; e < 8; ++e) o[e] = silu_f(v[e] * rstd * lng[8 * F.lane + e] + lnb[8 * F.lane + e]);
                u32x4 ow; ow.x = pk2(o[0], o[1]); ow.y = pk2(o[2], o[3]); ow.z = pk2(o[4], o[5]); ow.w = pk2(o[6], o[7]);
                *(u32x4*)(MIX + (size_t)(row0 + cb * 32 + rr) * D + 8 * F.lane) = ow; }
            __syncthreads();
        }
    }
}

__device__ __forceinline__ void phase_router(Frame& F, const Args& a, int l, const float* xin) {
    frame_refresh(F);
    LAS float* wl = (LAS float*)F.lds;
    LAS int* cls_s = (LAS int*)(F.lds + 81920);
    LAS int* pos_s = cls_s + 256;
    LAS int* lcnt = pos_s + 256;
    LAS int* lbase = lcnt + 32;
    const float* wg = a.in[19] + (size_t)l * 1024 * 4; const float* wrt = a.in[21] + (size_t)l * 4 * 1024 * 4;
    { f32x4 wv[10];
#pragma unroll
      for (int p = 0; p < 10; ++p) { const int q = F.tid + NTHREADS * p; wv[p] = (q < 1024) ? ((const f32x4*)wg)[q] : ((const f32x4*)wrt)[q - 1024]; }
#pragma unroll
      for (int p = 0; p < 10; ++p) { const int q = F.tid + NTHREADS * p, g5 = q >> 10, k = q & 1023;
          wl[(4 * g5 + 0) * 1024 + k] = wv[p].x; wl[(4 * g5 + 1) * 1024 + k] = wv[p].y; wl[(4 * g5 + 2) * 1024 + k] = wv[p].z; wl[(4 * g5 + 3) * 1024 + k] = wv[p].w; } }
    __syncthreads();
    const float* MOD = (const float*)(F.ws + WS_MOD) + (size_t)l * 16 * 6144;
    const float* gam = a.in[4] + (size_t)l * D; const float* bg = a.in[20] + l * 4; const float* br = a.in[22] + l * 16;
    bf16_t* HB = (bf16_t*)(F.ws + WS_HBUF); float* RW = (float*)(F.ws + WS_RW); int* SINFO = (int*)(F.ws + WS_LIST);
    unsigned char* H8 = F.ws + WS_H8; int* TLIST = (int*)(F.ws + WS_TLIST);
    unsigned* cnt = (unsigned*)(F.ws + WS_CTL) + CW_CNT + l * NCLS * 64;
    const float* x = a.in[0]; bf16_t* XB = (bf16_t*)(F.ws + WS_XB); const bool first = (l == 0);
    const f32x4 one4[4] = {{1.f, 1.f, 1.f, 1.f}, {1.f, 1.f, 1.f, 1.f}, {1.f, 1.f, 1.f, 1.f}, {1.f, 1.f, 1.f, 1.f}};
    const int lane = F.lane;
    for (int rb = F.vcu; rb < T / 256; rb += F.G) {
        if (F.tid < 32) lcnt[F.tid] = 0;
        __syncthreads();
        const int rowb = rb * 256 + F.wave * 32, b = rowb >> 12;
        f32x4 gp[4], shv[4]; load_mod(gam, MOD + (size_t)b * 6144 + 3072, MOD + (size_t)b * 6144 + 4096, lane, gp, shv);
        f32x4 h0[4], h1[4], n0[4], n1[4]; u32x2 d0[4], d1[4], nd0[4], nd1[4];
        if (first) { load_row(x + (size_t)rowb * D, lane, h0); load_row(x + (size_t)(rowb + 1) * D, lane, h1); } else { load_row_bf(XB + (size_t)rowb * D, lane, h0); load_row_bf(XB + (size_t)(rowb + 1) * D, lane, h1); }
        load_y(HB + (size_t)rowb * D, lane, d0); load_y(HB + (size_t)(rowb + 1) * D, lane, d1);
#pragma unroll 1
        for (int it = 0; it < 16; ++it) {
            const int rl0 = F.wave * 32 + it * 2, row0 = rb * 256 + rl0;
            if (it + 1 < 16) { if (first) { load_row(x + (size_t)(row0 + 2) * D, lane, n0); load_row(x + (size_t)(row0 + 3) * D, lane, n1); } else { load_row_bf(XB + (size_t)(row0 + 2) * D, lane, n0); load_row_bf(XB + (size_t)(row0 + 3) * D, lane, n1); }
                load_y(HB + (size_t)(row0 + 2) * D, lane, nd0); load_y(HB + (size_t)(row0 + 3) * D, lane, nd1); }
            add_y(h0, d0, one4); add_y(h1, d1, one4);
            store_row_bf16(XB + (size_t)row0 * D, lane, h0); store_row_bf16(XB + (size_t)(row0 + 1) * D, lane, h1);
            const float r0 = row_rstd(h0), r1 = row_rstd(h1);
#pragma unroll
            for (int j = 0; j < 4; ++j) { h0[j] = h0[j] * r0 * gp[j] + shv[j]; h1[j] = h1[j] * r1 * gp[j] + shv[j]; }
            store_row_fp8(H8 + (size_t)row0 * D, lane, h0, SC_H2); store_row_fp8(H8 + (size_t)(row0 + 1) * D, lane, h1, SC_H2);
            float lg[2][20];
#pragma unroll
            for (int c = 0; c < 20; c += 4) {
                f32x4 w[4][4];
#pragma unroll
                for (int cc = 0; cc < 4; ++cc)
#pragma unroll
                    for (int j = 0; j < 4; ++j) w[cc][j] = *(const LAS f32x4*)(wl + (c + cc) * 1024 + 4 * lane + 256 * j);
#pragma unroll
                for (int cc = 0; cc < 4; ++cc)
#pragma unroll
                    for (int j = 0; j < 4; ++j) asm volatile("" : "+v"(w[cc][j]));
#pragma unroll
                for (int cc = 0; cc < 4; ++cc) { float s0 = 0.f, s1 = 0.f;
#pragma unroll
                    for (int j = 0; j < 4; ++j) { const f32x4 wv = w[cc][j];
                        s0 += h0[j].x * wv.x + h0[j].y * wv.y + h0[j].z * wv.z + h0[j].w * wv.w;
                        s1 += h1[j].x * wv.x + h1[j].y * wv.y + h1[j].z * wv.z + h1[j].w * wv.w; }
                    lg[0][c + cc] = wave_sum(s0); lg[1][c + cc] = wave_sum(s1); } }
#pragma unroll
            for (int r = 0; r < 2; ++r) {
                float gl[4];
#pragma unroll
                for (int i = 0; i < 4; ++i) gl[i] = lg[r][i] + bg[i];
                int gi = 0; float gm = gl[0];
#pragma unroll
                for (int i = 1; i < 4; ++i) if (gl[i] > gm) { gm = gl[i]; gi = i; }
                float gs = 0.f;
#pragma unroll
                for (int i = 0; i < 4; ++i) gs += __expf(gl[i] - gm);
                const float gwt = 1.f / gs;
                float el[4];
#pragma unroll
                for (int e = 0; e < 4; ++e) { const float v = (gi == 0) ? lg[r][4 + e] : (gi == 1) ? lg[r][8 + e] : (gi == 2) ? lg[r][12 + e] : lg[r][16 + e]; el[e] = v + br[gi * 4 + e]; }
                int ea = 0; float va = el[0];
#pragma unroll
                for (int e = 1; e < 4; ++e) if (el[e] > va) { va = el[e]; ea = e; }
                int eb = -1; float vb = -3.0e38f;
#pragma unroll
                for (int e = 0; e < 4; ++e) if (e != ea && el[e] > vb) { vb = el[e]; eb = e; }
                const float wa = 1.f / (1.f + __expf(vb - va)), wb = 1.f - wa;
                const int lo = ea < eb ? ea : eb, hi = ea < eb ? eb : ea;
                const int pidx = (lo == 0) ? hi - 1 : (lo == 1 ? hi + 1 : 5);
                const int cls = gi * 6 + pidx;
                const float wlo = gwt * (ea == lo ? wa : wb), whi = gwt * (ea == lo ? wb : wa);
                if (lane == 0) { cls_s[rl0 + r] = cls; *(f32x2*)(RW + (size_t)(row0 + r) * 2) = (f32x2){wlo, whi}; }
            }
#pragma unroll
            for (int j = 0; j < 4; ++j) { h0[j] = n0[j]; h1[j] = n1[j]; d0[j] = nd0[j]; d1[j] = nd1[j]; }
        }
        __syncthreads();
        if (F.tid < 256) pos_s[F.tid] = atomicAdd((int*)&lcnt[cls_s[F.tid]], 1);
        __syncthreads();
        if (F.tid < NCLS) lbase[F.tid] = (int)__hip_atomic_fetch_add(cnt + F.tid * 64, (unsigned)lcnt[F.tid], __ATOMIC_RELAXED, __HIP_MEMORY_SCOPE_AGENT);
        __syncthreads();
        if (F.tid < 256) { const int c = cls_s[F.tid], pos = lbase[c] + pos_s[F.tid]; SINFO[rb * 256 + F.tid] = (c << 16) | pos;
            __hip_atomic_store(TLIST + (size_t)c * T + pos, rb * 256 + F.tid, __ATOMIC_RELAXED, __HIP_MEMORY_SCOPE_AGENT); }
        __syncthreads();
    }
}

__device__ __forceinline__ void build_moe_table(Frame& F, int l) {
    frame_refresh(F);
    LAS int* tbl = (LAS int*)(F.lds + 131072);
    unsigned* cnt = (unsigned*)(F.ws + WS_CTL) + CW_CNT + l * NCLS * 64;
    if (F.tid == 0) { int acc = 0;
        for (int c = 0; c < NCLS; ++c) { const int n = (int)__hip_atomic_load(cnt + c * 64, __ATOMIC_RELAXED, __HIP_MEMORY_SCOPE_AGENT); tbl[c] = acc; tbl[32 + c] = n; acc += (n + 255) >> 8; }
        tbl[24] = acc; }
    __syncthreads();
    if (F.tid < 320) { const int mt = F.tid; int cls = 0;
        for (int k = 1; k < NCLS; ++k) if (tbl[k] <= mt) cls = k;
        tbl[64 + mt] = cls; }
    __syncthreads();
}

__device__ __forceinline__ void phase_final(Frame& F, const Args& a) {
    frame_refresh(F);
    const int gw = F.vcu * NWAVES + F.wave, NGW = F.G * NWAVES, lane = F.lane;
    const float* MOD = (const float*)(F.ws + WS_MOD) + (size_t)3 * 16 * 6144;
    const bf16_t* Y2 = (const bf16_t*)(F.ws + WS_HSORT); const int* SINFO = (const int*)(F.ws + WS_LIST);
    const LAS int* tbl = (const LAS int*)(F.lds + 131072);
    f32x4 g4[4];
#pragma unroll
    for (int j = 0; j < 4; ++j) g4[j] = ((const f32x4*)a.in[26])[lane + 64 * j];
    for (int blk = gw; blk < T / 32; blk += NGW) {
        const int row0 = blk * 32, b = row0 >> 12;
        f32x4 g2[4];
#pragma unroll
        for (int j = 0; j < 4; ++j) g2[j] = ((const f32x4*)(MOD + (size_t)b * 6144 + 5120))[lane + 64 * j];
        const int si = SINFO[row0 + (lane & 31)]; const int slotv = tbl[si >> 16] * 256 + (si & 0xffff);
        f32x4 xa[4], xb[4], na[4], nb[4]; u32x2 ya[4], yb[4], nya[4], nyb[4];
        const bf16_t* XB = (const bf16_t*)(F.ws + WS_XB); load_row_bf(XB + (size_t)row0 * D, lane, xa); load_row_bf(XB + (size_t)(row0 + 1) * D, lane, xb);
        load_y(Y2 + (size_t)__builtin_amdgcn_readlane(slotv, 0) * D, lane, ya); load_y(Y2 + (size_t)__builtin_amdgcn_readlane(slotv, 1) * D, lane, yb);
#pragma unroll 1
        for (int r = 0; r < 32; r += 2) {
            if (r + 2 < 32) { load_row_bf(XB + (size_t)(row0 + r + 2) * D, lane, na); load_row_bf(XB + (size_t)(row0 + r + 3) * D, lane, nb);
                load_y(Y2 + (size_t)__builtin_amdgcn_readlane(slotv, r + 2) * D, lane, nya); load_y(Y2 + (size_t)__builtin_amdgcn_readlane(slotv, r + 3) * D, lane, nyb); }
            add_y(xa, ya, g2); add_y(xb, yb, g2);
            const float ra = row_rstd(xa), rb = row_rstd(xb);
            f32x4* oa = (f32x4*)(a.out + (size_t)(row0 + r) * D) + lane; f32x4* ob = (f32x4*)(a.out + (size_t)(row0 + r + 1) * D) + lane;
#pragma unroll
            for (int j = 0; j < 4; ++j) { oa[64 * j] = xa[j] * ra * g4[j]; ob[64 * j] = xb[j] * rb * g4[j]; }
#pragma unroll
            for (int j = 0; j < 4; ++j) { xa[j] = na[j]; xb[j] = nb[j]; ya[j] = nya[j]; yb[j] = nyb[j]; }
        }
    }
}

constexpr int NPHASE = 34;
#ifndef PHMASK
#define PHMASK 0xFFFFu
#endif
#define PHON(b) ((PHMASK >> (b)) & 1u)
#ifndef REPMASK
#define REPMASK 0u
#endif
#ifndef REPN
#define REPN 1
#endif
#define NREP(b) (((REPMASK >> (b)) & 1u) ? (1 + REPN) : 1)
#ifndef TIMEMASK
#define TIMEMASK 0u
#endif
#ifndef TIMEK
#define TIMEK 4
#endif
#define TIMEON(b) ((TIMEMASK >> (b)) & 1u)
#define TBEG(b) do { if (TIMEON(b)) t_beg = __builtin_amdgcn_s_memrealtime(); } while (0)
#define TEND(b) do { if (TIMEON(b)) t_acc += __builtin_amdgcn_s_memrealtime() - t_beg; } while (0)

__global__ void __launch_bounds__(NTHREADS, 2) fwd_kernel(Args args) {
    extern __shared__ __attribute__((aligned(16))) unsigned char lds_raw[];
    Frame F;
    F.lds = (LAS unsigned char*)lds_raw;
    F.tid = threadIdx.x; F.lane = F.tid & 63; F.wave = __builtin_amdgcn_readfirstlane(F.tid >> 6);
    F.G = gridDim.x; { const int bx = blockIdx.x; F.vcu = (F.G % 8 == 0) ? (bx % 8) * (F.G / 8) + bx / 8 : bx; }
    F.ws = args.ws;
    volatile LAS unsigned* MISC = (volatile LAS unsigned*)(F.lds + MISC_OFF);
    for (int u = F.tid; u < 256; u += NTHREADS) MISC[u] = 0u;
    __syncthreads();
    unsigned* ctl = (unsigned*)(F.ws + WS_CTL);
    const int lo = args.ph_lo, hi = args.ph_hi;
    const bool multi = (hi - lo) > 1;
    XcdBarrier bar; bar.bar = ctl + CW_BAR; bar.x = 0; bar.st = nullptr;
    if (multi) bar = xcd_barrier_post(ctl + CW_BAR, MISC + 8);
#define IN(k) (lo <= (k) && (k) < hi)
#define SEAM(k) do { if (IN(k) && IN((k) + 1)) xcd_barrier(bar); } while (0)

    unsigned long long t_beg = 0, t_acc = 0;
    TBEG(0);
    if (PHON(0) && IN(0)) { for (int rep = 0; rep < NREP(0); ++rep) { phase_prologue(F, args); __syncthreads(); } }
    SEAM(0);
    TEND(0);

    const float* MODB = (const float*)(F.ws + WS_MOD);
#pragma unroll 1
    for (int l = 0; l < NL; ++l) {
        const int pb = 1 + 8 * l;
        const float* xin = (l == 0) ? args.in[0] : args.out;
        TBEG(1);
        if (PHON(1) && IN(pb + 0)) { if (l > 0) build_moe_table(F, l - 1); phase_norm1(F, args, l); }
        SEAM(pb + 0);
        TEND(1);
        TBEG(2);
        if (PHON(2) && IN(pb + 1)) {
            pg8::DenseSched S{(const char*)(F.ws + WS_HBUF), (const char*)(F.ws + WS_WIN) + (size_t)l * NPROJ * 1024 * 2, T / 256, NPROJ / 256, F.G, (int)blockIdx.x, 2048, 2048};
            pg8::EpiBf16Store E{(bf16_t*)(F.ws + WS_PROJ), NPROJ, 1.f};
            for (int rep = 0; rep < NREP(2); ++rep) pg8::gemm_phase<pg8::EpiBf16Store, pg8::DenseSched, false>(F.lds, 2048, 2048, S, E);
        }
        SEAM(pb + 1);
        TEND(2);
        TBEG(3);
        if (IN(pb + 2)) { if (l & 1) { if (PHON(3)) for (int rep = 0; rep < NREP(3); ++rep) { phase_conv(F, args, l >> 1); __syncthreads(); } } else { if (PHON(4)) for (int rep = 0; rep < NREP(4); ++rep) { phase_dilated2(F, args); __syncthreads(); } } }
        if (l & 1) __syncthreads(); else SEAM(pb + 2);
        TEND(3);
        TBEG(5);
        if (IN(pb + 3)) { if (l & 1) { if (PHON(5)) for (int rep = 0; rep < NREP(5); ++rep) { phase_stick(F); __syncthreads(); } } else { if (PHON(6)) for (int rep = 0; rep < NREP(6); ++rep) { phase_gmlp(F, args, l >> 1); __syncthreads(); } if (PHON(4)) phase_dil_combine(F); } }
        SEAM(pb + 3);
        TEND(5);
        TBEG(7);
        if (PHON(7) && IN(pb + 4)) {
            pg8::DenseSched S{(const char*)(F.ws + WS_MIX), (const char*)(F.ws + WS_WOUT) + (size_t)l * 1024 * 1024 * 2, T / 256, D / 256, F.G, (int)blockIdx.x, 2048, 2048};
            pg8::EpiDelta E{(bf16_t*)(F.ws + WS_HBUF), MODB + (size_t)l * 16 * 6144 + 2048};
            for (int rep = 0; rep < NREP(7); ++rep) pg8::gemm_phase<pg8::EpiDelta, pg8::DenseSched, false>(F.lds, 2048, 2048, S, E);
        }
        SEAM(pb + 4);
        TEND(7);
        TBEG(8);
        if (PHON(8) && IN(pb + 5)) phase_router(F, args, l, xin);
        SEAM(pb + 5);
        TEND(8);
        TBEG(9);
        if (PHON(9) && IN(pb + 6)) {
            build_moe_table(F, l);
            pg8::MoeSched1 S{(const char*)(F.ws + WS_H8), (const char*)(F.ws + WS_WGU) + (size_t)l * 16 * 1024 * 1024, (const char*)(F.ws + WS_TLIST), (const LAS int*)(F.lds + 131072), F.G, (int)blockIdx.x};
            pg8::EpiHid E{F.ws + WS_PROJ, (const float*)(F.ws + WS_RW), 1.f / (SC_H2 * SC_WGU), SC_HID};
            for (int rep = 0; rep < NREP(9); ++rep) pg8::gemm_phase<pg8::EpiHid, pg8::MoeSched1, true, true>(F.lds, 1024, 1024, S, E);
        }
        SEAM(pb + 6);
        TEND(9);
        TBEG(10);
        if (PHON(10) && IN(pb + 7)) {
            build_moe_table(F, l);
            pg8::MoeSched2 S{(const char*)(F.ws + WS_PROJ), (const char*)(F.ws + WS_WDT) + (size_t)l * 1024 * 8192, (const LAS int*)(F.lds + 131072), F.G, (int)blockIdx.x};
            pg8::EpiBf16Store E{(bf16_t*)(F.ws + WS_HSORT), D, 1.f / (SC_HID * SC_WD)};
            for (int rep = 0; rep < NREP(10); ++rep) pg8::gemm_phase<pg8::EpiBf16Store, pg8::MoeSched2, true>(F.lds, 1024, 8192, S, E);
        }
        SEAM(pb + 7);
        TEND(10);
    }
    TBEG(11);
    if (PHON(11) && IN(33)) { build_moe_table(F, NL - 1); phase_final(F, args); }
    TEND(11);
    if (TIMEMASK != 0u && blockIdx.x == 0) {
        const unsigned long long t0 = __builtin_amdgcn_s_memrealtime();
        while (__builtin_amdgcn_s_memrealtime() - t0 < (unsigned long long)TIMEK * t_acc) __builtin_amdgcn_s_sleep(8);
    }
#undef IN
#undef SEAM
}

extern "C" void kernel_launch(void* const* d_in, const int* in_sizes, int n_in, void* d_out, int out_size, void* d_ws, size_t ws_size, hipStream_t stream) {
    static int grid = 0;
    if (grid == 0) {
        if (n_in != 27 || out_size != T * D || ws_size < WS_END) { fprintf(stderr, "kernel_launch: unexpected shapes (n_in %d out %d ws %zu)\n", n_in, out_size, ws_size); grid = -1; return; }
        int dev = 0, cus = 0, per_cu = 0;
        if (hipGetDevice(&dev) != hipSuccess || hipDeviceGetAttribute(&cus, hipDeviceAttributeMultiprocessorCount, dev) != hipSuccess) { grid = -1; return; }
        if (hipFuncSetAttribute((const void*)fwd_kernel, hipFuncAttributeMaxDynamicSharedMemorySize, LDS_BYTES) != hipSuccess) { fprintf(stderr, "kernel_launch: hipFuncSetAttribute failed\n"); grid = -1; return; }
        if (hipOccupancyMaxActiveBlocksPerMultiprocessor(&per_cu, (const void*)fwd_kernel, NTHREADS, LDS_BYTES) != hipSuccess || per_cu < 1) { fprintf(stderr, "kernel_launch: occupancy query says %d\n", per_cu); }
        (void)hipGetLastError();
        grid = cus;
    }
    if (grid < 0) return;
    (void)hipMemsetAsync((char*)d_ws + WS_CTL, 0, CTL_ZERO_BYTES, stream);
    Args a{};
    for (int i = 0; i < 27; ++i) a.in[i] = (const float*)d_in[i];
    a.out = (float*)d_out; a.ws = (unsigned char*)d_ws;
#ifndef MK_MULTI
    a.ph_lo = 0; a.ph_hi = NPHASE;
    hipLaunchKernelGGL(fwd_kernel, dim3(grid), dim3(NTHREADS), LDS_BYTES, stream, a);
#else
    for (int p = 0; p < NPHASE; ++p) { a.ph_lo = p; a.ph_hi = p + 1; hipLaunchKernelGGL(fwd_kernel, dim3(grid), dim3(NTHREADS), LDS_BYTES, stream, a); }
#endif
}
```

```cpp
#include <hip/hip_runtime.h>
#include <cstdio>
#include <cstdint>

#define LAS __attribute__((address_space(3)))
#define GAS __attribute__((address_space(1)))
typedef unsigned short bf16_t;
typedef short bf16x8 __attribute__((ext_vector_type(8)));
typedef float f32x4 __attribute__((ext_vector_type(4)));
typedef float f32x2 __attribute__((ext_vector_type(2)));
typedef float f32x16 __attribute__((ext_vector_type(16)));
typedef unsigned u32x4 __attribute__((ext_vector_type(4)));
typedef unsigned u32x2 __attribute__((ext_vector_type(2)));
typedef __bf16 bf16x2v __attribute__((ext_vector_type(2)));

constexpr int T = 65536, D = 1024, SEQ = 4096, NBATCH = 16, NL = 4, NPROJ = 2560, NEXP = 16, DE = 512, NCLS = 24;
constexpr float EPS = 1e-6f;
constexpr int NWAVES = 8, NTHREADS = 512;
constexpr float SC_H2 = 4.f, SC_WGU = 128.f, SC_HID = 8.f, SC_WD = 64.f;

constexpr size_t MiB = 1u << 20;
constexpr size_t WS_CTL = 0, CTL_ZERO_BYTES = 1 * MiB;
constexpr size_t WS_WIN = 2 * MiB;
constexpr size_t WS_WOUT = 22 * MiB;
constexpr size_t WS_WS = 30 * MiB;
constexpr size_t WS_MOD = 31 * MiB;
constexpr size_t WS_RW = 33 * MiB;
constexpr size_t WS_LIST = 34 * MiB;
constexpr size_t WS_WGU = 40 * MiB;
constexpr size_t WS_WDT = 168 * MiB;
constexpr size_t WS_HBUF = 232 * MiB;
constexpr size_t WS_MIX = 360 * MiB;
constexpr size_t WS_PROJ = 488 * MiB;
constexpr size_t WS_XB = 808 * MiB;
constexpr size_t WS_END = 936 * MiB;
constexpr int HID_ROWS = T + NCLS * 256;
constexpr size_t WS_TLIST = WS_PROJ + 80 * MiB;
constexpr size_t WS_H8 = WS_MIX;
constexpr size_t WS_HSORT = WS_PROJ + 160 * MiB;
constexpr int CW_BAR = 4096;
constexpr int CW_CNT = 8192;

constexpr int LDS_BYTES = 155648;
constexpr int MISC_OFF = LDS_BYTES - 1024;

__device__ __forceinline__ unsigned pk2(float a, float b) { f32x2 v = {a, b}; bf16x2v r = __builtin_convertvector(v, bf16x2v); return __builtin_bit_cast(unsigned, r); }
__device__ __forceinline__ float bf_lo(unsigned u) { return __uint_as_float(u << 16); }
__device__ __forceinline__ float bf_hi(unsigned u) { return __uint_as_float(u & 0xffff0000u); }
__device__ __forceinline__ float bf1(bf16_t b) { return __uint_as_float(((unsigned)b) << 16); }
template <int CTRL, int RM> __device__ __forceinline__ float dpp_mov0(float v) { return __builtin_bit_cast(float, __builtin_amdgcn_update_dpp(0, __builtin_bit_cast(int, v), CTRL, RM, 0xf, true)); }
__device__ __forceinline__ float wave_sum(float v) {
    v += dpp_mov0<0xB1, 0xf>(v); v += dpp_mov0<0x4E, 0xf>(v); v += dpp_mov0<0x141, 0xf>(v); v += dpp_mov0<0x140, 0xf>(v);
    v += dpp_mov0<0x142, 0xa>(v); v += dpp_mov0<0x143, 0xc>(v);
    return __builtin_bit_cast(float, __builtin_amdgcn_readlane(__builtin_bit_cast(int, v), 63));
}
__device__ __forceinline__ float frcp(float x) { return __builtin_amdgcn_rcpf(x); }
__device__ __forceinline__ float silu_f(float x) { return x * frcp(1.f + __expf(-x)); }
__device__ __forceinline__ float sigmoid_f(float x) { return frcp(1.f + __expf(-x)); }
__device__ __forceinline__ float gelu_tanh(float x) {
    const float u = 0.7978845608028654f * (x + 0.044715f * x * x * x);
    const float e = __expf(2.f * u);
    const float th = 1.f - 2.f * frcp(e + 1.f);
    return 0.5f * x * (1.f + th);
}
__device__ __forceinline__ unsigned pk_fp8x4(float a, float b, float c, float d) {
    a = fminf(fmaxf(a, -448.f), 448.f); b = fminf(fmaxf(b, -448.f), 448.f); c = fminf(fmaxf(c, -448.f), 448.f); d = fminf(fmaxf(d, -448.f), 448.f);
    unsigned w = 0; w = __builtin_amdgcn_cvt_pk_fp8_f32(a, b, w, false); w = __builtin_amdgcn_cvt_pk_fp8_f32(c, d, w, true); return w;
}
#define LDS_WAIT() asm volatile("s_waitcnt lgkmcnt(0)" ::: "memory")

#define XB_TMO      128
#define XB_XCNT(j)  (256  + 64 * (j))
#define XB_XSUB(j)  (1280 + 64 * (j))
#define XB_XGEN(j)  (2304 + 64 * (j))
#define XB_TOP      3328
#define XB_TOPGEN   3392
#define XCD_BAR_WORDS 3456
#define XB_SPIN_CAP (1u << 20)

__device__ __forceinline__ unsigned xb_ld(unsigned* p)              { return __hip_atomic_load(p, __ATOMIC_RELAXED, __HIP_MEMORY_SCOPE_AGENT); }
__device__ __forceinline__ unsigned xb_add(unsigned* p, unsigned v) { return __hip_atomic_fetch_add(p, v, __ATOMIC_RELAXED, __HIP_MEMORY_SCOPE_AGENT); }
__device__ __forceinline__ unsigned xb_xcc_id() { return (unsigned)__builtin_amdgcn_s_getreg((3 << 11) | 20) & 0xFu; }
#define XB_SPIN(cond, bar) do { unsigned _sp = 0; while (cond) { __builtin_amdgcn_s_sleep(1); \
    if ((++_sp & 255u) == 0u) { if (xb_ld(&(bar)[XB_TMO])) break; if (_sp > XB_SPIN_CAP) { atomicAdd(&(bar)[XB_TMO], 1u); break; } } } } while (0)

struct XcdBarrier { unsigned* bar; unsigned x; volatile LAS unsigned* st; };

__device__ __forceinline__ XcdBarrier xcd_barrier_post(unsigned* bar, volatile LAS unsigned* st) {
    XcdBarrier b; b.bar = bar; b.x = xb_xcc_id(); b.st = st;
    if (threadIdx.x == 0) (void)xb_add(&bar[XB_XCNT(b.x)], 1u);
    return b;
}
__device__ __forceinline__ void xcd_barrier_complete(unsigned* bar, unsigned x, unsigned& nloc, unsigned& nx) {
    const unsigned G = gridDim.x * gridDim.y * gridDim.z;
    unsigned sum, cnt, mine, sp = 0u;
    for (;;) {
        sum = 0u; cnt = 0u; mine = 0u;
#pragma unroll
        for (unsigned j = 0; j < 16; ++j) { const unsigned c = xb_ld(&bar[XB_XCNT(j)]); sum += c; cnt += (c > 0u) ? 1u : 0u; mine = (j == x) ? c : mine; }
        if (sum == G) break;
        __builtin_amdgcn_s_sleep(1);
        if ((++sp & 255u) == 0u) { if (xb_ld(&bar[XB_TMO])) break; if (sp > XB_SPIN_CAP) { atomicAdd(&bar[XB_TMO], 1u); break; } }
    }
    nloc = mine > 0u ? mine : 1u; nx = cnt > 0u ? cnt : 1u;
}
__device__ __forceinline__ void xcd_barrier(const XcdBarrier& b) {
    asm volatile("s_waitcnt vmcnt(0)" ::: "memory");
    __syncthreads();
    if (threadIdx.x == 0) {
        unsigned* bar = b.bar;
        __builtin_amdgcn_s_waitcnt(0);
        unsigned nloc = b.st[0], nx = b.st[1];
        if (nloc == 0u) { xcd_barrier_complete(bar, b.x, nloc, nx); b.st[0] = nloc; b.st[1] = nx; }
        const unsigned old = xb_add(&bar[XB_XSUB(b.x)], 1u);
        const unsigned gen = old / nloc;
        if (old + 1u == (gen + 1u) * nloc) {
            __builtin_amdgcn_fence(__ATOMIC_RELEASE, "agent");
            asm volatile("s_waitcnt vmcnt(0)" ::: "memory");
            const unsigned og = xb_add(&bar[XB_TOP], 1u);
            const unsigned tg = og / nx;
            if (og + 1u == (tg + 1u) * nx) xb_add(&bar[XB_TOPGEN], 1u);
            else XB_SPIN(xb_ld(&bar[XB_TOPGEN]) == tg, bar);
            __builtin_amdgcn_fence(__ATOMIC_ACQUIRE, "agent");
            xb_add(&bar[XB_XGEN(b.x)], 1u);
            asm volatile("s_waitcnt vmcnt(0)" ::: "memory");
        } else {
            XB_SPIN(xb_ld(&bar[XB_XGEN(b.x)]) == gen, bar);
            __builtin_amdgcn_fence(__ATOMIC_ACQUIRE, "agent");
            asm volatile("s_waitcnt vmcnt(0)" ::: "memory");
        }
    }
    __syncthreads();
}

namespace pg8 {
constexpr int BM = 256, BK = 64, HALF = 128, HTB = HALF * BK * 2, STAGE_BYTES = 8 * HTB, NXCD = 8, WGM = 8, KT = 16;
__device__ __forceinline__ int lds_byte(int r, int c) { const int st = (r >> 4) * 2 + (c >> 5), rr = r & 15, cc = c & 31, ob = rr * 64 + cc * 2; return st * 1024 + (ob ^ (((ob >> 9) & 1) << 5)); }
__device__ __forceinline__ void stage_rc(int b, int& R, int& C) { const int st = b / 1024, sb = b % 1024, swz = sb ^ (((sb >> 9) & 1) << 5); R = (st >> 1) * 16 + swz / 64; C = (st & 1) * 32 + (swz % 64) / 2; }
__device__ __forceinline__ int perm32(int rho) { const int n = rho >> 4, i = rho & 15; return 8 * (i >> 2) + 4 * n + (i & 3); }

struct Unit { int A, B0, B1; int listoff; int nvalid, r0, c0, aux; };

__device__ __forceinline__ bool static_tile(int i, int G, int c, int nM, int nN, int& pm, int& pn) {
    const int nwg = nM * nN; const long L = (long)i * G + c; if (L >= nwg) return false;
    int wgid = (int)L; { const int q = nwg / NXCD, r = nwg % NXCD, xcd = wgid % NXCD, off = wgid / NXCD; wgid = (xcd < r ? xcd * (q + 1) : r * (q + 1) + (xcd - r) * q) + off; }
    const int nig = WGM * nN, gid = wgid / nig, fm = gid * WGM, gsz = (nM - fm) < WGM ? (nM - fm) : WGM;
    pm = fm + ((wgid % nig) % gsz); pn = (wgid % nig) / gsz; return true;
}

typedef int v8i_t __attribute__((ext_vector_type(8)));
typedef int v4i_t __attribute__((ext_vector_type(4)));
template <class Epi, class Sched, bool F8, bool GATHER = false>
__device__ __forceinline__ void gemm_phase(LAS unsigned char* lds, const int lda, const int ldb, const Sched& S, const Epi& E) {
    constexpr int KTN = F8 ? 8 : 16, KSPL = KTN / 2;
    int tid = threadIdx.x; asm volatile("" : "+v"(tid));
    const int wid = __builtin_amdgcn_readfirstlane(tid >> 6), lane = tid & 63, wr = wid >> 2, wc = wid & 3, fr = lane & 15, fq = lane >> 4;
    unsigned voffA[2], voffB[2], vg[2][2];
#pragma unroll
    for (int i = 0; i < 2; ++i) { int R, C; stage_rc(tid * 16 + i * 8192, R, C); const int Rb = Epi::PERM ? ((R & ~31) + perm32(R & 31)) : R;
        voffA[i] = (unsigned)(R * lda + C * 2); voffB[i] = (unsigned)(Rb * ldb + C * 2); }
    LAS int* toks = (LAS int*)(lds + 131072 + 4096);
#define PG8_TOKDMA(un, slot) do { if (GATHER && wid == 0) __builtin_amdgcn_raw_ptr_buffer_load_lds(rsL, (LAS void*)(toks + (slot) * 256), 16, lane * 16, (un).listoff, 0, 0); } while (0)
#define PG8_VG(un, slot) do { _Pragma("unroll") for (int _i = 0; _i < 2; ++_i) { int _R, _C; stage_rc(tid * 16 + _i * 8192, _R, _C); \
        _Pragma("unroll") for (int _h = 0; _h < 2; ++_h) { const int _idx = _h * HALF + _R; int _tok = toks[(slot) * 256 + _idx]; _tok = (_idx < (un).nvalid) ? _tok : 0; \
            vg[_h][_i] = (unsigned)(_tok * lda + _C * 2); } } } while (0)
    const int kstep = BK * 2;
    const int hstepA = HALF * lda, hstepB = HALF * ldb;
    const unsigned ldsw = (unsigned)wid * 1024u;
    int aoffk[2], boffk[2];
#pragma unroll
    for (int k = 0; k < 2; ++k) { aoffk[k] = F8 ? lds_byte(wr * 64 + fr, fq * 16 + 8 * k) : lds_byte(wr * 64 + fr, fq * 8 + 32 * k);
        boffk[k] = F8 ? lds_byte(wc * 32 + fr, fq * 16 + 8 * k) : lds_byte(wc * 32 + fr, fq * 8 + 32 * k); }
#define PG8_SA(b, h) (((b) * 2 + (h)) * HTB)
#define PG8_SB(b, h) ((4 + (b) * 2 + (h)) * HTB)
    const __amdgpu_buffer_rsrc_t rsA = __builtin_amdgcn_make_buffer_rsrc((void*)S.Abase, 0, 0x7fffffff, 0x00020000), rsB = __builtin_amdgcn_make_buffer_rsrc((void*)S.Bbase, 0, 0x7fffffff, 0x00020000);
#define PG8_STAGE_X(rs, bufoff, soff, voff) do { _Pragma("unroll") for (int _i = 0; _i < 2; ++_i) \
        __builtin_amdgcn_raw_ptr_buffer_load_lds(rs, (LAS void*)(lds + (bufoff) + ldsw + _i * 8192), 16, (int)(voff)[_i], (int)(soff), 0, 0); } while (0)
    __amdgpu_buffer_rsrc_t rsL = rsA; if constexpr (GATHER) rsL = __builtin_amdgcn_make_buffer_rsrc((void*)S.Lbase, 0, 0x7fffffff, 0x00020000);
#define PG8_STAGE_A(bufoff, soff) PG8_STAGE_X(rsA, bufoff, soff, voffA)
#define PG8_STAGE_AH(bufoff, soff, h) do { if constexpr (GATHER) PG8_STAGE_X(rsA, bufoff, soff, vg[h]); else PG8_STAGE_X(rsA, bufoff, (soff) + (h) * hstepA, voffA); } while (0)
#define PG8_STAGE_B(bufoff, soff) PG8_STAGE_X(rsB, bufoff, soff, voffB)
#define PG8_RD(off) (*(const LAS v4i_t*)(lds + (off)))
#define PG8_LDA(dst, b, h) do { _Pragma("unroll") for (int m = 0; m < 4; ++m) { \
        if constexpr (F8) dst##8[m] = __builtin_shufflevector(PG8_RD(PG8_SA(b, h) + aoffk[0] + m * 2048), PG8_RD(PG8_SA(b, h) + aoffk[1] + m * 2048), 0, 1, 2, 3, 4, 5, 6, 7); \
        else { _Pragma("unroll") for (int k = 0; k < 2; ++k) dst[m][k] = *(const LAS bf16x8*)(lds + PG8_SA(b, h) + aoffk[k] + m * 2048); } } } while (0)
#define PG8_LDB(dst, b, h) do { _Pragma("unroll") for (int n = 0; n < 2; ++n) { \
        if constexpr (F8) dst##8[n] = __builtin_shufflevector(PG8_RD(PG8_SB(b, h) + boffk[0] + n * 2048), PG8_RD(PG8_SB(b, h) + boffk[1] + n * 2048), 0, 1, 2, 3, 4, 5, 6, 7); \
        else { _Pragma("unroll") for (int k = 0; k < 2; ++k) dst[n][k] = *(const LAS bf16x8*)(lds + PG8_SB(b, h) + boffk[k] + n * 2048); } } } while (0)
#define PG8_MMA(ai, bj, At, Bt) do { __builtin_amdgcn_s_setprio(1); _Pragma("unroll") for (int m = 0; m < 4; ++m) _Pragma("unroll") for (int n = 0; n < 2; ++n) { \
        if constexpr (F8) asm volatile("s_nop 1\n\tv_mfma_scale_f32_16x16x128_f8f6f4 %0, %1, %2, %0, %3, %3 op_sel_hi:[0,0,0]" : "+v"(acc[ai][bj][m][n]) : "v"(Bt##8[n]), "v"(At##8[m]), "v"(f8scale)); \
        else { _Pragma("unroll") for (int k = 0; k < 2; ++k) acc[ai][bj][m][n] = __builtin_amdgcn_mfma_f32_16x16x32_bf16(Bt[n][k], At[m][k], acc[ai][bj][m][n], 0, 0, 0); } } \
        __builtin_amdgcn_s_setprio(0); } while (0)
#define PG8_WAIT_V(n) asm volatile("s_waitcnt vmcnt(" #n ")" ::: "memory")
#define PG8_WAIT_L(n) asm volatile("s_waitcnt lgkmcnt(" #n ")" ::: "memory")
#define PG8_BAR __builtin_amdgcn_s_barrier()
#define PG8_SCHED __builtin_amdgcn_sched_barrier(0)
    Unit cur, nxt; int ui = 0;
    if (!S.next(0, cur)) return;
    f32x4 acc[2][2][4][2];
#pragma unroll
    for (int a = 0; a < 2; ++a)
#pragma unroll
        for (int b = 0; b < 2; ++b)
#pragma unroll
            for (int m = 0; m < 4; ++m)
#pragma unroll
                for (int n = 0; n < 2; ++n) acc[a][b][m][n] = (f32x4){0.f, 0.f, 0.f, 0.f};
    int f8scale = 0x7f7f7f7f; asm volatile("" : "+v"(f8scale));
    bf16x8 At[4][2], B0[2][2], B1[2][2]; v8i_t At8[4], B08[2], B18[2];
    int cA = cur.A, cB0 = cur.B0, cB1 = cur.B1;
    if constexpr (GATHER) { PG8_TOKDMA(cur, 0); PG8_WAIT_V(0); __syncthreads(); PG8_VG(cur, 0); }
    PG8_STAGE_B(PG8_SB(0, 0), cB0); PG8_STAGE_AH(PG8_SA(0, 0), cA, 0); PG8_STAGE_B(PG8_SB(0, 1), cB0 + hstepB); PG8_STAGE_AH(PG8_SA(0, 1), cA, 1);
    if (wr == 1) PG8_BAR;
    PG8_WAIT_V(4); PG8_BAR;
    PG8_STAGE_B(PG8_SB(1, 0), cB0 + kstep); PG8_STAGE_AH(PG8_SA(1, 0), cA + kstep, 0); PG8_STAGE_B(PG8_SB(1, 1), cB0 + hstepB + kstep);
    PG8_WAIT_V(6); PG8_BAR;
    for (;;) {
        const bool has_next = S.next(ui + 1, nxt);
        const int nA = has_next ? nxt.A : cA, nB = has_next ? nxt.B0 : cB0;
        const int tslot = ui % 3, nslot = (ui + 1) % 3;
        if (has_next) PG8_TOKDMA(nxt, nslot);
#pragma unroll 1
        for (int t = 0; t < KTN; t += 2) {
            const bool last = (t == KTN - 2);
            const int a1 = cA + (t + 1) * kstep;
            const int a2 = last ? nA : cA + (t + 2) * kstep;
            const int b2 = last ? nB : ((t + 2 < KSPL) ? cB0 : cB1) + (t + 2) * kstep;
            const int a3 = a2 + kstep, b3 = b2 + kstep;
            PG8_LDB(B0, 0, 0); PG8_SCHED; PG8_LDA(At, 0, 0); PG8_STAGE_AH(PG8_SA(1, 1), a1, 1);
            if constexpr (GATHER) { if (last && has_next) PG8_VG(nxt, nslot); }
            PG8_WAIT_L(8); PG8_BAR; PG8_WAIT_L(0); PG8_MMA(0, 0, At, B0); PG8_BAR; PG8_SCHED;
            PG8_LDB(B1, 0, 1); PG8_STAGE_B(PG8_SB(0, 0), b2);
            PG8_BAR; PG8_WAIT_L(0); PG8_MMA(0, 1, At, B1); PG8_BAR;
            PG8_LDA(At, 0, 1); PG8_STAGE_AH(PG8_SA(0, 0), a2, 0);
            PG8_BAR; PG8_WAIT_L(0); PG8_MMA(1, 0, At, B0); PG8_BAR; PG8_SCHED;
            PG8_STAGE_B(PG8_SB(0, 1), b2 + hstepB);
            PG8_WAIT_V(6); PG8_BAR; PG8_MMA(1, 1, At, B1); PG8_BAR;
            PG8_LDB(B0, 1, 0); PG8_SCHED; PG8_LDA(At, 1, 0); PG8_STAGE_AH(PG8_SA(0, 1), a2, 1);
            PG8_WAIT_L(8); PG8_BAR; PG8_WAIT_L(0); PG8_MMA(0, 0, At, B0); PG8_BAR; PG8_SCHED;
            PG8_LDB(B1, 1, 1); PG8_STAGE_B(PG8_SB(1, 0), b3);
            PG8_BAR; PG8_WAIT_L(0); PG8_MMA(0, 1, At, B1); PG8_BAR;
            PG8_LDA(At, 1, 1); PG8_STAGE_AH(PG8_SA(1, 0), a3, 0);
            PG8_BAR; PG8_WAIT_L(0); PG8_MMA(1, 0, At, B0); PG8_BAR; PG8_SCHED;
            PG8_STAGE_B(PG8_SB(1, 1), b3 + hstepB);
            PG8_WAIT_V(6); PG8_BAR; PG8_MMA(1, 1, At, B1); PG8_BAR;
        }
        if constexpr (F8) asm volatile("s_nop 15\n\ts_nop 15" ::: "memory");
        E(acc, cur, wr, wc, fr, fq, toks + tslot * 256);
        if (!has_next) break;
#pragma unroll
        for (int a = 0; a < 2; ++a)
#pragma unroll
            for (int b = 0; b < 2; ++b)
#pragma unroll
                for (int m = 0; m < 4; ++m)
#pragma unroll
                    for (int n = 0; n < 2; ++n) acc[a][b][m][n] = (f32x4){0.f, 0.f, 0.f, 0.f};
        cur = nxt; cA = nA; cB0 = cur.B0; cB1 = cur.B1; ++ui;
    }
    PG8_WAIT_V(0);
    if (wr == 0) PG8_BAR;
    PG8_BAR;
#undef PG8_SA
#undef PG8_SB
#undef PG8_STAGE_X
#undef PG8_STAGE_A
#undef PG8_STAGE_B
#undef PG8_STAGE_AH
#undef PG8_TOKDMA
#undef PG8_VG
#undef PG8_LDA
#undef PG8_LDB
#undef PG8_MMA
#undef PG8_RD
#undef PG8_WAIT_V
#undef PG8_WAIT_L
#undef PG8_BAR
#undef PG8_SCHED
}


struct EpiBf16Store {
    static constexpr bool PERM = true;
    bf16_t* O; int ldc; float sc;
    __device__ __forceinline__ void operator()(const f32x4 (&acc)[2][2][4][2], const Unit& u, int wr, int wc, int fr, int fq, const LAS int* toks) const {
        const int row0 = u.r0 + wr * 64 + fr, col0 = u.c0 + wc * 32 + 8 * fq;
#pragma unroll
        for (int ai = 0; ai < 2; ++ai)
#pragma unroll
            for (int m = 0; m < 4; ++m) { bf16_t* rowp = O + (size_t)(row0 + ai * HALF + m * 16) * ldc + col0;
#pragma unroll
                for (int bj = 0; bj < 2; ++bj) { const f32x4 v0 = acc[ai][bj][m][0] * sc, v1 = acc[ai][bj][m][1] * sc;
                    u32x4 w; w.x = pk2(v0[0], v0[1]); w.y = pk2(v0[2], v0[3]); w.z = pk2(v1[0], v1[1]); w.w = pk2(v1[2], v1[3]);
                    *(u32x4*)(rowp + bj * HALF) = w; } }
    }
};
struct EpiDelta {
    static constexpr bool PERM = true;
    bf16_t* O; const float* gate;
    __device__ __forceinline__ void operator()(const f32x4 (&acc)[2][2][4][2], const Unit& u, int wr, int wc, int fr, int fq, const LAS int* toks) const {
        const int row0 = u.r0 + wr * 64 + fr, col0 = u.c0 + wc * 32 + 8 * fq;
        const float* gp = gate + (size_t)(u.r0 >> 12) * 6144 + col0;
        f32x4 gv[2][2];
#pragma unroll
        for (int bj = 0; bj < 2; ++bj)
#pragma unroll
            for (int n = 0; n < 2; ++n) gv[bj][n] = *(const f32x4*)(gp + bj * HALF + 4 * n);
#pragma unroll
        for (int ai = 0; ai < 2; ++ai)
#pragma unroll
            for (int m = 0; m < 4; ++m) { bf16_t* rowp = O + (size_t)(row0 + ai * HALF + m * 16) * D + col0;
#pragma unroll
                for (int bj = 0; bj < 2; ++bj) { const f32x4 v0 = acc[ai][bj][m][0] * gv[bj][0], v1 = acc[ai][bj][m][1] * gv[bj][1];
                    u32x4 w; w.x = pk2(v0[0], v0[1]); w.y = pk2(v0[2], v0[3]); w.z = pk2(v1[0], v1[1]); w.w = pk2(v1[2], v1[3]);
                    *(u32x4*)(rowp + bj * HALF) = w; } }
    }
};
struct EpiHid {
    static constexpr bool PERM = true;
    unsigned char* H; const float* rw; float isc, osc;
    __device__ __forceinline__ void operator()(const f32x4 (&acc)[2][2][4][2], const Unit& u, int wr, int wc, int fr, int fq, const LAS int* toks) const {
        const int rl0 = wr * 64 + fr, col0 = u.c0 + wc * 32 + 8 * fq;
#pragma unroll
        for (int ai = 0; ai < 2; ++ai)
#pragma unroll
            for (int m = 0; m < 4; ++m) { const int rl = rl0 + ai * HALF + m * 16;
                float w = 0.f; if (rl < u.nvalid) w = rw[(size_t)toks[rl] * 2 + u.aux] * osc * isc;
                const f32x4 g0 = acc[ai][0][m][0] * isc, g1 = acc[ai][0][m][1] * isc, u0 = acc[ai][1][m][0], u1 = acc[ai][1][m][1];
                float h[8];
#pragma unroll
                for (int j = 0; j < 4; ++j) { h[j] = silu_f(g0[j]) * u0[j] * w; h[4 + j] = silu_f(g1[j]) * u1[j] * w; }
                u32x2 o; o.x = pk_fp8x4(h[0], h[1], h[2], h[3]); o.y = pk_fp8x4(h[4], h[5], h[6], h[7]);
                *(u32x2*)(H + (size_t)(u.r0 + rl) * D + col0) = o; }
    }
};

struct DenseSched {
    const char* Abase; const char* Bbase; int nM, nN, G, c, lda, ldb;
    __device__ __forceinline__ bool next(int i, Unit& u) const {
        int pm, pn; if (!static_tile(i, G, c, nM, nN, pm, pn)) return false;
        u.A = pm * BM * lda; u.B0 = pn * BM * ldb; u.B1 = u.B0; u.listoff = 0; u.nvalid = 256; u.r0 = pm * BM; u.c0 = pn * BM; u.aux = 0; return true;
    }
};
__device__ __forceinline__ void cls_experts(int cls, int& e_lo, int& e_hi) {
    const int g = cls / 6, p = cls % 6; const int lo = (p < 3) ? 0 : (p < 5 ? 1 : 2); const int hi = (p < 3) ? p + 1 : (p < 5 ? p - 1 : 3);
    e_lo = g * 4 + lo; e_hi = g * 4 + hi;
}
struct MoeSched1 {
    const char* Abase; const char* Bbase; const char* Lbase; const LAS int* tbl; int G, c;
    __device__ __forceinline__ bool next(int i, Unit& u) const {
        const int MT = tbl[24]; int mt, pn; if (!static_tile(i, G, c, MT, 8, mt, pn)) return false;
        const int cls = tbl[64 + mt];
        const int ml = mt - tbl[cls]; int e_lo, e_hi; cls_experts(cls, e_lo, e_hi);
        const int e = (pn < 4) ? e_lo : e_hi;
        u.A = 0; u.B0 = (e * 1024 + (pn & 3) * 256) * 1024; u.B1 = u.B0; u.listoff = (cls * T + ml * 256) * 4;
        const int rem = tbl[32 + cls] - ml * 256; u.nvalid = rem < 256 ? rem : 256; u.r0 = mt * 256; u.c0 = (pn >> 2) * 512 + (pn & 3) * 128; u.aux = pn >> 2; return true;
    }
};
struct MoeSched2 {
    const char* Abase; const char* Bbase; const LAS int* tbl; int G, c;
    __device__ __forceinline__ bool next(int i, Unit& u) const {
        const int MT = tbl[24]; int mt, pn; if (!static_tile(i, G, c, MT, 4, mt, pn)) return false;
        const int cls = tbl[64 + mt];
        const int ml = mt - tbl[cls]; int e_lo, e_hi; cls_experts(cls, e_lo, e_hi);
        u.A = mt * 256 * 1024;
        const int brow = pn * 256 * 8192;
        u.B0 = brow + e_lo * 512; u.B1 = brow + e_hi * 512 - 4 * 128; u.listoff = 0;
        const int rem = tbl[32 + cls] - ml * 256; u.nvalid = rem < 256 ? rem : 256; u.r0 = mt * 256; u.c0 = pn * 256; u.aux = 0; return true;
    }
};
}

struct Args { const float* in[27]; float* out; unsigned char* ws; int ph_lo, ph_hi; };

__device__ const unsigned char BUCKET[3][132] = {
 {0,1,2,3,4,5,6,7,8,9,10,11,12,13,14,15,16,16,16,16,16,16,17,17,17,17,17,17,17,17,18,18,18,18,18,18,18,18,18,18,19,19,19,19,19,19,19,19,19,19,19,19,19,19,20,20,20,20,20,20,20,20,20,20,20,20,20,20,20,20,20,20,20,21,21,21,21,21,21,21,21,21,21,21,21,21,21,21,21,21,21,21,21,21,21,21,21,21,21,22,22,22,22,22,22,22,22,22,22,22,22,22,22,22,22,22,22,22,22,22,22,22,22,22,22,22,22,22,22,0,0,0},
 {0,4,8,12,16,16,17,17,18,18,19,19,19,19,20,20,20,20,20,21,21,21,21,21,21,22,22,22,22,22,22,22,22,22,23,23,23,23,23,23,23,23,23,23,23,23,24,24,24,24,24,24,24,24,24,24,24,24,24,24,24,24,25,25,25,25,25,25,25,25,25,25,25,25,25,25,25,25,25,25,25,25,25,26,26,26,26,26,26,26,26,26,26,26,26,26,26,26,26,26,26,26,26,26,26,26,26,26,26,26,26,26,26,27,27,27,27,27,27,27,27,27,27,27,27,27,27,27,27,0,0,0},
 {0,16,18,19,20,21,21,22,22,23,23,23,24,24,24,24,25,25,25,25,25,26,26,26,26,26,26,26,26,27,27,27,27,27,27,27,27,27,27,28,28,28,28,28,28,28,28,28,28,28,28,28,29,29,29,29,29,29,29,29,29,29,29,29,29,29,29,29,29,29,30,30,30,30,30,30,30,30,30,30,30,30,30,30,30,30,30,30,30,30,30,30,30,30,30,31,31,31,31,31,31,31,31,31,31,31,31,31,31,31,31,31,31,31,31,31,31,31,31,31,31,31,31,31,31,31,31,31,31,0,0,0}};

struct Frame {
    LAS unsigned char* lds;
    int tid, lane, wave, vcu, G;
    unsigned char* ws;
};

__device__ __forceinline__ void frame_refresh(Frame& F) {
    int tid = threadIdx.x; asm volatile("" : "+v"(tid));
    F.tid = tid; F.lane = tid & 63; F.wave = __builtin_amdgcn_readfirstlane(tid >> 6);
}
__device__ __forceinline__ void transpose_item(const float* W, int srcN, int k0, int n0, bf16_t* dst, size_t dstride, LAS float* scr, int lane) {
#pragma unroll 8
    for (int i = 0; i < 32; ++i) { const int kk = 2 * i + (lane >> 5); scr[kk * 33 + (lane & 31)] = W[(size_t)(k0 + kk) * srcN + n0 + (lane & 31)]; }
    LDS_WAIT(); asm volatile("" ::: "memory");
    const int c = lane & 7;
#pragma unroll
    for (int j = 0; j < 4; ++j) { const int n = (lane >> 3) + 8 * j; const LAS float* s = scr + (8 * c) * 33 + n;
        u32x4 o; o.x = pk2(s[0 * 33], s[1 * 33]); o.y = pk2(s[2 * 33], s[3 * 33]); o.z = pk2(s[4 * 33], s[5 * 33]); o.w = pk2(s[6 * 33], s[7 * 33]);
        *(u32x4*)(dst + (size_t)n * dstride + 8 * c) = o; }
    LDS_WAIT(); asm volatile("" ::: "memory");
}

__device__ __forceinline__ void transpose_item_f8(const float* W, int srcN, int k0, int n0, unsigned char* dst, size_t dstride, LAS float* scr, int lane, float sc) {
#pragma unroll 8
    for (int i = 0; i < 32; ++i) { const int kk = 2 * i + (lane >> 5); scr[kk * 33 + (lane & 31)] = W[(size_t)(k0 + kk) * srcN + n0 + (lane & 31)]; }
    LDS_WAIT(); asm volatile("" ::: "memory");
    const int c = lane & 7;
#pragma unroll
    for (int j = 0; j < 4; ++j) { const int n = (lane >> 3) + 8 * j; const LAS float* s = scr + (8 * c) * 33 + n;
        u32x2 o; o.x = pk_fp8x4(s[0 * 33] * sc, s[1 * 33] * sc, s[2 * 33] * sc, s[3 * 33] * sc); o.y = pk_fp8x4(s[4 * 33] * sc, s[5 * 33] * sc, s[6 * 33] * sc, s[7 * 33] * sc);
        *(u32x2*)(dst + (size_t)n * dstride + 8 * c) = o; }
    LDS_WAIT(); asm volatile("" ::: "memory");
}
__device__ __forceinline__ void phase_prologue(Frame& F, const Args& a) {
    frame_refresh(F);
    LAS float* scr = (LAS float*)(F.lds + F.wave * 16384);
    const int gw = F.vcu * NWAVES + F.wave, NGW = F.G * NWAVES;
    bf16_t* WIN = (bf16_t*)(F.ws + WS_WIN); bf16_t* WOUT = (bf16_t*)(F.ws + WS_WOUT); unsigned char* WGU = F.ws + WS_WGU; unsigned char* WDT = F.ws + WS_WDT;
    constexpr int I_IN = 4 * 16 * 80, I_OUT = 4 * 16 * 32, I_G = 64 * 16 * 16, I_D = 64 * 8 * 32;
    constexpr int NITEMS = I_IN + I_OUT + 2 * I_G + I_D;
    for (int it = gw; it < NITEMS; it += NGW) {
        int r = it;
        if (r < I_IN) { const int l = r / 1280, q = r % 1280, kb = q / 80, nb = q % 80;
            const float* W = ((l & 1) ? a.in[13] : a.in[7]) + (size_t)(l >> 1) * 1024 * NPROJ;
            transpose_item(W, NPROJ, 64 * kb, 32 * nb, WIN + ((size_t)l * NPROJ + 32 * nb) * 1024 + 64 * kb, 1024, scr, F.lane); continue; }
        r -= I_IN;
        if (r < I_OUT) { const int l = r / 512, q = r % 512, kb = q / 32, nb = q % 32;
            const float* W = ((l & 1) ? a.in[14] : a.in[8]) + (size_t)(l >> 1) * 1024 * 1024;
            transpose_item(W, 1024, 64 * kb, 32 * nb, WOUT + ((size_t)l * 1024 + 32 * nb) * 1024 + 64 * kb, 1024, scr, F.lane); continue; }
        r -= I_OUT;
        if (r < 2 * I_G) { const int up = r / I_G, q0 = r % I_G, le = q0 / 256, q = q0 % 256, kb = q / 16, nb = q % 16;
            const float* W = (up ? a.in[24] : a.in[23]) + (size_t)le * 1024 * 512;
            const int n0 = 32 * nb, drow = 256 * (n0 >> 7) + 128 * up + (n0 & 127);
            transpose_item_f8(W, 512, 64 * kb, n0, WGU + ((size_t)le * 1024 + drow) * 1024 + 64 * kb, 1024, scr, F.lane, SC_WGU); continue; }
        r -= 2 * I_G;
        { const int le = r / 256, q = r % 256, kb = q / 32, nb = q % 32, l = le >> 4, e = le & 15;
            const float* W = a.in[25] + (size_t)le * 512 * 1024;
            transpose_item_f8(W, 1024, 64 * kb, 32 * nb, WDT + ((size_t)l * 1024 + 32 * nb) * 8192 + e * 512 + 64 * kb, 8192, scr, F.lane, SC_WD); }
    }
    { bf16_t* WS = (bf16_t*)(F.ws + WS_WS); const float* src = a.in[11];
      for (int i = (F.vcu * NTHREADS + F.tid); i < 2 * 4 * 128 * 128; i += F.G * NTHREADS) { const int t = (i >> 7) & 127, s = i & 127; const float v = (s <= t) ? src[i] : 0.f; WS[i] = (bf16_t)(pk2(v, 0.f) & 0xffffu); } }
    __syncthreads();
    { LAS float* sc = (LAS float*)F.lds;
      LAS float* red = (LAS float*)(F.lds + 65536);
      const float* c = a.in[1];
      for (int i = F.tid; i < 16 * 1024; i += NTHREADS) sc[i] = silu_f(c[i]);
      __syncthreads();
      float* MOD = (float*)(F.ws + WS_MOD);
      for (int grp = F.vcu; grp < 4 * 96; grp += F.G) {
          const int l = grp / 96, n = (grp % 96) * 64 + F.lane;
          const float* w = a.in[5] + ((size_t)l * 1024 + F.wave * 128) * 6144 + n;
          float acc[16];
#pragma unroll
          for (int b = 0; b < 16; ++b) acc[b] = 0.f;
#pragma unroll 4
          for (int k = 0; k < 128; ++k) { const float wv = w[(size_t)k * 6144];
#pragma unroll
              for (int b = 0; b < 16; ++b) acc[b] += sc[b * 1024 + F.wave * 128 + k] * wv; }
#pragma unroll
          for (int b = 0; b < 16; ++b) red[(F.wave * 16 + b) * 64 + F.lane] = acc[b];
          __syncthreads();
#pragma unroll
          for (int bb = 0; bb < 2; ++bb) { const int b = F.wave * 2 + bb; float s = a.in[6][(size_t)l * 6144 + n];
#pragma unroll
              for (int w8 = 0; w8 < 8; ++w8) s += red[(w8 * 16 + b) * 64 + F.lane];
              MOD[((size_t)l * 16 + b) * 6144 + n] = s; }
          __syncthreads();
      }
    }
}

__device__ __forceinline__ void load_row(const float* xrow, int lane, f32x4 (&v)[4]) {
    const f32x4* xr = (const f32x4*)xrow + lane;
#pragma unroll
    for (int j = 0; j < 4; ++j) v[j] = xr[64 * j];
}
__device__ __forceinline__ float row_rstd(const f32x4 (&v)[4]) {
    float ss = 0.f;
#pragma unroll
    for (int j = 0; j < 4; ++j) ss += (v[j].x * v[j].x + v[j].y * v[j].y) + (v[j].z * v[j].z + v[j].w * v[j].w);
    return rsqrtf(wave_sum(ss) * (1.f / D) + EPS);
}
__device__ __forceinline__ void load_mod(const float* gam, const float* sh, const float* sc, int lane, f32x4 (&gp)[4], f32x4 (&shv)[4]) {
#pragma unroll
    for (int j = 0; j < 4; ++j) { const f32x4 g = ((const f32x4*)gam)[lane + 64 * j], s1 = ((const f32x4*)sc)[lane + 64 * j]; gp[j] = g * (1.f + s1); shv[j] = ((const f32x4*)sh)[lane + 64 * j]; }
}
__device__ __forceinline__ void store_row_bf16(bf16_t* orow, int lane, const f32x4 (&h)[4]) {
    u32x2* o = (u32x2*)orow + lane;
#pragma unroll
    for (int j = 0; j < 4; ++j) { u32x2 w; w.x = pk2(h[j].x, h[j].y); w.y = pk2(h[j].z, h[j].w); o[64 * j] = w; }
}

__device__ __forceinline__ void load_y(const bf16_t* yrow, int lane, u32x2 (&y)[4]) {
    const u32x2* yr = (const u32x2*)yrow + lane;
#pragma unroll
    for (int j = 0; j < 4; ++j) y[j] = yr[64 * j];
}
__device__ __forceinline__ void add_y(f32x4 (&x)[4], const u32x2 (&y)[4], const f32x4 (&g)[4]) {
#pragma unroll
    for (int j = 0; j < 4; ++j) { x[j].x += g[j].x * bf_lo(y[j].x); x[j].y += g[j].y * bf_hi(y[j].x); x[j].z += g[j].z * bf_lo(y[j].y); x[j].w += g[j].w * bf_hi(y[j].y); }
}
__device__ __forceinline__ void store_row_fp8(unsigned char* orow, int lane, const f32x4 (&h)[4], float sc) {
    unsigned* o = (unsigned*)orow + lane;
#pragma unroll
    for (int j = 0; j < 4; ++j) o[64 * j] = pk_fp8x4(h[j].x * sc, h[j].y * sc, h[j].z * sc, h[j].w * sc);
}
__device__ __forceinline__ void load_row_bf(const bf16_t* xrow, int lane, f32x4 (&v)[4]) {
    const u32x2* xr = (const u32x2*)xrow + lane;
#pragma unroll
    for (int j = 0; j < 4; ++j) { const u32x2 w = xr[64 * j]; v[j] = (f32x4){bf_lo(w.x), bf_hi(w.x), bf_lo(w.y), bf_hi(w.y)}; }
}
__device__ __forceinline__ void store_row_f32(float* xrow, int lane, const f32x4 (&v)[4]) {
    f32x4* xr = (f32x4*)xrow + lane;
#pragma unroll
    for (int j = 0; j < 4; ++j) xr[64 * j] = v[j];
}
__device__ __forceinline__ void phase_norm1(Frame& F, const Args& a, int l) {
    frame_refresh(F);
    const int gw = F.vcu * NWAVES + F.wave, NGW = F.G * NWAVES, lane = F.lane;
    const float* MOD = (const float*)(F.ws + WS_MOD) + (size_t)l * 16 * 6144;
    bf16_t* HB = (bf16_t*)(F.ws + WS_HBUF);
    const float* gam = a.in[3] + (size_t)l * D;
    const bool addy = l > 0;
    const float* xin = a.in[0]; bf16_t* XB = (bf16_t*)(F.ws + WS_XB);
    const bf16_t* Y2 = (const bf16_t*)(F.ws + WS_HSORT); const int* SINFO = (const int*)(F.ws + WS_LIST);
    const LAS int* tbl = (const LAS int*)(F.lds + 131072);
    for (int blk = gw; blk < T / 32; blk += NGW) {
        const int row0 = blk * 32, b = row0 >> 12;
        f32x4 gp[4], shv[4], g2[4]; load_mod(gam, MOD + (size_t)b * 6144, MOD + (size_t)b * 6144 + 1024, lane, gp, shv);
        int slotv = 0;
        if (addy) { const int si = SINFO[row0 + (lane & 31)]; slotv = tbl[si >> 16] * 256 + (si & 0xffff);
#pragma unroll
            for (int j = 0; j < 4; ++j) g2[j] = ((const f32x4*)(MOD - 16 * 6144 + (size_t)b * 6144 + 5120))[lane + 64 * j]; }
        f32x4 xa[4], xb[4], na[4], nb[4]; u32x2 ya[4], yb[4], nya[4], nyb[4];
        if (addy) { load_row_bf(XB + (size_t)row0 * D, lane, xa); load_row_bf(XB + (size_t)(row0 + 1) * D, lane, xb); } else { load_row(xin + (size_t)row0 * D, lane, xa); load_row(xin + (size_t)(row0 + 1) * D, lane, xb); }
        if (addy) { load_y(Y2 + (size_t)__builtin_amdgcn_readlane(slotv, 0) * D, lane, ya); load_y(Y2 + (size_t)__builtin_amdgcn_readlane(slotv, 1) * D, lane, yb); }
#pragma unroll 1
        for (int r = 0; r < 32; r += 2) {
            if (r + 2 < 32) { if (addy) { load_row_bf(XB + (size_t)(row0 + r + 2) * D, lane, na); load_row_bf(XB + (size_t)(row0 + r + 3) * D, lane, nb); } else { load_row(xin + (size_t)(row0 + r + 2) * D, lane, na); load_row(xin + (size_t)(row0 + r + 3) * D, lane, nb); }
                if (addy) { load_y(Y2 + (size_t)__builtin_amdgcn_readlane(slotv, r + 2) * D, lane, nya); load_y(Y2 + (size_t)__builtin_amdgcn_readlane(slotv, r + 3) * D, lane, nyb); } }
            if (addy) { add_y(xa, ya, g2); add_y(xb, yb, g2); store_row_bf16(XB + (size_t)(row0 + r) * D, lane, xa); store_row_bf16(XB + (size_t)(row0 + r + 1) * D, lane, xb); }
            const float ra = row_rstd(xa), rb = row_rstd(xb);
#pragma unroll
            for (int j = 0; j < 4; ++j) { xa[j] = xa[j] * ra * gp[j] + shv[j]; xb[j] = xb[j] * rb * gp[j] + shv[j]; }
            store_row_bf16(HB + (size_t)(row0 + r) * D, lane, xa); store_row_bf16(HB + (size_t)(row0 + r + 1) * D, lane, xb);
#pragma unroll
            for (int j = 0; j < 4; ++j) { xa[j] = na[j]; xb[j] = nb[j]; ya[j] = nya[j]; yb[j] = nyb[j]; }
        }
    }
}

__device__ __forceinline__ float xor32(float v) {
    const unsigned u = __float_as_uint(v);
    auto rr = __builtin_amdgcn_permlane32_swap(u, u, false, false);
    return __uint_as_float((threadIdx.x & 32) ? rr[0] : rr[1]);
}
typedef short v4i16_t __attribute__((ext_vector_type(4)));
__device__ __forceinline__ v4i16_t tr_read8(const LAS char* p) { return __builtin_amdgcn_ds_read_tr16_b64_v4i16((LAS v4i16_t*)p); }
__device__ __forceinline__ void pv_mma(f32x16 (&O)[2], const bf16x8 (&pk)[2], const LAS char* vimg, int lane) {
    const int hh = lane >> 5;
    const LAS char* vb = vimg + (4 * hh + ((lane & 15) >> 2)) * 64 + ((lane >> 4) & 1) * 32 + (lane & 3) * 8;
#pragma unroll
    for (int dh = 0; dh < 2; ++dh)
#pragma unroll
        for (int s4 = 0; s4 < 2; ++s4) {
            const v4i16_t lo = tr_read8(vb + dh * 2048 + (16 * s4) * 64), hi = tr_read8(vb + dh * 2048 + (16 * s4 + 8) * 64);
            bf16x8 af; af[0] = lo[0]; af[1] = lo[1]; af[2] = lo[2]; af[3] = lo[3]; af[4] = hi[0]; af[5] = hi[1]; af[6] = hi[2]; af[7] = hi[3];
            O[dh] = __builtin_amdgcn_mfma_f32_32x32x16_bf16(af, pk[s4], O[dh], 0, 0, 0);
        }
}
__device__ __forceinline__ void pack_p(const float (&p)[16], bf16x8 (&pk)[2]) {
#pragma unroll
    for (int s4 = 0; s4 < 2; ++s4) { u32x4 w; w.x = pk2(p[8 * s4 + 0], p[8 * s4 + 1]); w.y = pk2(p[8 * s4 + 2], p[8 * s4 + 3]); w.z = pk2(p[8 * s4 + 4], p[8 * s4 + 5]); w.w = pk2(p[8 * s4 + 6], p[8 * s4 + 7]);
        pk[s4] = __builtin_bit_cast(bf16x8, w); }
}
__device__ __forceinline__ void store_ot(const f32x16 (&O)[2], float sc, bf16_t* orow, int lane) {
    const int hh = lane >> 5;
#pragma unroll
    for (int dh = 0; dh < 2; ++dh)
#pragma unroll
        for (int g = 0; g < 4; ++g) { u32x2 w; w.x = pk2(O[dh][4 * g] * sc, O[dh][4 * g + 1] * sc); w.y = pk2(O[dh][4 * g + 2] * sc, O[dh][4 * g + 3] * sc);
            *(u32x2*)(orow + 32 * dh + 8 * g + 4 * hh) = w; }
}

constexpr int DK_PITCH = 144, DL_K = 0, DL_V = 384 * DK_PITCH, DL_VH = 384 * 64, DL_BT = DL_V + 2 * DL_VH;
struct DilUnit { int b, hd, p, d, sh, res, S0; };
__device__ __forceinline__ void dil_decode(int u, DilUnit& U) {
    const int pair = u / 48, k = u % 48; U.p = k >> 4; const int idx = k & 15; U.hd = pair & 7; U.b = pair >> 3;
    U.sh = 2 * U.p; U.d = 1 << U.sh;
    const int lb = 4 - U.sh;
    U.res = idx >> lb; U.S0 = (idx & ((1 << lb) - 1)) * 256;
}
struct DilRegs { u32x4 k[6]; u32x4 v[6]; bf16x8 q[4]; };
__device__ __forceinline__ void dil_load(DilRegs& R, const bf16_t* P, const DilUnit& U, int tid) {
    const bf16_t* Pb = P + (size_t)U.b * SEQ * NPROJ;
#pragma unroll
    for (int i = 0; i < 6; ++i) { const int q = tid + 512 * i, key = q >> 3, c8 = q & 7; int sub = U.S0 - 128 + key; sub = sub < 0 ? 0 : sub;
        const bf16_t* rp = Pb + (size_t)(U.res + (sub << U.sh)) * NPROJ + U.hd * 64 + 8 * c8;
        R.k[i] = *(const u32x4*)(rp + 512); R.v[i] = *(const u32x4*)(rp + 1024); }
    const int lane = tid & 63, w = tid >> 6, qs = U.S0 + 32 * w + (lane & 31);
    const bf16_t* qp = Pb + (size_t)(U.res + (qs << U.sh)) * NPROJ + U.hd * 64 + 8 * (lane >> 5);
#pragma unroll
    for (int s4 = 0; s4 < 4; ++s4) R.q[s4] = *(const bf16x8*)(qp + 16 * s4);
}
__device__ __forceinline__ void dil_stage(const DilRegs& R, LAS char* lds, int tid) {
#pragma unroll
    for (int i = 0; i < 6; ++i) { const int q = tid + 512 * i, key = q >> 3, c8 = q & 7;
        *(LAS u32x4*)(lds + DL_K + key * DK_PITCH + c8 * 16) = R.k[i];
        *(LAS u32x4*)(lds + DL_V + (c8 >> 2) * DL_VH + key * 64 + (c8 & 3) * 16) = R.v[i]; }
}
__device__ __forceinline__ void phase_dilated2(Frame& F, const Args& a) {
    frame_refresh(F);
    const int tid = F.tid, lane = F.lane, wave = F.wave, r32 = lane & 31, hh = lane >> 5;
    const bf16_t* P = (const bf16_t*)(F.ws + WS_PROJ);
    bf16_t* OP0 = (bf16_t*)(F.ws + WS_MIX); bf16_t* OP12 = (bf16_t*)(F.ws + WS_HBUF); float* LSE = (float*)(F.ws + WS_LIST);
    LAS char* lds = (LAS char*)F.lds;
    LAS float* btab = (LAS float*)(lds + DL_BT);
    for (int i = tid; i < 8 * 3 * 132; i += NTHREADS) { const int h = i / 396, rem = i % 396, br = rem / 132, sd = rem % 132; btab[i] = a.in[2][(int)BUCKET[br][sd] * 8 + h]; }
    DilRegs R; DilUnit U, NU;
    const bool xl = (F.G == 256); const int xq = F.vcu >> 5, xj = F.vcu & 31; const int nmine = xl ? 24 : (6144 - F.vcu + F.G - 1) / F.G;
#define DIL_UNIT(i) (xl ? ((xq * 16 + 2 * ((i) / 3)) * 48 + xj + 32 * ((i) % 3)) : (F.vcu + (i) * F.G))
    if (nmine > 0) { dil_decode(DIL_UNIT(0), U); dil_load(R, P, U, tid); }
    for (int it = 0; it < nmine; ++it) {
        __syncthreads();
        dil_stage(R, lds, tid);
        bf16x8 qf[4];
#pragma unroll
        for (int s4 = 0; s4 < 4; ++s4) qf[s4] = R.q[s4];
        __syncthreads();
        if (it + 1 < nmine) { dil_decode(DIL_UNIT(it + 1), NU); dil_load(R, P, NU, tid); }
        const int qs = U.S0 + 32 * wave + r32;
        const int lim = qs < 128 ? qs : 128;
        const LAS float* bt = btab + (U.hd * 3 + U.p) * 132;
        float m = -1e30f, l = 0.f; f32x16 O[2];
#pragma unroll
        for (int i = 0; i < 16; ++i) { O[0][i] = 0.f; O[1][i] = 0.f; }
#pragma unroll 1
        for (int j = 0; j < 5; ++j) {
            const int kb = 32 * (wave + j);
            if (U.S0 - 128 + kb + 31 < 0) continue;
            f32x16 S;
#pragma unroll
            for (int i = 0; i < 16; ++i) S[i] = 0.f;
            const LAS char* kp = lds + DL_K + (kb + r32) * DK_PITCH + 16 * hh;
#pragma unroll
            for (int s4 = 0; s4 < 4; ++s4) S = __builtin_amdgcn_mfma_f32_32x32x16_bf16(*(const LAS bf16x8*)(kp + 32 * s4), qf[s4], S, 0, 0, 0);
            const int dist0 = 128 + r32 - 32 * j - 4 * hh;
            float sv[16]; float smax = -1e30f;
            float bv[16];
#pragma unroll
            for (int i = 0; i < 16; ++i) { const unsigned ud = (unsigned)(dist0 - ((i & 3) + 8 * (i >> 2))); bv[i] = bt[ud < 132u ? ud : 131u]; }
#pragma unroll
            for (int i = 0; i < 16; ++i) { const int dist = dist0 - ((i & 3) + 8 * (i >> 2)); const bool valid = (unsigned)dist <= (unsigned)lim;
                sv[i] = valid ? (S[i] * 0.125f + bv[i]) : -1e30f; smax = fmaxf(smax, sv[i]); }
            smax = fmaxf(smax, xor32(smax));
            const float mn = fmaxf(m, smax);
            const float alpha = __expf(m - mn);
            float p[16]; float ps = 0.f;
#pragma unroll
            for (int i = 0; i < 16; ++i) { p[i] = (sv[i] > -1e29f) ? __expf(sv[i] - mn) : 0.f; ps += p[i]; }
            l = l * alpha + ps; m = mn;
#pragma unroll
            for (int dh = 0; dh < 2; ++dh)
#pragma unroll
                for (int i = 0; i < 16; ++i) O[dh][i] *= alpha;
            bf16x8 pk[2]; pack_p(p, pk);
            const LAS char* vb = lds + DL_V + (kb + 4 * hh + ((lane & 15) >> 2)) * 64 + ((lane >> 4) & 1) * 32 + (lane & 3) * 8;
#pragma unroll
            for (int dh = 0; dh < 2; ++dh)
#pragma unroll
                for (int s4 = 0; s4 < 2; ++s4) {
                    const v4i16_t lo = tr_read8(vb + dh * DL_VH + (16 * s4) * 64), hi = tr_read8(vb + dh * DL_VH + (16 * s4 + 8) * 64);
                    bf16x8 af; af[0] = lo[0]; af[1] = lo[1]; af[2] = lo[2]; af[3] = lo[3]; af[4] = hi[0]; af[5] = hi[1]; af[6] = hi[2]; af[7] = hi[3];
                    O[dh] = __builtin_amdgcn_mfma_f32_32x32x16_bf16(af, pk[s4], O[dh], 0, 0, 0);
                }
        }
        const float lt = l + xor32(l);
        const size_t row = (size_t)U.b * SEQ + U.res + ((size_t)qs << U.sh);
        bf16_t* orow = (U.p == 0) ? (OP0 + row * D + U.hd * 64) : (OP12 + ((size_t)(U.p - 1) * T + row) * 512 + U.hd * 64);
        store_ot(O, frcp(lt), orow, lane);
        if (hh == 0) LSE[((size_t)U.p * T + row) * 8 + U.hd] = m + __logf(lt);
        U = NU;
    }
}
__device__ __forceinline__ void phase_dil_combine(Frame& F) {
    frame_refresh(F);
    const int gw = F.vcu * NWAVES + F.wave, NGW = F.G * NWAVES, lane = F.lane;
    bf16_t* OP0 = (bf16_t*)(F.ws + WS_MIX); const bf16_t* OP12 = (const bf16_t*)(F.ws + WS_HBUF); const float* LSE = (const float*)(F.ws + WS_LIST);
    for (int blk = gw; blk < T / 32; blk += NGW) {
#pragma unroll 1
        for (int r = 0; r < 32; r += 2) {
            u32x4 o[2][3]; float ls[2][3];
#pragma unroll
            for (int q = 0; q < 2; ++q) { const size_t row = (size_t)blk * 32 + r + q;
                o[q][0] = *(const u32x4*)(OP0 + row * D + 8 * lane); o[q][1] = *(const u32x4*)(OP12 + row * 512 + 8 * lane); o[q][2] = *(const u32x4*)(OP12 + ((size_t)T + row) * 512 + 8 * lane);
#pragma unroll
                for (int p = 0; p < 3; ++p) ls[q][p] = LSE[((size_t)p * T + row) * 8 + (lane >> 3)]; }
#pragma unroll
            for (int q = 0; q < 2; ++q) { const size_t row = (size_t)blk * 32 + r + q;
                const float M = fmaxf(ls[q][0], fmaxf(ls[q][1], ls[q][2]));
                float w0 = __expf(ls[q][0] - M), w1 = __expf(ls[q][1] - M), w2 = __expf(ls[q][2] - M); const float inv = frcp(w0 + w1 + w2); w0 *= inv; w1 *= inv; w2 *= inv;
                u32x4 res;
#pragma unroll
                for (int e = 0; e < 4; ++e) { const unsigned a0 = o[q][0][e], a1 = o[q][1][e], a2 = o[q][2][e];
                    res[e] = pk2(bf_lo(a0) * w0 + bf_lo(a1) * w1 + bf_lo(a2) * w2, bf_hi(a0) * w0 + bf_hi(a1) * w1 + bf_hi(a2) * w2); }
                *(u32x4*)(OP0 + row * D + 8 * lane) = res; }
        }
    }
}

struct KRegs { u32x4 k[4]; };
__device__ __forceinline__ void stick_req_k(KRegs& R, const bf16_t* Pb, int ko, int tb, int lane) {
    const int r32 = lane & 31, hh = lane >> 5;
    int kt = tb + r32; kt = kt < 0 ? 0 : kt;
    const bf16_t* kp = Pb + (size_t)kt * NPROJ + ko + 8 * hh;
#pragma unroll
    for (int s4 = 0; s4 < 4; ++s4) R.k[s4] = *(const u32x4*)(kp + 16 * s4);
}
__device__ __forceinline__ void stick_req_v(const __amdgpu_buffer_rsrc_t rs, int vo, int tb, LAS char* slot, int lane) {
#pragma unroll
    for (int dh = 0; dh < 2; ++dh)
#pragma unroll
        for (int kh = 0; kh < 2; ++kh) { int vt = tb + 16 * kh + (lane >> 2); vt = vt < 0 ? 0 : vt;
            __builtin_amdgcn_raw_ptr_buffer_load_lds(rs, (LAS void*)(slot + dh * 2048 + kh * 1024), 16, (vt * NPROJ + vo + dh * 32 + 8 * (lane & 3)) * 2, 0, 0, 0); }
}
__device__ __forceinline__ void stick_req(KRegs& R, const bf16_t* Pb, const __amdgpu_buffer_rsrc_t rs, int ko, int vo, int tb, LAS char* slot, int lane) {
    stick_req_k(R, Pb, ko, tb, lane); stick_req_v(rs, vo, tb, slot, lane);
}
__device__ __forceinline__ bool stick_tile(const KRegs& C, int tb, int tq, int lane, const bf16x8 (&qf)[4], float& carry, f32x16 (&O)[2], const LAS char* vimg, int nwait) {
    const int hh = lane >> 5;
    f32x16 S;
#pragma unroll
    for (int i = 0; i < 16; ++i) S[i] = 0.f;
#pragma unroll
    for (int s4 = 0; s4 < 4; ++s4) S = __builtin_amdgcn_mfma_f32_32x32x16_bf16(__builtin_bit_cast(bf16x8, C.k[s4]), qf[s4], S, 0, 0, 0);
    const int dist0 = tq - tb - 4 * hh;
    float lk[16];
#pragma unroll
    for (int i = 0; i < 16; ++i) { const int dist = dist0 - ((i & 3) + 8 * (i >> 2)); const bool valid = dist > 0;
        const float z = S[i] * 0.125f;
        const float sp = fmaxf(z, 0.f) + __logf(1.f + __expf(-fabsf(z)));
        lk[i] = valid ? -sp : 0.f; S[i] = valid ? (z - sp) : -1e30f; }
    float G[4], PG[4];
#pragma unroll
    for (int g = 0; g < 4; ++g) { G[g] = (lk[4 * g] + lk[4 * g + 1]) + (lk[4 * g + 2] + lk[4 * g + 3]); PG[g] = xor32(G[g]); }
    float after[4]; float run = 0.f;
#pragma unroll
    for (int g = 3; g >= 0; --g) { after[g] = run + (hh == 0 ? PG[g] : 0.f); run += G[g] + PG[g]; }
    float p[16];
#pragma unroll
    for (int g = 0; g < 4; ++g) { const float b3 = carry + after[g], b2 = b3 + lk[4 * g + 3], b1 = b2 + lk[4 * g + 2], b0 = b1 + lk[4 * g + 1];
        p[4 * g + 3] = __expf(S[4 * g + 3] + b3); p[4 * g + 2] = __expf(S[4 * g + 2] + b2); p[4 * g + 1] = __expf(S[4 * g + 1] + b1); p[4 * g] = __expf(S[4 * g] + b0); }
    carry += run;
    bf16x8 pk[2]; pack_p(p, pk);
    if (nwait >= 16) asm volatile("s_waitcnt vmcnt(16)" ::: "memory"); else if (nwait >= 8) asm volatile("s_waitcnt vmcnt(8)" ::: "memory"); else asm volatile("s_waitcnt vmcnt(0)" ::: "memory");
    pv_mma(O, pk, vimg, lane);
    return __all(carry < -110.f) != 0;
}
__device__ __forceinline__ void phase_stick(Frame& F) {
    frame_refresh(F);
    const int gw = F.vcu * NWAVES + F.wave, NGW = F.G * NWAVES, lane = F.lane, hh = lane >> 5;
    const bf16_t* P = (const bf16_t*)(F.ws + WS_PROJ); bf16_t* MIX = (bf16_t*)(F.ws + WS_MIX);
    LAS char* ring = (LAS char*)F.lds + F.wave * 12288;
    int wt = gw;
    bf16x8 qf[4]; KRegs R0, R1, R2;
    if (wt < 16384) { const int qt = wt & 127, hd = (wt >> 7) & 7, b = wt >> 10; const bf16_t* Pb = P + (size_t)b * SEQ * NPROJ;
#pragma unroll
        for (int s4 = 0; s4 < 4; ++s4) qf[s4] = *(const bf16x8*)(Pb + (size_t)(qt * 32 + (lane & 31)) * NPROJ + 1024 + hd * 64 + 16 * s4 + 8 * hh);
        stick_req_k(R0, Pb, 1536 + hd * 64, qt * 32, lane); stick_req_k(R1, Pb, 1536 + hd * 64, qt * 32 - 32, lane); }
    asm volatile("s_waitcnt lgkmcnt(0)" ::: "memory");
    for (; wt < 16384; wt += NGW) {
        const int qt = wt & 127, hd = (wt >> 7) & 7, b = wt >> 10;
        const int tq = qt * 32 + (lane & 31);
        const bf16_t* Pb = P + (size_t)b * SEQ * NPROJ;
        const __amdgpu_buffer_rsrc_t rs = __builtin_amdgcn_make_buffer_rsrc((void*)Pb, 0, 0x7fffffff, 0x00020000);
        const int ko = 1536 + hd * 64, vo = 2048 + hd * 64;
        float carry = 0.f; f32x16 O[2];
#pragma unroll
        for (int i = 0; i < 16; ++i) { O[0][i] = 0.f; O[1][i] = 0.f; }
        stick_req_v(rs, vo, qt * 32, ring, lane);
        if (qt >= 1) stick_req_v(rs, vo, qt * 32 - 32, ring + 4096, lane);
#pragma unroll 1
        for (int kt = qt; kt >= 0; kt -= 3) {
            if (kt >= 2) stick_req(R2, Pb, rs, ko, vo, (kt - 2) * 32, ring + 8192, lane);
            if (stick_tile(R0, kt * 32, tq, lane, qf, carry, O, ring, kt == qt ? (kt >= 2 ? 12 : (kt >= 1 ? 4 : 0)) : (kt >= 2 ? 16 : (kt >= 1 ? 8 : 0)))) break;
            if (kt < 1) break;
            if (kt >= 3) stick_req(R0, Pb, rs, ko, vo, (kt - 3) * 32, ring, lane);
            if (stick_tile(R1, (kt - 1) * 32, tq, lane, qf, carry, O, ring + 4096, kt >= 3 ? 16 : (kt >= 2 ? 8 : 0))) break;
            if (kt < 2) break;
            if (kt >= 4) stick_req(R1, Pb, rs, ko, vo, (kt - 4) * 32, ring + 4096, lane);
            if (stick_tile(R2, (kt - 2) * 32, tq, lane, qf, carry, O, ring + 8192, kt >= 4 ? 16 : (kt >= 3 ? 8 : 0))) break;
        }
        const int wn = wt + NGW;
        asm volatile("" ::: "memory");
        if (wn < 16384) { const int qn = wn & 127, hn = (wn >> 7) & 7, bn = wn >> 10; const bf16_t* Pn = P + (size_t)bn * SEQ * NPROJ;
#pragma unroll
            for (int s4 = 0; s4 < 4; ++s4) qf[s4] = *(const bf16x8*)(Pn + (size_t)(qn * 32 + (lane & 31)) * NPROJ + 1024 + hn * 64 + 16 * s4 + 8 * hh);
            stick_req_k(R0, Pn, 1536 + hn * 64, qn * 32, lane); stick_req_k(R1, Pn, 1536 + hn * 64, qn * 32 - 32, lane); }
        asm volatile("" ::: "memory");
        store_ot(O, 1.f, MIX + ((size_t)b * SEQ + tq) * D + 512 + hd * 64, lane);
        asm volatile("s_waitcnt vmcnt(20) lgkmcnt(0)" ::: "memory");
    }
}

__device__ __forceinline__ void phase_gmlp(Frame& F, const Args& a, int j2) {
    frame_refresh(F);
    const bf16_t* P = (const bf16_t*)(F.ws + WS_PROJ); bf16_t* MIX = (bf16_t*)(F.ws + WS_MIX);
    const bf16_t* WSM = (const bf16_t*)(F.ws + WS_WS) + (size_t)j2 * 4 * 128 * 128;
    const float* lng = a.in[9] + (size_t)j2 * 512; const float* lnb = a.in[10] + (size_t)j2 * 512; const float* bs = a.in[12] + (size_t)j2 * 4 * 128;
    constexpr int VP = 136;
    LAS bf16_t* vT = (LAS bf16_t*)F.lds;
    const int lane = F.lane, wave = F.wave;
    for (int ch = F.vcu; ch < T / 128; ch += F.G) {
        const int row0 = ch * 128;
        float lg[8], lb[8];
#pragma unroll
        for (int i = 0; i < 8; ++i) { lg[i] = lng[8 * lane + i]; lb[i] = lnb[8 * lane + i]; }
        u32x4 wv[16];
#pragma unroll
        for (int tt = 0; tt < 16; ++tt) wv[tt] = *(const u32x4*)(P + (size_t)(row0 + wave * 16 + tt) * NPROJ + 2048 + 8 * lane);
#pragma unroll
        for (int tt = 0; tt < 16; ++tt) asm volatile("" : "+v"(wv[tt]));
#pragma unroll
        for (int tt = 0; tt < 16; ++tt) { const int tl = wave * 16 + tt;
            const u32x4 w = wv[tt];
            float g[8]; g[0] = gelu_tanh(bf_lo(w.x)); g[1] = gelu_tanh(bf_hi(w.x)); g[2] = gelu_tanh(bf_lo(w.y)); g[3] = gelu_tanh(bf_hi(w.y));
            g[4] = gelu_tanh(bf_lo(w.z)); g[5] = gelu_tanh(bf_hi(w.z)); g[6] = gelu_tanh(bf_lo(w.w)); g[7] = gelu_tanh(bf_hi(w.w));
            float s = 0.f;
#pragma unroll
            for (int i = 0; i < 8; ++i) s += g[i];
            const float mu = wave_sum(s) * (1.f / 512.f); float s2 = 0.f;
#pragma unroll
            for (int i = 0; i < 8; ++i) { g[i] -= mu; s2 += g[i] * g[i]; }
            const float rstd = rsqrtf(wave_sum(s2) * (1.f / 512.f) + EPS);
#pragma unroll
            for (int i = 0; i < 8; ++i) { const float v = g[i] * rstd * lg[i] + lb[i]; vT[(8 * lane + i) * VP + tl] = (bf16_t)(pk2(v, 0.f) & 0xffffu); }
        }
        __syncthreads();
        const int g = wave >> 1, r32 = lane & 31, hh = lane >> 5;
        f32x16 accv[2][4];
#pragma unroll
        for (int ti = 0; ti < 2; ++ti) { const int tm = (wave & 1) + 2 * ti;
#pragma unroll
            for (int c4 = 0; c4 < 4; ++c4)
#pragma unroll
                for (int i = 0; i < 16; ++i) accv[ti][c4][i] = 0.f;
            const int nks = 2 * (tm + 1);
            bf16x8 afr[8];
#pragma unroll
            for (int ks = 0; ks < 8; ++ks) { const int kc = ks < nks ? ks : 0; afr[ks] = *(const bf16x8*)(WSM + ((size_t)g * 128 + tm * 32 + r32) * 128 + kc * 16 + 8 * hh); }
#pragma unroll
            for (int ks = 0; ks < 8; ++ks) asm volatile("" : "+v"(afr[ks]));
#pragma unroll
            for (int ks = 0; ks < 8; ++ks) { if (ks < nks) {
#pragma unroll
                for (int c4 = 0; c4 < 4; ++c4) { const bf16x8 bfv = *(const LAS bf16x8*)(vT + (g * 128 + c4 * 32 + r32) * VP + ks * 16 + 8 * hh);
                    accv[ti][c4] = __builtin_amdgcn_mfma_f32_32x32x16_bf16(afr[ks], bfv, accv[ti][c4], 0, 0, 0); } } }
        }
        __syncthreads();
        constexpr int OP = 520;
        LAS bf16_t* outL = (LAS bf16_t*)F.lds;
#pragma unroll
        for (int ti = 0; ti < 2; ++ti) { const int tm = (wave & 1) + 2 * ti;
#pragma unroll
            for (int i = 0; i < 16; ++i) { const int tl = tm * 32 + (i & 3) + 8 * (i >> 2) + 4 * hh; const float bsv = bs[g * 128 + tl];
#pragma unroll
                for (int c4 = 0; c4 < 4; ++c4) outL[tl * OP + g * 128 + c4 * 32 + r32] = (bf16_t)(pk2(accv[ti][c4][i] + bsv, 0.f) & 0xffffu); } }
        __syncthreads();
        { u32x4 uv[16];
#pragma unroll
          for (int tt = 0; tt < 16; ++tt) uv[tt] = *(const u32x4*)(P + (size_t)(row0 + wave * 16 + tt) * NPROJ + 1536 + 8 * lane);
#pragma unroll
          for (int tt = 0; tt < 16; ++tt) asm volatile("" : "+v"(uv[tt]));
#pragma unroll
          for (int tt = 0; tt < 16; ++tt) { const int tl = wave * 16 + tt; const u32x4 m = *(const LAS u32x4*)(outL + tl * OP + 8 * lane); const u32x4 u = uv[tt];
              u32x4 o;
#pragma unroll
              for (int e = 0; e < 4; ++e) o[e] = pk2(gelu_tanh(bf_lo(u[e])) * bf_lo(m[e]), gelu_tanh(bf_hi(u[e])) * bf_hi(m[e]));
              *(u32x4*)(MIX + (size_t)(row0 + tl) * D + 512 + 8 * lane) = o; } }
        __syncthreads();
    }
}

template <bool OUT>
__device__ __forceinline__ void conv_chunk(const bf16_t* P, int row0, int tseq0, int tl0, int c0, float (&x0)[32], float (&x1)[32], const float (&w0)[31], const float (&w1)[31], float bd0, float bd1, LAS float* tile) {
    unsigned av[32], gv[32];
#pragma unroll
    for (int i = 0; i < 32; ++i) { int tl = tl0 + i; tl = (tseq0 + tl < 0) ? -tseq0 : tl;
        const bf16_t* pr = P + (size_t)(row0 + tl) * NPROJ; av[i] = *(const unsigned*)(pr + c0); gv[i] = *(const unsigned*)(pr + 512 + c0); }
#pragma unroll
    for (int i = 0; i < 32; ++i) asm volatile("" : "+v"(av[i]), "+v"(gv[i]));
#pragma unroll
    for (int i = 0; i < 32; ++i) { const int tl = tl0 + i; const bool ok = (tseq0 + tl >= 0);
        const float h0 = ok ? bf_lo(av[i]) * sigmoid_f(bf_lo(gv[i])) : 0.f, h1 = ok ? bf_hi(av[i]) * sigmoid_f(bf_hi(gv[i])) : 0.f;
        x0[i] = h0; x1[i] = h1;
        if (OUT) { float o0 = bd0, o1 = bd1;
#pragma unroll
            for (int j = 0; j < 31; ++j) { o0 += w0[j] * x0[(i + 2 + j) & 31]; o1 += w1[j] * x1[(i + 2 + j) & 31]; }
            *(LAS f32x2*)(tile + i * 512 + c0) = (f32x2){o0, o1}; }
    }
}
__device__ __forceinline__ void phase_conv(Frame& F, const Args& a, int j2) {
    frame_refresh(F);
    const bf16_t* P = (const bf16_t*)(F.ws + WS_PROJ); bf16_t* MIX = (bf16_t*)(F.ws + WS_MIX);
    const float* wdw = a.in[15] + (size_t)j2 * 31 * 512; const float* bdw = a.in[16] + (size_t)j2 * 512;
    const float* lng = a.in[17] + (size_t)j2 * 512; const float* lnb = a.in[18] + (size_t)j2 * 512;
    const int half = F.tid >> 8, ht = F.tid & 255, c0 = 2 * ht;
    LAS float* tile = (LAS float*)F.lds + half * (32 * 512);
    float w0[31], w1[31];
#pragma unroll
    for (int j = 0; j < 31; ++j) { w0[j] = wdw[j * 512 + c0]; w1[j] = wdw[j * 512 + c0 + 1]; }
    const float bd0 = bdw[c0], bd1 = bdw[c0 + 1];
    const int wih = F.wave & 3;
    for (int s0 = F.vcu * 2; s0 < T / 128; s0 += F.G * 2) {
        const int seg = s0 + half;
        const int row0 = seg * 128, tseq0 = row0 & (SEQ - 1);
        float x0[32], x1[32];
        conv_chunk<false>(P, row0, tseq0, -32, c0, x0, x1, w0, w1, bd0, bd1, tile);
#pragma unroll 1
        for (int cb = 0; cb < 4; ++cb) {
            conv_chunk<true>(P, row0, tseq0, cb * 32, c0, x0, x1, w0, w1, bd0, bd1, tile);
            __syncthreads();
            for (int rr = wih; rr < 32; rr += 4) { const LAS float* tr = tile + rr * 512 + 8 * F.lane; float v[8]; float s = 0.f;
#pragma unroll
                for (int e = 0; e < 8; ++e) { v[e] = tr[e]; s += v[e]; }
                const float mu = wave_sum(s) * (1.f / 512.f); float s2 = 0.f;
#pragma unroll
                for (int e = 0; e < 8; ++e) { v[e] -= mu; s2 += v[e] * v[e]; }
                const float rstd = rsqrtf(wave_sum(s2) * (1.f / 512.f) + EPS);
                float o[8];
#pragma unroll
                for (int e = 0; e < 8; ++e) o[e] = silu_f(v[e] * rstd * lng[8 * F.lane + e] + lnb[8 * F.lane + e]);
                u32x4 ow; ow.x = pk2(o[0], o[1]); ow.y = pk2(o[2], o[3]); ow.z = pk2(o[4], o[5]); ow.w = pk2(o[6], o[7]);
                *(u32x4*)(MIX + (size_t)(row0 + cb * 32 + rr) * D + 8 * F.lane) = ow; }
            __syncthreads();
        }
    }
}

__device__ __forceinline__ void phase_router(Frame& F, const Args& a, int l, const float* xin) {
    frame_refresh(F);
    LAS float* wl = (LAS float*)F.lds;
    LAS int* cls_s = (LAS int*)(F.lds + 81920);
    LAS int* pos_s = cls_s + 256;
    LAS int* lcnt = pos_s + 256;
    LAS int* lbase = lcnt + 32;
    const float* wg = a.in[19] + (size_t)l * 1024 * 4; const float* wrt = a.in[21] + (size_t)l * 4 * 1024 * 4;
    { f32x4 wv[10];
#pragma unroll
      for (int p = 0; p < 10; ++p) { const int q = F.tid + NTHREADS * p; wv[p] = (q < 1024) ? ((const f32x4*)wg)[q] : ((const f32x4*)wrt)[q - 1024]; }
#pragma unroll
      for (int p = 0; p < 10; ++p) { const int q = F.tid + NTHREADS * p, g5 = q >> 10, k = q & 1023;
          wl[(4 * g5 + 0) * 1024 + k] = wv[p].x; wl[(4 * g5 + 1) * 1024 + k] = wv[p].y; wl[(4 * g5 + 2) * 1024 + k] = wv[p].z; wl[(4 * g5 + 3) * 1024 + k] = wv[p].w; } }
    __syncthreads();
    const float* MOD = (const float*)(F.ws + WS_MOD) + (size_t)l * 16 * 6144;
    const float* gam = a.in[4] + (size_t)l * D; const float* bg = a.in[20] + l * 4; const float* br = a.in[22] + l * 16;
    bf16_t* HB = (bf16_t*)(F.ws + WS_HBUF); float* RW = (float*)(F.ws + WS_RW); int* SINFO = (int*)(F.ws + WS_LIST);
    unsigned char* H8 = F.ws + WS_H8; int* TLIST = (int*)(F.ws + WS_TLIST);
    unsigned* cnt = (unsigned*)(F.ws + WS_CTL) + CW_CNT + l * NCLS * 64;
    const float* x = a.in[0]; bf16_t* XB = (bf16_t*)(F.ws + WS_XB); const bool first = (l == 0);
    const f32x4 one4[4] = {{1.f, 1.f, 1.f, 1.f}, {1.f, 1.f, 1.f, 1.f}, {1.f, 1.f, 1.f, 1.f}, {1.f, 1.f, 1.f, 1.f}};
    const int lane = F.lane;
    for (int rb = F.vcu; rb < T / 256; rb += F.G) {
        if (F.tid < 32) lcnt[F.tid] = 0;
        __syncthreads();
        const int rowb = rb * 256 + F.wave * 32, b = rowb >> 12;
        f32x4 gp[4], shv[4]; load_mod(gam, MOD + (size_t)b * 6144 + 3072, MOD + (size_t)b * 6144 + 4096, lane, gp, shv);
        f32x4 h0[4], h1[4], n0[4], n1[4]; u32x2 d0[4], d1[4], nd0[4], nd1[4];
        float lgv[20];
#pragma unroll
        for (int c = 0; c < 20; ++c) lgv[c] = 0.f;
        if (first) { load_row(x + (size_t)rowb * D, lane, h0); load_row(x + (size_t)(rowb + 1) * D, lane, h1); } else { load_row_bf(XB + (size_t)rowb * D, lane, h0); load_row_bf(XB + (size_t)(rowb + 1) * D, lane, h1); }
        load_y(HB + (size_t)rowb * D, lane, d0); load_y(HB + (size_t)(rowb + 1) * D, lane, d1);
#pragma unroll 1
        for (int it = 0; it < 16; ++it) {
            const int rl0 = F.wave * 32 + it * 2, row0 = rb * 256 + rl0;
            if (it + 1 < 16) { if (first) { load_row(x + (size_t)(row0 + 2) * D, lane, n0); load_row(x + (size_t)(row0 + 3) * D, lane, n1); } else { load_row_bf(XB + (size_t)(row0 + 2) * D, lane, n0); load_row_bf(XB + (size_t)(row0 + 3) * D, lane, n1); }
                load_y(HB + (size_t)(row0 + 2) * D, lane, nd0); load_y(HB + (size_t)(row0 + 3) * D, lane, nd1); }
            add_y(h0, d0, one4); add_y(h1, d1, one4);
            store_row_bf16(XB + (size_t)row0 * D, lane, h0); store_row_bf16(XB + (size_t)(row0 + 1) * D, lane, h1);
            const float r0 = row_rstd(h0), r1 = row_rstd(h1);
#pragma unroll
            for (int j = 0; j < 4; ++j) { h0[j] = h0[j] * r0 * gp[j] + shv[j]; h1[j] = h1[j] * r1 * gp[j] + shv[j]; }
            store_row_fp8(H8 + (size_t)row0 * D, lane, h0, SC_H2); store_row_fp8(H8 + (size_t)(row0 + 1) * D, lane, h1, SC_H2);
#pragma unroll
            for (int c = 0; c < 20; c += 2) {
                f32x4 w[2][4];
#pragma unroll
                for (int cc = 0; cc < 2; ++cc)
#pragma unroll
                    for (int j = 0; j < 4; ++j) w[cc][j] = *(const LAS f32x4*)(wl + (c + cc) * 1024 + 4 * lane + 256 * j);
#pragma unroll
                for (int cc = 0; cc < 2; ++cc)
#pragma unroll
                    for (int j = 0; j < 4; ++j) asm volatile("" : "+v"(w[cc][j]));
#pragma unroll
                for (int cc = 0; cc < 2; ++cc) { f32x2 a0 = {0.f, 0.f}, a1 = {0.f, 0.f};
#pragma unroll
                    for (int j = 0; j < 4; ++j) { const f32x4 wv = w[cc][j]; const f32x2 wlo = {wv.x, wv.y}, whi = {wv.z, wv.w};
                        a0 += (f32x2){h0[j].x, h0[j].y} * wlo; a0 += (f32x2){h0[j].z, h0[j].w} * whi;
                        a1 += (f32x2){h1[j].x, h1[j].y} * wlo; a1 += (f32x2){h1[j].z, h1[j].w} * whi; }
                    const float t0 = wave_sum(a0.x + a0.y), t1 = wave_sum(a1.x + a1.y);
                    lgv[c + cc] = (lane == it * 2) ? t0 : ((lane == it * 2 + 1) ? t1 : lgv[c + cc]); } }
#pragma unroll
            for (int j = 0; j < 4; ++j) { h0[j] = n0[j]; h1[j] = n1[j]; d0[j] = nd0[j]; d1[j] = nd1[j]; }
        }
        {
            float gl[4];
#pragma unroll
            for (int i = 0; i < 4; ++i) gl[i] = lgv[i] + bg[i];
            int gi = 0; float gm = gl[0];
#pragma unroll
            for (int i = 1; i < 4; ++i) if (gl[i] > gm) { gm = gl[i]; gi = i; }
            float gs = 0.f;
#pragma unroll
            for (int i = 0; i < 4; ++i) gs += __expf(gl[i] - gm);
            const float gwt = 1.f / gs;
            float el[4];
#pragma unroll
            for (int e = 0; e < 4; ++e) { const float v = (gi == 0) ? lgv[4 + e] : (gi == 1) ? lgv[8 + e] : (gi == 2) ? lgv[12 + e] : lgv[16 + e]; el[e] = v + br[gi * 4 + e]; }
            int ea = 0; float va = el[0];
#pragma unroll
            for (int e = 1; e < 4; ++e) if (el[e] > va) { va = el[e]; ea = e; }
            int eb = -1; float vb = -3.0e38f;
#pragma unroll
            for (int e = 0; e < 4; ++e) if (e != ea && el[e] > vb) { vb = el[e]; eb = e; }
            const float wa = 1.f / (1.f + __expf(vb - va)), wb = 1.f - wa;
            const int lo = ea < eb ? ea : eb, hi = ea < eb ? eb : ea;
            const int pidx = (lo == 0) ? hi - 1 : (lo == 1 ? hi + 1 : 5);
            const int cls = gi * 6 + pidx;
            const float wlo = gwt * (ea == lo ? wa : wb), whi = gwt * (ea == lo ? wb : wa);
            if (lane < 32) { cls_s[F.wave * 32 + lane] = cls; *(f32x2*)(RW + (size_t)(rowb + lane) * 2) = (f32x2){wlo, whi}; }
        }
        __syncthreads();
        if (F.tid < 256) pos_s[F.tid] = atomicAdd((int*)&lcnt[cls_s[F.tid]], 1);
        __syncthreads();
        if (F.tid < NCLS) lbase[F.tid] = (int)__hip_atomic_fetch_add(cnt + F.tid * 64, (unsigned)lcnt[F.tid], __ATOMIC_RELAXED, __HIP_MEMORY_SCOPE_AGENT);
        __syncthreads();
        if (F.tid < 256) { const int c = cls_s[F.tid], pos = lbase[c] + pos_s[F.tid]; SINFO[rb * 256 + F.tid] = (c << 16) | pos;
            __hip_atomic_store(TLIST + (size_t)c * T + pos, rb * 256 + F.tid, __ATOMIC_RELAXED, __HIP_MEMORY_SCOPE_AGENT); }
        __syncthreads();
    }
}

__device__ __forceinline__ void build_moe_table(Frame& F, int l) {
    frame_refresh(F);
    LAS int* tbl = (LAS int*)(F.lds + 131072);
    unsigned* cnt = (unsigned*)(F.ws + WS_CTL) + CW_CNT + l * NCLS * 64;
    if (F.tid == 0) { int acc = 0;
        for (int c = 0; c < NCLS; ++c) { const int n = (int)__hip_atomic_load(cnt + c * 64, __ATOMIC_RELAXED, __HIP_MEMORY_SCOPE_AGENT); tbl[c] = acc; tbl[32 + c] = n; acc += (n + 255) >> 8; }
        tbl[24] = acc; }
    __syncthreads();
    if (F.tid < 320) { const int mt = F.tid; int cls = 0;
        for (int k = 1; k < NCLS; ++k) if (tbl[k] <= mt) cls = k;
        tbl[64 + mt] = cls; }
    __syncthreads();
}

__device__ __forceinline__ void phase_final(Frame& F, const Args& a) {
    frame_refresh(F);
    const int gw = F.vcu * NWAVES + F.wave, NGW = F.G * NWAVES, lane = F.lane;
    const float* MOD = (const float*)(F.ws + WS_MOD) + (size_t)3 * 16 * 6144;
    const bf16_t* Y2 = (const bf16_t*)(F.ws + WS_HSORT); const int* SINFO = (const int*)(F.ws + WS_LIST);
    const LAS int* tbl = (const LAS int*)(F.lds + 131072);
    f32x4 g4[4];
#pragma unroll
    for (int j = 0; j < 4; ++j) g4[j] = ((const f32x4*)a.in[26])[lane + 64 * j];
    for (int blk = gw; blk < T / 32; blk += NGW) {
        const int row0 = blk * 32, b = row0 >> 12;
        f32x4 g2[4];
#pragma unroll
        for (int j = 0; j < 4; ++j) g2[j] = ((const f32x4*)(MOD + (size_t)b * 6144 + 5120))[lane + 64 * j];
        const int si = SINFO[row0 + (lane & 31)]; const int slotv = tbl[si >> 16] * 256 + (si & 0xffff);
        f32x4 xa[4], xb[4], na[4], nb[4]; u32x2 ya[4], yb[4], nya[4], nyb[4];
        const bf16_t* XB = (const bf16_t*)(F.ws + WS_XB); load_row_bf(XB + (size_t)row0 * D, lane, xa); load_row_bf(XB + (size_t)(row0 + 1) * D, lane, xb);
        load_y(Y2 + (size_t)__builtin_amdgcn_readlane(slotv, 0) * D, lane, ya); load_y(Y2 + (size_t)__builtin_amdgcn_readlane(slotv, 1) * D, lane, yb);
#pragma unroll 1
        for (int r = 0; r < 32; r += 2) {
            if (r + 2 < 32) { load_row_bf(XB + (size_t)(row0 + r + 2) * D, lane, na); load_row_bf(XB + (size_t)(row0 + r + 3) * D, lane, nb);
                load_y(Y2 + (size_t)__builtin_amdgcn_readlane(slotv, r + 2) * D, lane, nya); load_y(Y2 + (size_t)__builtin_amdgcn_readlane(slotv, r + 3) * D, lane, nyb); }
            add_y(xa, ya, g2); add_y(xb, yb, g2);
            const float ra = row_rstd(xa), rb = row_rstd(xb);
            f32x4* oa = (f32x4*)(a.out + (size_t)(row0 + r) * D) + lane; f32x4* ob = (f32x4*)(a.out + (size_t)(row0 + r + 1) * D) + lane;
#pragma unroll
            for (int j = 0; j < 4; ++j) { oa[64 * j] = xa[j] * ra * g4[j]; ob[64 * j] = xb[j] * rb * g4[j]; }
#pragma unroll
            for (int j = 0; j < 4; ++j) { xa[j] = na[j]; xb[j] = nb[j]; ya[j] = nya[j]; yb[j] = nyb[j]; }
        }
    }
}

constexpr int NPHASE = 34;
#ifndef PHMASK
#define PHMASK 0xFFFFu
#endif
#define PHON(b) ((PHMASK >> (b)) & 1u)
#ifndef REPMASK
#define REPMASK 0u
#endif
#ifndef REPN
#define REPN 1
#endif
#define NREP(b) (((REPMASK >> (b)) & 1u) ? (1 + REPN) : 1)
#ifndef TIMEMASK
#define TIMEMASK 0u
#endif
#ifndef TIMEK
#define TIMEK 4
#endif
#define TIMEON(b) ((TIMEMASK >> (b)) & 1u)
#define TBEG(b) do { if (TIMEON(b)) t_beg = __builtin_amdgcn_s_memrealtime(); } while (0)
#define TEND(b) do { if (TIMEON(b)) t_acc += __builtin_amdgcn_s_memrealtime() - t_beg; } while (0)

__global__ void __launch_bounds__(NTHREADS, 2) fwd_kernel(Args args) {
    extern __shared__ __attribute__((aligned(16))) unsigned char lds_raw[];
    Frame F;
    F.lds = (LAS unsigned char*)lds_raw;
    F.tid = threadIdx.x; F.lane = F.tid & 63; F.wave = __builtin_amdgcn_readfirstlane(F.tid >> 6);
    F.G = gridDim.x; { const int bx = blockIdx.x; F.vcu = (F.G % 8 == 0) ? (bx % 8) * (F.G / 8) + bx / 8 : bx; }
    F.ws = args.ws;
    volatile LAS unsigned* MISC = (volatile LAS unsigned*)(F.lds + MISC_OFF);
    for (int u = F.tid; u < 256; u += NTHREADS) MISC[u] = 0u;
    __syncthreads();
    unsigned* ctl = (unsigned*)(F.ws + WS_CTL);
    const int lo = args.ph_lo, hi = args.ph_hi;
    const bool multi = (hi - lo) > 1;
    XcdBarrier bar; bar.bar = ctl + CW_BAR; bar.x = 0; bar.st = nullptr;
    if (multi) bar = xcd_barrier_post(ctl + CW_BAR, MISC + 8);
#define IN(k) (lo <= (k) && (k) < hi)
#define SEAM(k) do { if (IN(k) && IN((k) + 1)) xcd_barrier(bar); } while (0)

    unsigned long long t_beg = 0, t_acc = 0;
    TBEG(0);
    if (PHON(0) && IN(0)) { for (int rep = 0; rep < NREP(0); ++rep) { phase_prologue(F, args); __syncthreads(); } }
    SEAM(0);
    TEND(0);

    const float* MODB = (const float*)(F.ws + WS_MOD);
#pragma unroll 1
    for (int l = 0; l < NL; ++l) {
        const int pb = 1 + 8 * l;
        const float* xin = (l == 0) ? args.in[0] : args.out;
        TBEG(1);
        if (PHON(1) && IN(pb + 0)) { if (l > 0) build_moe_table(F, l - 1); phase_norm1(F, args, l); }
        SEAM(pb + 0);
        TEND(1);
        TBEG(2);
        if (PHON(2) && IN(pb + 1)) {
            pg8::DenseSched S{(const char*)(F.ws + WS_HBUF), (const char*)(F.ws + WS_WIN) + (size_t)l * NPROJ * 1024 * 2, T / 256, NPROJ / 256, F.G, (int)blockIdx.x, 2048, 2048};
            pg8::EpiBf16Store E{(bf16_t*)(F.ws + WS_PROJ), NPROJ, 1.f};
            for (int rep = 0; rep < NREP(2); ++rep) pg8::gemm_phase<pg8::EpiBf16Store, pg8::DenseSched, false>(F.lds, 2048, 2048, S, E);
        }
        SEAM(pb + 1);
        TEND(2);
        TBEG(3);
        if (IN(pb + 2)) { if (l & 1) { if (PHON(3)) for (int rep = 0; rep < NREP(3); ++rep) { phase_conv(F, args, l >> 1); __syncthreads(); } } else { if (PHON(4)) for (int rep = 0; rep < NREP(4); ++rep) { phase_dilated2(F, args); __syncthreads(); } } }
        if (l & 1) __syncthreads(); else SEAM(pb + 2);
        TEND(3);
        TBEG(5);
        if (IN(pb + 3)) { if (l & 1) { if (PHON(5)) for (int rep = 0; rep < NREP(5); ++rep) { phase_stick(F); __syncthreads(); } } else { if (PHON(6)) for (int rep = 0; rep < NREP(6); ++rep) { phase_gmlp(F, args, l >> 1); __syncthreads(); } if (PHON(4)) phase_dil_combine(F); } }
        SEAM(pb + 3);
        TEND(5);
        TBEG(7);
        if (PHON(7) && IN(pb + 4)) {
            pg8::DenseSched S{(const char*)(F.ws + WS_MIX), (const char*)(F.ws + WS_WOUT) + (size_t)l * 1024 * 1024 * 2, T / 256, D / 256, F.G, (int)blockIdx.x, 2048, 2048};
            pg8::EpiDelta E{(bf16_t*)(F.ws + WS_HBUF), MODB + (size_t)l * 16 * 6144 + 2048};
            for (int rep = 0; rep < NREP(7); ++rep) pg8::gemm_phase<pg8::EpiDelta, pg8::DenseSched, false>(F.lds, 2048, 2048, S, E);
        }
        SEAM(pb + 4);
        TEND(7);
        TBEG(8);
        if (PHON(8) && IN(pb + 5)) phase_router(F, args, l, xin);
        SEAM(pb + 5);
        TEND(8);
        TBEG(9);
        if (PHON(9) && IN(pb + 6)) {
            build_moe_table(F, l);
            pg8::MoeSched1 S{(const char*)(F.ws + WS_H8), (const char*)(F.ws + WS_WGU) + (size_t)l * 16 * 1024 * 1024, (const char*)(F.ws + WS_TLIST), (const LAS int*)(F.lds + 131072), F.G, (int)blockIdx.x};
            pg8::EpiHid E{F.ws + WS_PROJ, (const float*)(F.ws + WS_RW), 1.f / (SC_H2 * SC_WGU), SC_HID};
            for (int rep = 0; rep < NREP(9); ++rep) pg8::gemm_phase<pg8::EpiHid, pg8::MoeSched1, true, true>(F.lds, 1024, 1024, S, E);
        }
        SEAM(pb + 6);
        TEND(9);
        TBEG(10);
        if (PHON(10) && IN(pb + 7)) {
            build_moe_table(F, l);
            pg8::MoeSched2 S{(const char*)(F.ws + WS_PROJ), (const char*)(F.ws + WS_WDT) + (size_t)l * 1024 * 8192, (const LAS int*)(F.lds + 131072), F.G, (int)blockIdx.x};
            pg8::EpiBf16Store E{(bf16_t*)(F.ws + WS_HSORT), D, 1.f / (SC_HID * SC_WD)};
            for (int rep = 0; rep < NREP(10); ++rep) pg8::gemm_phase<pg8::EpiBf16Store, pg8::MoeSched2, true>(F.lds, 1024, 8192, S, E);
        }
        SEAM(pb + 7);
        TEND(10);
    }
    TBEG(11);
    if (PHON(11) && IN(33)) { build_moe_table(F, NL - 1); phase_final(F, args); }
    TEND(11);
    if (TIMEMASK != 0u && blockIdx.x == 0) {
        const unsigned long long t0 = __builtin_amdgcn_s_memrealtime();
        while (__builtin_amdgcn_s_memrealtime() - t0 < (unsigned long long)TIMEK * t_acc) __builtin_amdgcn_s_sleep(8);
    }
#undef IN
#undef SEAM
}

extern "C" void kernel_launch(void* const* d_in, const int* in_sizes, int n_in, void* d_out, int out_size, void* d_ws, size_t ws_size, hipStream_t stream) {
    static int grid = 0;
    if (grid == 0) {
        if (n_in != 27 || out_size != T * D || ws_size < WS_END) { fprintf(stderr, "kernel_launch: unexpected shapes (n_in %d out %d ws %zu)\n", n_in, out_size, ws_size); grid = -1; return; }
        int dev = 0, cus = 0, per_cu = 0;
        if (hipGetDevice(&dev) != hipSuccess || hipDeviceGetAttribute(&cus, hipDeviceAttributeMultiprocessorCount, dev) != hipSuccess) { grid = -1; return; }
        if (hipFuncSetAttribute((const void*)fwd_kernel, hipFuncAttributeMaxDynamicSharedMemorySize, LDS_BYTES) != hipSuccess) { fprintf(stderr, "kernel_launch: hipFuncSetAttribute failed\n"); grid = -1; return; }
        if (hipOccupancyMaxActiveBlocksPerMultiprocessor(&per_cu, (const void*)fwd_kernel, NTHREADS, LDS_BYTES) != hipSuccess || per_cu < 1) { fprintf(stderr, "kernel_launch: occupancy query says %d\n", per_cu); }
        (void)hipGetLastError();
        grid = cus;
    }
    if (grid < 0) return;
    (void)hipMemsetAsync((char*)d_ws + WS_CTL, 0, CTL_ZERO_BYTES, stream);
    Args a{};
    for (int i = 0; i < 27; ++i) a.in[i] = (const float*)d_in[i];
    a.out = (float*)d_out; a.ws = (unsigned char*)d_ws;
#ifndef MK_MULTI
    a.ph_lo = 0; a.ph_hi = NPHASE;
    hipLaunchKernelGGL(fwd_kernel, dim3(grid), dim3(NTHREADS), LDS_BYTES, stream, a);
#else
    for (int p = 0; p < NPHASE; ++p) { a.ph_lo = p; a.ph_hi = p + 1; hipLaunchKernelGGL(fwd_kernel, dim3(grid), dim3(NTHREADS), LDS_BYTES, stream, a); }
#endif
}
```

```cpp
#include <hip/hip_runtime.h>
#include <cstdio>
#include <cstdint>

#define LAS __attribute__((address_space(3)))
#define GAS __attribute__((address_space(1)))
typedef unsigned short bf16_t;
typedef short bf16x8 __attribute__((ext_vector_type(8)));
typedef float f32x4 __attribute__((ext_vector_type(4)));
typedef float f32x2 __attribute__((ext_vector_type(2)));
typedef float f32x16 __attribute__((ext_vector_type(16)));
typedef unsigned u32x4 __attribute__((ext_vector_type(4)));
typedef unsigned u32x2 __attribute__((ext_vector_type(2)));
typedef __bf16 bf16x2v __attribute__((ext_vector_type(2)));

constexpr int T = 65536, D = 1024, SEQ = 4096, NBATCH = 16, NL = 4, NPROJ = 2560, NEXP = 16, DE = 512, NCLS = 24;
constexpr float EPS = 1e-6f;
constexpr int NWAVES = 8, NTHREADS = 512;
constexpr float SC_H2 = 4.f, SC_WGU = 128.f, SC_HID = 8.f, SC_WD = 64.f;

constexpr size_t MiB = 1u << 20;
constexpr size_t WS_CTL = 0, CTL_ZERO_BYTES = 1 * MiB;
constexpr size_t WS_WIN = 2 * MiB;
constexpr size_t WS_WOUT = 22 * MiB;
constexpr size_t WS_WS = 30 * MiB;
constexpr size_t WS_MOD = 31 * MiB;
constexpr size_t WS_RW = 33 * MiB;
constexpr size_t WS_LIST = 34 * MiB;
constexpr size_t WS_WGU = 40 * MiB;
constexpr size_t WS_WDT = 168 * MiB;
constexpr size_t WS_HBUF = 232 * MiB;
constexpr size_t WS_MIX = 360 * MiB;
constexpr size_t WS_PROJ = 488 * MiB;
constexpr size_t WS_XB = 808 * MiB;
constexpr size_t WS_END = 936 * MiB;
constexpr int HID_ROWS = T + NCLS * 256;
constexpr size_t WS_REST = WS_PROJ, WS_QH = WS_PROJ + 128 * MiB, WS_KH = WS_PROJ + 192 * MiB, WS_VH = WS_PROJ + 256 * MiB;
constexpr size_t QKV_SEC = (size_t)NBATCH * 8 * SEQ * 64;
constexpr size_t WS_TLIST = WS_PROJ + 80 * MiB;
constexpr size_t WS_H8 = WS_MIX;
constexpr size_t WS_HSORT = WS_PROJ + 160 * MiB;
constexpr int CW_BAR = 4096;
constexpr int CW_CNT = 8192;

constexpr int LDS_BYTES = 155648;
constexpr int MISC_OFF = LDS_BYTES - 1024;

__device__ __forceinline__ unsigned pk2(float a, float b) { f32x2 v = {a, b}; bf16x2v r = __builtin_convertvector(v, bf16x2v); return __builtin_bit_cast(unsigned, r); }
__device__ __forceinline__ float bf_lo(unsigned u) { return __uint_as_float(u << 16); }
__device__ __forceinline__ float bf_hi(unsigned u) { return __uint_as_float(u & 0xffff0000u); }
__device__ __forceinline__ float bf1(bf16_t b) { return __uint_as_float(((unsigned)b) << 16); }
template <int CTRL, int RM> __device__ __forceinline__ float dpp_mov0(float v) { return __builtin_bit_cast(float, __builtin_amdgcn_update_dpp(0, __builtin_bit_cast(int, v), CTRL, RM, 0xf, true)); }
__device__ __forceinline__ float wave_sum(float v) {
    v += dpp_mov0<0xB1, 0xf>(v); v += dpp_mov0<0x4E, 0xf>(v); v += dpp_mov0<0x141, 0xf>(v); v += dpp_mov0<0x140, 0xf>(v);
    v += dpp_mov0<0x142, 0xa>(v); v += dpp_mov0<0x143, 0xc>(v);
    return __builtin_bit_cast(float, __builtin_amdgcn_readlane(__builtin_bit_cast(int, v), 63));
}
__device__ __forceinline__ float frcp(float x) { return __builtin_amdgcn_rcpf(x); }
__device__ __forceinline__ float silu_f(float x) { return x * frcp(1.f + __expf(-x)); }
__device__ __forceinline__ float sigmoid_f(float x) { return frcp(1.f + __expf(-x)); }
__device__ __forceinline__ float gelu_tanh(float x) {
    const float u = 0.7978845608028654f * (x + 0.044715f * x * x * x);
    const float e = __expf(2.f * u);
    const float th = 1.f - 2.f * frcp(e + 1.f);
    return 0.5f * x * (1.f + th);
}
__device__ __forceinline__ unsigned pk_fp8x4(float a, float b, float c, float d) {
    a = fminf(fmaxf(a, -448.f), 448.f); b = fminf(fmaxf(b, -448.f), 448.f); c = fminf(fmaxf(c, -448.f), 448.f); d = fminf(fmaxf(d, -448.f), 448.f);
    unsigned w = 0; w = __builtin_amdgcn_cvt_pk_fp8_f32(a, b, w, false); w = __builtin_amdgcn_cvt_pk_fp8_f32(c, d, w, true); return w;
}
#define LDS_WAIT() asm volatile("s_waitcnt lgkmcnt(0)" ::: "memory")

#define XB_TMO      128
#define XB_XCNT(j)  (256  + 64 * (j))
#define XB_XSUB(j)  (1280 + 64 * (j))
#define XB_XGEN(j)  (2304 + 64 * (j))
#define XB_TOP      3328
#define XB_TOPGEN   3392
#define XCD_BAR_WORDS 3456
#define XB_SPIN_CAP (1u << 20)

__device__ __forceinline__ unsigned xb_ld(unsigned* p)              { return __hip_atomic_load(p, __ATOMIC_RELAXED, __HIP_MEMORY_SCOPE_AGENT); }
__device__ __forceinline__ unsigned xb_add(unsigned* p, unsigned v) { return __hip_atomic_fetch_add(p, v, __ATOMIC_RELAXED, __HIP_MEMORY_SCOPE_AGENT); }
__device__ __forceinline__ unsigned xb_xcc_id() { return (unsigned)__builtin_amdgcn_s_getreg((3 << 11) | 20) & 0xFu; }
#define XB_SPIN(cond, bar) do { unsigned _sp = 0; while (cond) { __builtin_amdgcn_s_sleep(1); \
    if ((++_sp & 255u) == 0u) { if (xb_ld(&(bar)[XB_TMO])) break; if (_sp > XB_SPIN_CAP) { atomicAdd(&(bar)[XB_TMO], 1u); break; } } } } while (0)

struct XcdBarrier { unsigned* bar; unsigned x; volatile LAS unsigned* st; };

__device__ __forceinline__ XcdBarrier xcd_barrier_post(unsigned* bar, volatile LAS unsigned* st) {
    XcdBarrier b; b.bar = bar; b.x = xb_xcc_id(); b.st = st;
    if (threadIdx.x == 0) (void)xb_add(&bar[XB_XCNT(b.x)], 1u);
    return b;
}
__device__ __forceinline__ void xcd_barrier_complete(unsigned* bar, unsigned x, unsigned& nloc, unsigned& nx) {
    const unsigned G = gridDim.x * gridDim.y * gridDim.z;
    unsigned sum, cnt, mine, sp = 0u;
    for (;;) {
        sum = 0u; cnt = 0u; mine = 0u;
#pragma unroll
        for (unsigned j = 0; j < 16; ++j) { const unsigned c = xb_ld(&bar[XB_XCNT(j)]); sum += c; cnt += (c > 0u) ? 1u : 0u; mine = (j == x) ? c : mine; }
        if (sum == G) break;
        __builtin_amdgcn_s_sleep(1);
        if ((++sp & 255u) == 0u) { if (xb_ld(&bar[XB_TMO])) break; if (sp > XB_SPIN_CAP) { atomicAdd(&bar[XB_TMO], 1u); break; } }
    }
    nloc = mine > 0u ? mine : 1u; nx = cnt > 0u ? cnt : 1u;
}
__device__ __forceinline__ void xcd_barrier(const XcdBarrier& b) {
    asm volatile("s_waitcnt vmcnt(0)" ::: "memory");
    __syncthreads();
    if (threadIdx.x == 0) {
        unsigned* bar = b.bar;
        __builtin_amdgcn_s_waitcnt(0);
        unsigned nloc = b.st[0], nx = b.st[1];
        if (nloc == 0u) { xcd_barrier_complete(bar, b.x, nloc, nx); b.st[0] = nloc; b.st[1] = nx; }
        const unsigned old = xb_add(&bar[XB_XSUB(b.x)], 1u);
        const unsigned gen = old / nloc;
        if (old + 1u == (gen + 1u) * nloc) {
            __builtin_amdgcn_fence(__ATOMIC_RELEASE, "agent");
            asm volatile("s_waitcnt vmcnt(0)" ::: "memory");
            const unsigned og = xb_add(&bar[XB_TOP], 1u);
            const unsigned tg = og / nx;
            if (og + 1u == (tg + 1u) * nx) xb_add(&bar[XB_TOPGEN], 1u);
            else XB_SPIN(xb_ld(&bar[XB_TOPGEN]) == tg, bar);
            __builtin_amdgcn_fence(__ATOMIC_ACQUIRE, "agent");
            xb_add(&bar[XB_XGEN(b.x)], 1u);
            asm volatile("s_waitcnt vmcnt(0)" ::: "memory");
        } else {
            XB_SPIN(xb_ld(&bar[XB_XGEN(b.x)]) == gen, bar);
            __builtin_amdgcn_fence(__ATOMIC_ACQUIRE, "agent");
            asm volatile("s_waitcnt vmcnt(0)" ::: "memory");
        }
    }
    __syncthreads();
}

namespace pg8 {
constexpr int BM = 256, BK = 64, HALF = 128, HTB = HALF * BK * 2, STAGE_BYTES = 8 * HTB, NXCD = 8, WGM = 8, KT = 16;
__device__ __forceinline__ int lds_byte(int r, int c) { const int st = (r >> 4) * 2 + (c >> 5), rr = r & 15, cc = c & 31, ob = rr * 64 + cc * 2; return st * 1024 + (ob ^ (((ob >> 9) & 1) << 5)); }
__device__ __forceinline__ void stage_rc(int b, int& R, int& C) { const int st = b / 1024, sb = b % 1024, swz = sb ^ (((sb >> 9) & 1) << 5); R = (st >> 1) * 16 + swz / 64; C = (st & 1) * 32 + (swz % 64) / 2; }
__device__ __forceinline__ int perm32(int rho) { const int n = rho >> 4, i = rho & 15; return 8 * (i >> 2) + 4 * n + (i & 3); }

struct Unit { int A, B0, B1; int listoff; int nvalid, r0, c0, aux; };

__device__ __forceinline__ bool static_tile(int i, int G, int c, int nM, int nN, int& pm, int& pn) {
    const int nwg = nM * nN; const long L = (long)i * G + c; if (L >= nwg) return false;
    int wgid = (int)L; { const int q = nwg / NXCD, r = nwg % NXCD, xcd = wgid % NXCD, off = wgid / NXCD; wgid = (xcd < r ? xcd * (q + 1) : r * (q + 1) + (xcd - r) * q) + off; }
    const int nig = WGM * nN, gid = wgid / nig, fm = gid * WGM, gsz = (nM - fm) < WGM ? (nM - fm) : WGM;
    pm = fm + ((wgid % nig) % gsz); pn = (wgid % nig) / gsz; return true;
}

typedef int v8i_t __attribute__((ext_vector_type(8)));
typedef int v4i_t __attribute__((ext_vector_type(4)));
template <class Epi, class Sched, bool F8, bool GATHER = false>
__device__ __forceinline__ void gemm_phase(LAS unsigned char* lds, const int lda, const int ldb, const Sched& S, const Epi& E) {
    constexpr int KTN = F8 ? 8 : 16, KSPL = KTN / 2;
    int tid = threadIdx.x; asm volatile("" : "+v"(tid));
    const int wid = __builtin_amdgcn_readfirstlane(tid >> 6), lane = tid & 63, wr = wid >> 2, wc = wid & 3, fr = lane & 15, fq = lane >> 4;
    unsigned voffA[2], voffB[2], vg[2][2];
#pragma unroll
    for (int i = 0; i < 2; ++i) { int R, C; stage_rc(tid * 16 + i * 8192, R, C); const int Rb = Epi::PERM ? ((R & ~31) + perm32(R & 31)) : R;
        voffA[i] = (unsigned)(R * lda + C * 2); voffB[i] = (unsigned)(Rb * ldb + C * 2); }
    LAS int* toks = (LAS int*)(lds + 131072 + 4096);
#define PG8_TOKDMA(un, slot) do { if (GATHER && wid == 0) __builtin_amdgcn_raw_ptr_buffer_load_lds(rsL, (LAS void*)(toks + (slot) * 256), 16, lane * 16, (un).listoff, 0, 0); } while (0)
#define PG8_VG(un, slot) do { _Pragma("unroll") for (int _i = 0; _i < 2; ++_i) { int _R, _C; stage_rc(tid * 16 + _i * 8192, _R, _C); \
        _Pragma("unroll") for (int _h = 0; _h < 2; ++_h) { const int _idx = _h * HALF + _R; int _tok = toks[(slot) * 256 + _idx]; _tok = (_idx < (un).nvalid) ? _tok : 0; \
            vg[_h][_i] = (unsigned)(_tok * lda + _C * 2); } } } while (0)
    const int kstep = BK * 2;
    const int hstepA = HALF * lda, hstepB = HALF * ldb;
    const unsigned ldsw = (unsigned)wid * 1024u;
    int aoffk[2], boffk[2];
#pragma unroll
    for (int k = 0; k < 2; ++k) { aoffk[k] = F8 ? lds_byte(wr * 64 + fr, fq * 16 + 8 * k) : lds_byte(wr * 64 + fr, fq * 8 + 32 * k);
        boffk[k] = F8 ? lds_byte(wc * 32 + fr, fq * 16 + 8 * k) : lds_byte(wc * 32 + fr, fq * 8 + 32 * k); }
#define PG8_SA(b, h) (((b) * 2 + (h)) * HTB)
#define PG8_SB(b, h) ((4 + (b) * 2 + (h)) * HTB)
    const __amdgpu_buffer_rsrc_t rsA = __builtin_amdgcn_make_buffer_rsrc((void*)S.Abase, 0, 0x7fffffff, 0x00020000), rsB = __builtin_amdgcn_make_buffer_rsrc((void*)S.Bbase, 0, 0x7fffffff, 0x00020000);
#define PG8_STAGE_X(rs, bufoff, soff, voff) do { _Pragma("unroll") for (int _i = 0; _i < 2; ++_i) \
        __builtin_amdgcn_raw_ptr_buffer_load_lds(rs, (LAS void*)(lds + (bufoff) + ldsw + _i * 8192), 16, (int)(voff)[_i], (int)(soff), 0, 0); } while (0)
    __amdgpu_buffer_rsrc_t rsL = rsA; if constexpr (GATHER) rsL = __builtin_amdgcn_make_buffer_rsrc((void*)S.Lbase, 0, 0x7fffffff, 0x00020000);
#define PG8_STAGE_A(bufoff, soff) PG8_STAGE_X(rsA, bufoff, soff, voffA)
#define PG8_STAGE_AH(bufoff, soff, h) do { if constexpr (GATHER) PG8_STAGE_X(rsA, bufoff, soff, vg[h]); else PG8_STAGE_X(rsA, bufoff, (soff) + (h) * hstepA, voffA); } while (0)
#define PG8_STAGE_B(bufoff, soff) PG8_STAGE_X(rsB, bufoff, soff, voffB)
#define PG8_RD(off) (*(const LAS v4i_t*)(lds + (off)))
#define PG8_LDA(dst, b, h) do { _Pragma("unroll") for (int m = 0; m < 4; ++m) { \
        if constexpr (F8) dst##8[m] = __builtin_shufflevector(PG8_RD(PG8_SA(b, h) + aoffk[0] + m * 2048), PG8_RD(PG8_SA(b, h) + aoffk[1] + m * 2048), 0, 1, 2, 3, 4, 5, 6, 7); \
        else { _Pragma("unroll") for (int k = 0; k < 2; ++k) dst[m][k] = *(const LAS bf16x8*)(lds + PG8_SA(b, h) + aoffk[k] + m * 2048); } } } while (0)
#define PG8_LDB(dst, b, h) do { _Pragma("unroll") for (int n = 0; n < 2; ++n) { \
        if constexpr (F8) dst##8[n] = __builtin_shufflevector(PG8_RD(PG8_SB(b, h) + boffk[0] + n * 2048), PG8_RD(PG8_SB(b, h) + boffk[1] + n * 2048), 0, 1, 2, 3, 4, 5, 6, 7); \
        else { _Pragma("unroll") for (int k = 0; k < 2; ++k) dst[n][k] = *(const LAS bf16x8*)(lds + PG8_SB(b, h) + boffk[k] + n * 2048); } } } while (0)
#define PG8_MMA(ai, bj, At, Bt) do { __builtin_amdgcn_s_setprio(1); _Pragma("unroll") for (int m = 0; m < 4; ++m) _Pragma("unroll") for (int n = 0; n < 2; ++n) { \
        if constexpr (F8) asm volatile("s_nop 1\n\tv_mfma_scale_f32_16x16x128_f8f6f4 %0, %1, %2, %0, %3, %3 op_sel_hi:[0,0,0]" : "+v"(acc[ai][bj][m][n]) : "v"(Bt##8[n]), "v"(At##8[m]), "v"(f8scale)); \
        else { _Pragma("unroll") for (int k = 0; k < 2; ++k) acc[ai][bj][m][n] = __builtin_amdgcn_mfma_f32_16x16x32_bf16(Bt[n][k], At[m][k], acc[ai][bj][m][n], 0, 0, 0); } } \
        __builtin_amdgcn_s_setprio(0); } while (0)
#define PG8_WAIT_V(n) asm volatile("s_waitcnt vmcnt(" #n ")" ::: "memory")
#define PG8_WAIT_L(n) asm volatile("s_waitcnt lgkmcnt(" #n ")" ::: "memory")
#define PG8_BAR __builtin_amdgcn_s_barrier()
#define PG8_SCHED __builtin_amdgcn_sched_barrier(0)
    Unit cur, nxt; int ui = 0;
    if (!S.next(0, cur)) return;
    f32x4 acc[2][2][4][2];
#pragma unroll
    for (int a = 0; a < 2; ++a)
#pragma unroll
        for (int b = 0; b < 2; ++b)
#pragma unroll
            for (int m = 0; m < 4; ++m)
#pragma unroll
                for (int n = 0; n < 2; ++n) acc[a][b][m][n] = (f32x4){0.f, 0.f, 0.f, 0.f};
    int f8scale = 0x7f7f7f7f; asm volatile("" : "+v"(f8scale));
    bf16x8 At[4][2], B0[2][2], B1[2][2]; v8i_t At8[4], B08[2], B18[2];
    int cA = cur.A, cB0 = cur.B0, cB1 = cur.B1;
    if constexpr (GATHER) { PG8_TOKDMA(cur, 0); PG8_WAIT_V(0); __syncthreads(); PG8_VG(cur, 0); }
    PG8_STAGE_B(PG8_SB(0, 0), cB0); PG8_STAGE_AH(PG8_SA(0, 0), cA, 0); PG8_STAGE_B(PG8_SB(0, 1), cB0 + hstepB); PG8_STAGE_AH(PG8_SA(0, 1), cA, 1);
    if (wr == 1) PG8_BAR;
    PG8_WAIT_V(4); PG8_BAR;
    PG8_STAGE_B(PG8_SB(1, 0), cB0 + kstep); PG8_STAGE_AH(PG8_SA(1, 0), cA + kstep, 0); PG8_STAGE_B(PG8_SB(1, 1), cB0 + hstepB + kstep);
    PG8_WAIT_V(6); PG8_BAR;
    for (;;) {
        const bool has_next = S.next(ui + 1, nxt);
        const int nA = has_next ? nxt.A : cA, nB = has_next ? nxt.B0 : cB0;
        const int tslot = ui % 3, nslot = (ui + 1) % 3;
        if (has_next) PG8_TOKDMA(nxt, nslot);
#pragma unroll 1
        for (int t = 0; t < KTN; t += 2) {
            const bool last = (t == KTN - 2);
            const int a1 = cA + (t + 1) * kstep;
            const int a2 = last ? nA : cA + (t + 2) * kstep;
            const int b2 = last ? nB : ((t + 2 < KSPL) ? cB0 : cB1) + (t + 2) * kstep;
            const int a3 = a2 + kstep, b3 = b2 + kstep;
            PG8_LDB(B0, 0, 0); PG8_SCHED; PG8_LDA(At, 0, 0); PG8_STAGE_AH(PG8_SA(1, 1), a1, 1);
            if constexpr (GATHER) { if (last && has_next) PG8_VG(nxt, nslot); }
            PG8_WAIT_L(8); PG8_BAR; PG8_WAIT_L(0); PG8_MMA(0, 0, At, B0); PG8_BAR; PG8_SCHED;
            PG8_LDB(B1, 0, 1); PG8_STAGE_B(PG8_SB(0, 0), b2);
            PG8_BAR; PG8_WAIT_L(0); PG8_MMA(0, 1, At, B1); PG8_BAR;
            PG8_LDA(At, 0, 1); PG8_STAGE_AH(PG8_SA(0, 0), a2, 0);
            PG8_BAR; PG8_WAIT_L(0); PG8_MMA(1, 0, At, B0); PG8_BAR; PG8_SCHED;
            PG8_STAGE_B(PG8_SB(0, 1), b2 + hstepB);
            PG8_WAIT_V(6); PG8_BAR; PG8_MMA(1, 1, At, B1); PG8_BAR;
            PG8_LDB(B0, 1, 0); PG8_SCHED; PG8_LDA(At, 1, 0); PG8_STAGE_AH(PG8_SA(0, 1), a2, 1);
            PG8_WAIT_L(8); PG8_BAR; PG8_WAIT_L(0); PG8_MMA(0, 0, At, B0); PG8_BAR; PG8_SCHED;
            PG8_LDB(B1, 1, 1); PG8_STAGE_B(PG8_SB(1, 0), b3);
            PG8_BAR; PG8_WAIT_L(0); PG8_MMA(0, 1, At, B1); PG8_BAR;
            PG8_LDA(At, 1, 1); PG8_STAGE_AH(PG8_SA(1, 0), a3, 0);
            PG8_BAR; PG8_WAIT_L(0); PG8_MMA(1, 0, At, B0); PG8_BAR; PG8_SCHED;
            PG8_STAGE_B(PG8_SB(1, 1), b3 + hstepB);
            PG8_WAIT_V(6); PG8_BAR; PG8_MMA(1, 1, At, B1); PG8_BAR;
        }
        if constexpr (F8) asm volatile("s_nop 15\n\ts_nop 15" ::: "memory");
        E(acc, cur, wr, wc, fr, fq, toks + tslot * 256);
        if (!has_next) break;
#pragma unroll
        for (int a = 0; a < 2; ++a)
#pragma unroll
            for (int b = 0; b < 2; ++b)
#pragma unroll
                for (int m = 0; m < 4; ++m)
#pragma unroll
                    for (int n = 0; n < 2; ++n) acc[a][b][m][n] = (f32x4){0.f, 0.f, 0.f, 0.f};
        cur = nxt; cA = nA; cB0 = cur.B0; cB1 = cur.B1; ++ui;
    }
    PG8_WAIT_V(0);
    if (wr == 0) PG8_BAR;
    PG8_BAR;
#undef PG8_SA
#undef PG8_SB
#undef PG8_STAGE_X
#undef PG8_STAGE_A
#undef PG8_STAGE_B
#undef PG8_STAGE_AH
#undef PG8_TOKDMA
#undef PG8_VG
#undef PG8_LDA
#undef PG8_LDB
#undef PG8_MMA
#undef PG8_RD
#undef PG8_WAIT_V
#undef PG8_WAIT_L
#undef PG8_BAR
#undef PG8_SCHED
}


struct EpiBf16Store {
    static constexpr bool PERM = true;
    bf16_t* O; int ldc; float sc;
    __device__ __forceinline__ void operator()(const f32x4 (&acc)[2][2][4][2], const Unit& u, int wr, int wc, int fr, int fq, const LAS int* toks) const {
        const int row0 = u.r0 + wr * 64 + fr, col0 = u.c0 + wc * 32 + 8 * fq;
#pragma unroll
        for (int ai = 0; ai < 2; ++ai)
#pragma unroll
            for (int m = 0; m < 4; ++m) { bf16_t* rowp = O + (size_t)(row0 + ai * HALF + m * 16) * ldc + col0;
#pragma unroll
                for (int bj = 0; bj < 2; ++bj) { const f32x4 v0 = acc[ai][bj][m][0] * sc, v1 = acc[ai][bj][m][1] * sc;
                    u32x4 w; w.x = pk2(v0[0], v0[1]); w.y = pk2(v0[2], v0[3]); w.z = pk2(v1[0], v1[1]); w.w = pk2(v1[2], v1[3]);
                    *(u32x4*)(rowp + bj * HALF) = w; } }
    }
};
struct EpiProj {
    static constexpr bool PERM = true;
    bf16_t* rest; bf16_t* qh; int odd;
    __device__ __forceinline__ void operator()(const f32x4 (&acc)[2][2][4][2], const Unit& u, int wr, int wc, int fr, int fq, const LAS int* toks) const {
        const int sec = u.c0 >> 9, cin = u.c0 & 511;
        const bool isqkv = odd ? (sec >= 2) : (sec < 3);
        const int qi = odd ? sec - 2 : sec, restcol0 = (odd ? sec : sec - 3) * 512;
        const int row0 = u.r0 + wr * 64 + fr;
#pragma unroll
        for (int ai = 0; ai < 2; ++ai)
#pragma unroll
            for (int m = 0; m < 4; ++m) { const int row = row0 + ai * HALF + m * 16;
#pragma unroll
                for (int bj = 0; bj < 2; ++bj) { const f32x4 v0 = acc[ai][bj][m][0], v1 = acc[ai][bj][m][1];
                    u32x4 w; w.x = pk2(v0[0], v0[1]); w.y = pk2(v0[2], v0[3]); w.z = pk2(v1[0], v1[1]); w.w = pk2(v1[2], v1[3]);
                    const int cs = cin + bj * HALF + wc * 32 + 8 * fq;
                    bf16_t* dst = isqkv ? qh + (size_t)qi * QKV_SEC + ((size_t)((row >> 12) * 8 + (cs >> 6)) * SEQ + (row & (SEQ - 1))) * 64 + (cs & 63)
                                        : rest + (size_t)row * 1024 + restcol0 + cs;
                    *(u32x4*)dst = w; } }
    }
};
struct EpiDelta {
    static constexpr bool PERM = true;
    bf16_t* O; const float* gate;
    __device__ __forceinline__ void operator()(const f32x4 (&acc)[2][2][4][2], const Unit& u, int wr, int wc, int fr, int fq, const LAS int* toks) const {
        const int row0 = u.r0 + wr * 64 + fr, col0 = u.c0 + wc * 32 + 8 * fq;
        const float* gp = gate + (size_t)(u.r0 >> 12) * 6144 + col0;
        f32x4 gv[2][2];
#pragma unroll
        for (int bj = 0; bj < 2; ++bj)
#pragma unroll
            for (int n = 0; n < 2; ++n) gv[bj][n] = *(const f32x4*)(gp + bj * HALF + 4 * n);
#pragma unroll
        for (int ai = 0; ai < 2; ++ai)
#pragma unroll
            for (int m = 0; m < 4; ++m) { bf16_t* rowp = O + (size_t)(row0 + ai * HALF + m * 16) * D + col0;
#pragma unroll
                for (int bj = 0; bj < 2; ++bj) { const f32x4 v0 = acc[ai][bj][m][0] * gv[bj][0], v1 = acc[ai][bj][m][1] * gv[bj][1];
                    u32x4 w; w.x = pk2(v0[0], v0[1]); w.y = pk2(v0[2], v0[3]); w.z = pk2(v1[0], v1[1]); w.w = pk2(v1[2], v1[3]);
                    *(u32x4*)(rowp + bj * HALF) = w; } }
    }
};
struct EpiHid {
    static constexpr bool PERM = true;
    unsigned char* H; const float* rw; float isc, osc;
    __device__ __forceinline__ void operator()(const f32x4 (&acc)[2][2][4][2], const Unit& u, int wr, int wc, int fr, int fq, const LAS int* toks) const {
        const int rl0 = wr * 64 + fr, col0 = u.c0 + wc * 32 + 8 * fq;
#pragma unroll
        for (int ai = 0; ai < 2; ++ai)
#pragma unroll
            for (int m = 0; m < 4; ++m) { const int rl = rl0 + ai * HALF + m * 16;
                float w = 0.f; if (rl < u.nvalid) w = rw[(size_t)toks[rl] * 2 + u.aux] * osc * isc;
                const f32x4 g0 = acc[ai][0][m][0] * isc, g1 = acc[ai][0][m][1] * isc, u0 = acc[ai][1][m][0], u1 = acc[ai][1][m][1];
                float h[8];
#pragma unroll
                for (int j = 0; j < 4; ++j) { h[j] = silu_f(g0[j]) * u0[j] * w; h[4 + j] = silu_f(g1[j]) * u1[j] * w; }
                u32x2 o; o.x = pk_fp8x4(h[0], h[1], h[2], h[3]); o.y = pk_fp8x4(h[4], h[5], h[6], h[7]);
                *(u32x2*)(H + (size_t)(u.r0 + rl) * D + col0) = o; }
    }
};

struct DenseSched {
    const char* Abase; const char* Bbase; int nM, nN, G, c, lda, ldb;
    __device__ __forceinline__ bool next(int i, Unit& u) const {
        int pm, pn; if (!static_tile(i, G, c, nM, nN, pm, pn)) return false;
        u.A = pm * BM * lda; u.B0 = pn * BM * ldb; u.B1 = u.B0; u.listoff = 0; u.nvalid = 256; u.r0 = pm * BM; u.c0 = pn * BM; u.aux = 0; return true;
    }
};
__device__ __forceinline__ void cls_experts(int cls, int& e_lo, int& e_hi) {
    const int g = cls / 6, p = cls % 6; const int lo = (p < 3) ? 0 : (p < 5 ? 1 : 2); const int hi = (p < 3) ? p + 1 : (p < 5 ? p - 1 : 3);
    e_lo = g * 4 + lo; e_hi = g * 4 + hi;
}
struct MoeSched1 {
    const char* Abase; const char* Bbase; const char* Lbase; const LAS int* tbl; int G, c;
    __device__ __forceinline__ bool next(int i, Unit& u) const {
        const int MT = tbl[24]; int mt, pn; if (!static_tile(i, G, c, MT, 8, mt, pn)) return false;
        const int cls = tbl[64 + mt];
        const int ml = mt - tbl[cls]; int e_lo, e_hi; cls_experts(cls, e_lo, e_hi);
        const int e = (pn < 4) ? e_lo : e_hi;
        u.A = 0; u.B0 = (e * 1024 + (pn & 3) * 256) * 1024; u.B1 = u.B0; u.listoff = (cls * T + ml * 256) * 4;
        const int rem = tbl[32 + cls] - ml * 256; u.nvalid = rem < 256 ? rem : 256; u.r0 = mt * 256; u.c0 = (pn >> 2) * 512 + (pn & 3) * 128; u.aux = pn >> 2; return true;
    }
};
struct MoeSched2 {
    const char* Abase; const char* Bbase; const LAS int* tbl; int G, c;
    __device__ __forceinline__ bool next(int i, Unit& u) const {
        const int MT = tbl[24]; int mt, pn; if (!static_tile(i, G, c, MT, 4, mt, pn)) return false;
        const int cls = tbl[64 + mt];
        const int ml = mt - tbl[cls]; int e_lo, e_hi; cls_experts(cls, e_lo, e_hi);
        u.A = mt * 256 * 1024;
        const int brow = pn * 256 * 8192;
        u.B0 = brow + e_lo * 512; u.B1 = brow + e_hi * 512 - 4 * 128; u.listoff = 0;
        const int rem = tbl[32 + cls] - ml * 256; u.nvalid = rem < 256 ? rem : 256; u.r0 = mt * 256; u.c0 = pn * 256; u.aux = 0; return true;
    }
};
}

struct Args { const float* in[27]; float* out; unsigned char* ws; int ph_lo, ph_hi; };

__device__ const unsigned char BUCKET[3][132] = {
 {0,1,2,3,4,5,6,7,8,9,10,11,12,13,14,15,16,16,16,16,16,16,17,17,17,17,17,17,17,17,18,18,18,18,18,18,18,18,18,18,19,19,19,19,19,19,19,19,19,19,19,19,19,19,20,20,20,20,20,20,20,20,20,20,20,20,20,20,20,20,20,20,20,21,21,21,21,21,21,21,21,21,21,21,21,21,21,21,21,21,21,21,21,21,21,21,21,21,21,22,22,22,22,22,22,22,22,22,22,22,22,22,22,22,22,22,22,22,22,22,22,22,22,22,22,22,22,22,22,0,0,0},
 {0,4,8,12,16,16,17,17,18,18,19,19,19,19,20,20,20,20,20,21,21,21,21,21,21,22,22,22,22,22,22,22,22,22,23,23,23,23,23,23,23,23,23,23,23,23,24,24,24,24,24,24,24,24,24,24,24,24,24,24,24,24,25,25,25,25,25,25,25,25,25,25,25,25,25,25,25,25,25,25,25,25,25,26,26,26,26,26,26,26,26,26,26,26,26,26,26,26,26,26,26,26,26,26,26,26,26,26,26,26,26,26,26,27,27,27,27,27,27,27,27,27,27,27,27,27,27,27,27,0,0,0},
 {0,16,18,19,20,21,21,22,22,23,23,23,24,24,24,24,25,25,25,25,25,26,26,26,26,26,26,26,26,27,27,27,27,27,27,27,27,27,27,28,28,28,28,28,28,28,28,28,28,28,28,28,29,29,29,29,29,29,29,29,29,29,29,29,29,29,29,29,29,29,30,30,30,30,30,30,30,30,30,30,30,30,30,30,30,30,30,30,30,30,30,30,30,30,30,31,31,31,31,31,31,31,31,31,31,31,31,31,31,31,31,31,31,31,31,31,31,31,31,31,31,31,31,31,31,31,31,31,31,0,0,0}};

struct Frame {
    LAS unsigned char* lds;
    int tid, lane, wave, vcu, G;
    unsigned char* ws;
};

__device__ __forceinline__ void frame_refresh(Frame& F) {
    int tid = threadIdx.x; asm volatile("" : "+v"(tid));
    F.tid = tid; F.lane = tid & 63; F.wave = __builtin_amdgcn_readfirstlane(tid >> 6);
}
__device__ __forceinline__ void transpose_item(const float* W, int srcN, int k0, int n0, bf16_t* dst, size_t dstride, LAS float* scr, int lane) {
#pragma unroll 8
    for (int i = 0; i < 32; ++i) { const int kk = 2 * i + (lane >> 5); scr[kk * 33 + (lane & 31)] = W[(size_t)(k0 + kk) * srcN + n0 + (lane & 31)]; }
    LDS_WAIT(); asm volatile("" ::: "memory");
    const int c = lane & 7;
#pragma unroll
    for (int j = 0; j < 4; ++j) { const int n = (lane >> 3) + 8 * j; const LAS float* s = scr + (8 * c) * 33 + n;
        u32x4 o; o.x = pk2(s[0 * 33], s[1 * 33]); o.y = pk2(s[2 * 33], s[3 * 33]); o.z = pk2(s[4 * 33], s[5 * 33]); o.w = pk2(s[6 * 33], s[7 * 33]);
        *(u32x4*)(dst + (size_t)n * dstride + 8 * c) = o; }
    LDS_WAIT(); asm volatile("" ::: "memory");
}

__device__ __forceinline__ void transpose_item_f8(const float* W, int srcN, int k0, int n0, unsigned char* dst, size_t dstride, LAS float* scr, int lane, float sc) {
#pragma unroll 8
    for (int i = 0; i < 32; ++i) { const int kk = 2 * i + (lane >> 5); scr[kk * 33 + (lane & 31)] = W[(size_t)(k0 + kk) * srcN + n0 + (lane & 31)]; }
    LDS_WAIT(); asm volatile("" ::: "memory");
    const int c = lane & 7;
#pragma unroll
    for (int j = 0; j < 4; ++j) { const int n = (lane >> 3) + 8 * j; const LAS float* s = scr + (8 * c) * 33 + n;
        u32x2 o; o.x = pk_fp8x4(s[0 * 33] * sc, s[1 * 33] * sc, s[2 * 33] * sc, s[3 * 33] * sc); o.y = pk_fp8x4(s[4 * 33] * sc, s[5 * 33] * sc, s[6 * 33] * sc, s[7 * 33] * sc);
        *(u32x2*)(dst + (size_t)n * dstride + 8 * c) = o; }
    LDS_WAIT(); asm volatile("" ::: "memory");
}
__device__ __forceinline__ void phase_prologue(Frame& F, const Args& a) {
    frame_refresh(F);
    LAS float* scr = (LAS float*)(F.lds + F.wave * 16384);
    const int gw = F.vcu * NWAVES + F.wave, NGW = F.G * NWAVES;
    bf16_t* WIN = (bf16_t*)(F.ws + WS_WIN); bf16_t* WOUT = (bf16_t*)(F.ws + WS_WOUT); unsigned char* WGU = F.ws + WS_WGU; unsigned char* WDT = F.ws + WS_WDT;
    constexpr int I_IN = 4 * 16 * 80, I_OUT = 4 * 16 * 32, I_G = 64 * 16 * 16, I_D = 64 * 8 * 32;
    constexpr int NITEMS = I_IN + I_OUT + 2 * I_G + I_D;
    for (int it = gw; it < NITEMS; it += NGW) {
        int r = it;
        if (r < I_IN) { const int l = r / 1280, q = r % 1280, kb = q / 80, nb = q % 80;
            const float* W = ((l & 1) ? a.in[13] : a.in[7]) + (size_t)(l >> 1) * 1024 * NPROJ;
            transpose_item(W, NPROJ, 64 * kb, 32 * nb, WIN + ((size_t)l * NPROJ + 32 * nb) * 1024 + 64 * kb, 1024, scr, F.lane); continue; }
        r -= I_IN;
        if (r < I_OUT) { const int l = r / 512, q = r % 512, kb = q / 32, nb = q % 32;
            const float* W = ((l & 1) ? a.in[14] : a.in[8]) + (size_t)(l >> 1) * 1024 * 1024;
            transpose_item(W, 1024, 64 * kb, 32 * nb, WOUT + ((size_t)l * 1024 + 32 * nb) * 1024 + 64 * kb, 1024, scr, F.lane); continue; }
        r -= I_OUT;
        if (r < 2 * I_G) { const int up = r / I_G, q0 = r % I_G, le = q0 / 256, q = q0 % 256, kb = q / 16, nb = q % 16;
            const float* W = (up ? a.in[24] : a.in[23]) + (size_t)le * 1024 * 512;
            const int n0 = 32 * nb, drow = 256 * (n0 >> 7) + 128 * up + (n0 & 127);
            transpose_item_f8(W, 512, 64 * kb, n0, WGU + ((size_t)le * 1024 + drow) * 1024 + 64 * kb, 1024, scr, F.lane, SC_WGU); continue; }
        r -= 2 * I_G;
        { const int le = r / 256, q = r % 256, kb = q / 32, nb = q % 32, l = le >> 4, e = le & 15;
            const float* W = a.in[25] + (size_t)le * 512 * 1024;
            transpose_item_f8(W, 1024, 64 * kb, 32 * nb, WDT + ((size_t)l * 1024 + 32 * nb) * 8192 + e * 512 + 64 * kb, 8192, scr, F.lane, SC_WD); }
    }
    { bf16_t* WS = (bf16_t*)(F.ws + WS_WS); const float* src = a.in[11];
      for (int i = (F.vcu * NTHREADS + F.tid); i < 2 * 4 * 128 * 128; i += F.G * NTHREADS) { const int t = (i >> 7) & 127, s = i & 127; const float v = (s <= t) ? src[i] : 0.f; WS[i] = (bf16_t)(pk2(v, 0.f) & 0xffffu); } }
    __syncthreads();
    { LAS float* sc = (LAS float*)F.lds;
      LAS float* red = (LAS float*)(F.lds + 65536);
      const float* c = a.in[1];
      for (int i = F.tid; i < 16 * 1024; i += NTHREADS) sc[i] = silu_f(c[i]);
      __syncthreads();
      float* MOD = (float*)(F.ws + WS_MOD);
      for (int grp = F.vcu; grp < 4 * 96; grp += F.G) {
          const int l = grp / 96, n = (grp % 96) * 64 + F.lane;
          const float* w = a.in[5] + ((size_t)l * 1024 + F.wave * 128) * 6144 + n;
          float acc[16];
#pragma unroll
          for (int b = 0; b < 16; ++b) acc[b] = 0.f;
#pragma unroll 4
          for (int k = 0; k < 128; ++k) { const float wv = w[(size_t)k * 6144];
#pragma unroll
              for (int b = 0; b < 16; ++b) acc[b] += sc[b * 1024 + F.wave * 128 + k] * wv; }
#pragma unroll
          for (int b = 0; b < 16; ++b) red[(F.wave * 16 + b) * 64 + F.lane] = acc[b];
          __syncthreads();
#pragma unroll
          for (int bb = 0; bb < 2; ++bb) { const int b = F.wave * 2 + bb; float s = a.in[6][(size_t)l * 6144 + n];
#pragma unroll
              for (int w8 = 0; w8 < 8; ++w8) s += red[(w8 * 16 + b) * 64 + F.lane];
              MOD[((size_t)l * 16 + b) * 6144 + n] = s; }
          __syncthreads();
      }
    }
}

__device__ __forceinline__ void load_row(const float* xrow, int lane, f32x4 (&v)[4]) {
    const f32x4* xr = (const f32x4*)xrow + lane;
#pragma unroll
    for (int j = 0; j < 4; ++j) v[j] = xr[64 * j];
}
__device__ __forceinline__ float row_rstd(const f32x4 (&v)[4]) {
    float ss = 0.f;
#pragma unroll
    for (int j = 0; j < 4; ++j) ss += (v[j].x * v[j].x + v[j].y * v[j].y) + (v[j].z * v[j].z + v[j].w * v[j].w);
    return rsqrtf(wave_sum(ss) * (1.f / D) + EPS);
}
__device__ __forceinline__ void load_mod(const float* gam, const float* sh, const float* sc, int lane, f32x4 (&gp)[4], f32x4 (&shv)[4]) {
#pragma unroll
    for (int j = 0; j < 4; ++j) { const f32x4 g = ((const f32x4*)gam)[lane + 64 * j], s1 = ((const f32x4*)sc)[lane + 64 * j]; gp[j] = g * (1.f + s1); shv[j] = ((const f32x4*)sh)[lane + 64 * j]; }
}
__device__ __forceinline__ void store_row_bf16(bf16_t* orow, int lane, const f32x4 (&h)[4]) {
    u32x2* o = (u32x2*)orow + lane;
#pragma unroll
    for (int j = 0; j < 4; ++j) { u32x2 w; w.x = pk2(h[j].x, h[j].y); w.y = pk2(h[j].z, h[j].w); o[64 * j] = w; }
}

__device__ __forceinline__ void load_y(const bf16_t* yrow, int lane, u32x2 (&y)[4]) {
    const u32x2* yr = (const u32x2*)yrow + lane;
#pragma unroll
    for (int j = 0; j < 4; ++j) y[j] = yr[64 * j];
}
__device__ __forceinline__ void add_y(f32x4 (&x)[4], const u32x2 (&y)[4], const f32x4 (&g)[4]) {
#pragma unroll
    for (int j = 0; j < 4; ++j) { x[j].x += g[j].x * bf_lo(y[j].x); x[j].y += g[j].y * bf_hi(y[j].x); x[j].z += g[j].z * bf_lo(y[j].y); x[j].w += g[j].w * bf_hi(y[j].y); }
}
__device__ __forceinline__ void store_row_fp8(unsigned char* orow, int lane, const f32x4 (&h)[4], float sc) {
    unsigned* o = (unsigned*)orow + lane;
#pragma unroll
    for (int j = 0; j < 4; ++j) o[64 * j] = pk_fp8x4(h[j].x * sc, h[j].y * sc, h[j].z * sc, h[j].w * sc);
}
__device__ __forceinline__ void load_row_bf(const bf16_t* xrow, int lane, f32x4 (&v)[4]) {
    const u32x2* xr = (const u32x2*)xrow + lane;
#pragma unroll
    for (int j = 0; j < 4; ++j) { const u32x2 w = xr[64 * j]; v[j] = (f32x4){bf_lo(w.x), bf_hi(w.x), bf_lo(w.y), bf_hi(w.y)}; }
}
__device__ __forceinline__ void store_row_f32(float* xrow, int lane, const f32x4 (&v)[4]) {
    f32x4* xr = (f32x4*)xrow + lane;
#pragma unroll
    for (int j = 0; j < 4; ++j) xr[64 * j] = v[j];
}
__device__ __forceinline__ void phase_norm1(Frame& F, const Args& a, int l) {
    frame_refresh(F);
    const int gw = F.vcu * NWAVES + F.wave, NGW = F.G * NWAVES, lane = F.lane;
    const float* MOD = (const float*)(F.ws + WS_MOD) + (size_t)l * 16 * 6144;
    bf16_t* HB = (bf16_t*)(F.ws + WS_HBUF);
    const float* gam = a.in[3] + (size_t)l * D;
    const bool addy = l > 0;
    const float* xin = a.in[0]; bf16_t* XB = (bf16_t*)(F.ws + WS_XB);
    const bf16_t* Y2 = (const bf16_t*)(F.ws + WS_HSORT); const int* SINFO = (const int*)(F.ws + WS_LIST);
    const LAS int* tbl = (const LAS int*)(F.lds + 131072);
    for (int blk = gw; blk < T / 32; blk += NGW) {
        const int row0 = blk * 32, b = row0 >> 12;
        f32x4 gp[4], shv[4], g2[4]; load_mod(gam, MOD + (size_t)b * 6144, MOD + (size_t)b * 6144 + 1024, lane, gp, shv);
        int slotv = 0;
        if (addy) { const int si = SINFO[row0 + (lane & 31)]; slotv = tbl[si >> 16] * 256 + (si & 0xffff);
#pragma unroll
            for (int j = 0; j < 4; ++j) g2[j] = ((const f32x4*)(MOD - 16 * 6144 + (size_t)b * 6144 + 5120))[lane + 64 * j]; }
        f32x4 xa[4], xb[4], na[4], nb[4]; u32x2 ya[4], yb[4], nya[4], nyb[4];
        if (addy) { load_row_bf(XB + (size_t)row0 * D, lane, xa); load_row_bf(XB + (size_t)(row0 + 1) * D, lane, xb); } else { load_row(xin + (size_t)row0 * D, lane, xa); load_row(xin + (size_t)(row0 + 1) * D, lane, xb); }
        if (addy) { load_y(Y2 + (size_t)__builtin_amdgcn_readlane(slotv, 0) * D, lane, ya); load_y(Y2 + (size_t)__builtin_amdgcn_readlane(slotv, 1) * D, lane, yb); }
#pragma unroll 1
        for (int r = 0; r < 32; r += 2) {
            if (r + 2 < 32) { if (addy) { load_row_bf(XB + (size_t)(row0 + r + 2) * D, lane, na); load_row_bf(XB + (size_t)(row0 + r + 3) * D, lane, nb); } else { load_row(xin + (size_t)(row0 + r + 2) * D, lane, na); load_row(xin + (size_t)(row0 + r + 3) * D, lane, nb); }
                if (addy) { load_y(Y2 + (size_t)__builtin_amdgcn_readlane(slotv, r + 2) * D, lane, nya); load_y(Y2 + (size_t)__builtin_amdgcn_readlane(slotv, r + 3) * D, lane, nyb); } }
            if (addy) { add_y(xa, ya, g2); add_y(xb, yb, g2); store_row_bf16(XB + (size_t)(row0 + r) * D, lane, xa); store_row_bf16(XB + (size_t)(row0 + r + 1) * D, lane, xb); }
            const float ra = row_rstd(xa), rb = row_rstd(xb);
#pragma unroll
            for (int j = 0; j < 4; ++j) { xa[j] = xa[j] * ra * gp[j] + shv[j]; xb[j] = xb[j] * rb * gp[j] + shv[j]; }
            store_row_bf16(HB + (size_t)(row0 + r) * D, lane, xa); store_row_bf16(HB + (size_t)(row0 + r + 1) * D, lane, xb);
#pragma unroll
            for (int j = 0; j < 4; ++j) { xa[j] = na[j]; xb[j] = nb[j]; ya[j] = nya[j]; yb[j] = nyb[j]; }
        }
    }
}

__device__ __forceinline__ float xor32(float v) {
    const unsigned u = __float_as_uint(v);
    auto rr = __builtin_amdgcn_permlane32_swap(u, u, false, false);
    return __uint_as_float((threadIdx.x & 32) ? rr[0] : rr[1]);
}
typedef short v4i16_t __attribute__((ext_vector_type(4)));
__device__ __forceinline__ v4i16_t tr_read8(const LAS char* p) { return __builtin_amdgcn_ds_read_tr16_b64_v4i16((LAS v4i16_t*)p); }
__device__ __forceinline__ void pv_mma(f32x16 (&O)[2], const bf16x8 (&pk)[2], const LAS char* vimg, int lane) {
    const int hh = lane >> 5;
    const LAS char* vb = vimg + (4 * hh + ((lane & 15) >> 2)) * 64 + ((lane >> 4) & 1) * 32 + (lane & 3) * 8;
#pragma unroll
    for (int dh = 0; dh < 2; ++dh)
#pragma unroll
        for (int s4 = 0; s4 < 2; ++s4) {
            const v4i16_t lo = tr_read8(vb + dh * 2048 + (16 * s4) * 64), hi = tr_read8(vb + dh * 2048 + (16 * s4 + 8) * 64);
            bf16x8 af; af[0] = lo[0]; af[1] = lo[1]; af[2] = lo[2]; af[3] = lo[3]; af[4] = hi[0]; af[5] = hi[1]; af[6] = hi[2]; af[7] = hi[3];
            O[dh] = __builtin_amdgcn_mfma_f32_32x32x16_bf16(af, pk[s4], O[dh], 0, 0, 0);
        }
}
__device__ __forceinline__ void pack_p(const float (&p)[16], bf16x8 (&pk)[2]) {
#pragma unroll
    for (int s4 = 0; s4 < 2; ++s4) { u32x4 w; w.x = pk2(p[8 * s4 + 0], p[8 * s4 + 1]); w.y = pk2(p[8 * s4 + 2], p[8 * s4 + 3]); w.z = pk2(p[8 * s4 + 4], p[8 * s4 + 5]); w.w = pk2(p[8 * s4 + 6], p[8 * s4 + 7]);
        pk[s4] = __builtin_bit_cast(bf16x8, w); }
}
__device__ __forceinline__ void store_ot(const f32x16 (&O)[2], float sc, bf16_t* orow, int lane) {
    const int hh = lane >> 5;
#pragma unroll
    for (int dh = 0; dh < 2; ++dh)
#pragma unroll
        for (int g = 0; g < 4; ++g) { u32x2 w; w.x = pk2(O[dh][4 * g] * sc, O[dh][4 * g + 1] * sc); w.y = pk2(O[dh][4 * g + 2] * sc, O[dh][4 * g + 3] * sc);
            *(u32x2*)(orow + 32 * dh + 8 * g + 4 * hh) = w; }
}

constexpr int DK_PITCH = 144, DL_K = 0, DL_V = 384 * DK_PITCH, DL_VH = 384 * 64, DL_BT = DL_V + 2 * DL_VH;
struct DilUnit { int b, hd, p, d, sh, res, S0; };
__device__ __forceinline__ void dil_decode(int u, DilUnit& U) {
    const int pair = u / 48, k = u % 48; U.p = k >> 4; const int idx = k & 15; U.hd = pair & 7; U.b = pair >> 3;
    U.sh = 2 * U.p; U.d = 1 << U.sh;
    const int lb = 4 - U.sh;
    U.res = idx >> lb; U.S0 = (idx & ((1 << lb) - 1)) * 256;
}
struct DilRegs { u32x4 k[6]; u32x4 v[6]; bf16x8 q[4]; };
__device__ __forceinline__ void dil_load(DilRegs& R, const bf16_t* QH, const DilUnit& U, int tid) {
    const bf16_t* Qb = QH + (size_t)(U.b * 8 + U.hd) * SEQ * 64;
#pragma unroll
    for (int i = 0; i < 6; ++i) { const int q = tid + 512 * i, key = q >> 3, c8 = q & 7; int sub = U.S0 - 128 + key; sub = sub < 0 ? 0 : sub;
        const bf16_t* rp = Qb + (size_t)(U.res + (sub << U.sh)) * 64 + 8 * c8;
        R.k[i] = *(const u32x4*)(rp + QKV_SEC); R.v[i] = *(const u32x4*)(rp + 2 * QKV_SEC); }
    const int lane = tid & 63, w = tid >> 6, qs = U.S0 + 32 * w + (lane & 31);
    const bf16_t* qp = Qb + (size_t)(U.res + (qs << U.sh)) * 64 + 8 * (lane >> 5);
#pragma unroll
    for (int s4 = 0; s4 < 4; ++s4) R.q[s4] = *(const bf16x8*)(qp + 16 * s4);
}
__device__ __forceinline__ void dil_stage(const DilRegs& R, LAS char* lds, int tid) {
#pragma unroll
    for (int i = 0; i < 6; ++i) { const int q = tid + 512 * i, key = q >> 3, c8 = q & 7;
        *(LAS u32x4*)(lds + DL_K + key * DK_PITCH + c8 * 16) = R.k[i];
        *(LAS u32x4*)(lds + DL_V + (c8 >> 2) * DL_VH + key * 64 + (c8 & 3) * 16) = R.v[i]; }
}
__device__ __forceinline__ void phase_dilated2(Frame& F, const Args& a) {
    frame_refresh(F);
    const int tid = F.tid, lane = F.lane, wave = F.wave, r32 = lane & 31, hh = lane >> 5;
    const bf16_t* P = (const bf16_t*)(F.ws + WS_QH);
    bf16_t* OP0 = (bf16_t*)(F.ws + WS_MIX); bf16_t* OP12 = (bf16_t*)(F.ws + WS_HBUF); float* LSE = (float*)(F.ws + WS_LIST);
    LAS char* lds = (LAS char*)F.lds;
    LAS float* btab = (LAS float*)(lds + DL_BT);
    for (int i = tid; i < 8 * 3 * 132; i += NTHREADS) { const int h = i / 396, rem = i % 396, br = rem / 132, sd = rem % 132; btab[i] = a.in[2][(int)BUCKET[br][sd] * 8 + h]; }
    DilRegs R; DilUnit U, NU;
    const bool xl = (F.G == 256); const int xq = F.vcu >> 5, xj = F.vcu & 31; const int nmine = xl ? 24 : (6144 - F.vcu + F.G - 1) / F.G;
#define DIL_UNIT(i) (xl ? ((xq * 16 + 2 * ((i) / 3)) * 48 + xj + 32 * ((i) % 3)) : (F.vcu + (i) * F.G))
    if (nmine > 0) { dil_decode(DIL_UNIT(0), U); dil_load(R, P, U, tid); }
    for (int it = 0; it < nmine; ++it) {
        __syncthreads();
        dil_stage(R, lds, tid);
        bf16x8 qf[4];
#pragma unroll
        for (int s4 = 0; s4 < 4; ++s4) qf[s4] = R.q[s4];
        __syncthreads();
        if (it + 1 < nmine) { dil_decode(DIL_UNIT(it + 1), NU); dil_load(R, P, NU, tid); }
        const int qs = U.S0 + 32 * wave + r32;
        const int lim = qs < 128 ? qs : 128;
        const LAS float* bt = btab + (U.hd * 3 + U.p) * 132;
        float m = -1e30f, l = 0.f; f32x16 O[2];
#pragma unroll
        for (int i = 0; i < 16; ++i) { O[0][i] = 0.f; O[1][i] = 0.f; }
#pragma unroll 1
        for (int j = 0; j < 5; ++j) {
            const int kb = 32 * (wave + j);
            if (U.S0 - 128 + kb + 31 < 0) continue;
            f32x16 S;
#pragma unroll
            for (int i = 0; i < 16; ++i) S[i] = 0.f;
            const LAS char* kp = lds + DL_K + (kb + r32) * DK_PITCH + 16 * hh;
#pragma unroll
            for (int s4 = 0; s4 < 4; ++s4) S = __builtin_amdgcn_mfma_f32_32x32x16_bf16(*(const LAS bf16x8*)(kp + 32 * s4), qf[s4], S, 0, 0, 0);
            const int dist0 = 128 + r32 - 32 * j - 4 * hh;
            float sv[16]; float smax = -1e30f;
            float bv[16];
#pragma unroll
            for (int i = 0; i < 16; ++i) { const unsigned ud = (unsigned)(dist0 - ((i & 3) + 8 * (i >> 2))); bv[i] = bt[ud < 132u ? ud : 131u]; }
#pragma unroll
            for (int i = 0; i < 16; ++i) { const int dist = dist0 - ((i & 3) + 8 * (i >> 2)); const bool valid = (unsigned)dist <= (unsigned)lim;
                sv[i] = valid ? (S[i] * 0.125f + bv[i]) : -1e30f; smax = fmaxf(smax, sv[i]); }
            smax = fmaxf(smax, xor32(smax));
            const float mn = fmaxf(m, smax);
            const float alpha = __expf(m - mn);
            float p[16]; float ps = 0.f;
#pragma unroll
            for (int i = 0; i < 16; ++i) { p[i] = (sv[i] > -1e29f) ? __expf(sv[i] - mn) : 0.f; ps += p[i]; }
            l = l * alpha + ps; m = mn;
#pragma unroll
            for (int dh = 0; dh < 2; ++dh)
#pragma unroll
                for (int i = 0; i < 16; ++i) O[dh][i] *= alpha;
            bf16x8 pk[2]; pack_p(p, pk);
            const LAS char* vb = lds + DL_V + (kb + 4 * hh + ((lane & 15) >> 2)) * 64 + ((lane >> 4) & 1) * 32 + (lane & 3) * 8;
#pragma unroll
            for (int dh = 0; dh < 2; ++dh)
#pragma unroll
                for (int s4 = 0; s4 < 2; ++s4) {
                    const v4i16_t lo = tr_read8(vb + dh * DL_VH + (16 * s4) * 64), hi = tr_read8(vb + dh * DL_VH + (16 * s4 + 8) * 64);
                    bf16x8 af; af[0] = lo[0]; af[1] = lo[1]; af[2] = lo[2]; af[3] = lo[3]; af[4] = hi[0]; af[5] = hi[1]; af[6] = hi[2]; af[7] = hi[3];
                    O[dh] = __builtin_amdgcn_mfma_f32_32x32x16_bf16(af, pk[s4], O[dh], 0, 0, 0);
                }
        }
        const float lt = l + xor32(l);
        const size_t row = (size_t)U.b * SEQ + U.res + ((size_t)qs << U.sh);
        bf16_t* orow = (U.p == 0) ? (OP0 + row * D + U.hd * 64) : (OP12 + ((size_t)(U.p - 1) * T + row) * 512 + U.hd * 64);
        store_ot(O, frcp(lt), orow, lane);
        if (hh == 0) LSE[((size_t)U.p * T + row) * 8 + U.hd] = m + __logf(lt);
        U = NU;
    }
}
__device__ __forceinline__ void phase_dil_combine(Frame& F) {
    frame_refresh(F);
    const int gw = F.vcu * NWAVES + F.wave, NGW = F.G * NWAVES, lane = F.lane;
    bf16_t* OP0 = (bf16_t*)(F.ws + WS_MIX); const bf16_t* OP12 = (const bf16_t*)(F.ws + WS_HBUF); const float* LSE = (const float*)(F.ws + WS_LIST);
    for (int blk = gw; blk < T / 32; blk += NGW) {
#pragma unroll 1
        for (int r = 0; r < 32; r += 2) {
            u32x4 o[2][3]; float ls[2][3];
#pragma unroll
            for (int q = 0; q < 2; ++q) { const size_t row = (size_t)blk * 32 + r + q;
                o[q][0] = *(const u32x4*)(OP0 + row * D + 8 * lane); o[q][1] = *(const u32x4*)(OP12 + row * 512 + 8 * lane); o[q][2] = *(const u32x4*)(OP12 + ((size_t)T + row) * 512 + 8 * lane);
#pragma unroll
                for (int p = 0; p < 3; ++p) ls[q][p] = LSE[((size_t)p * T + row) * 8 + (lane >> 3)]; }
#pragma unroll
            for (int q = 0; q < 2; ++q) { const size_t row = (size_t)blk * 32 + r + q;
                const float M = fmaxf(ls[q][0], fmaxf(ls[q][1], ls[q][2]));
                float w0 = __expf(ls[q][0] - M), w1 = __expf(ls[q][1] - M), w2 = __expf(ls[q][2] - M); const float inv = frcp(w0 + w1 + w2); w0 *= inv; w1 *= inv; w2 *= inv;
                u32x4 res;
#pragma unroll
                for (int e = 0; e < 4; ++e) { const unsigned a0 = o[q][0][e], a1 = o[q][1][e], a2 = o[q][2][e];
                    res[e] = pk2(bf_lo(a0) * w0 + bf_lo(a1) * w1 + bf_lo(a2) * w2, bf_hi(a0) * w0 + bf_hi(a1) * w1 + bf_hi(a2) * w2); }
                *(u32x4*)(OP0 + row * D + 8 * lane) = res; }
        }
    }
}

struct KRegs { u32x4 k[4]; };
__device__ __forceinline__ void stick_req_k(KRegs& R, const bf16_t* Pb, int ko, int tb, int lane) {
    const int r32 = lane & 31, hh = lane >> 5;
    int kt = tb + r32; kt = kt < 0 ? 0 : kt;
    const bf16_t* kp = Pb + (size_t)kt * 64 + ko + 8 * hh;
#pragma unroll
    for (int s4 = 0; s4 < 4; ++s4) R.k[s4] = *(const u32x4*)(kp + 16 * s4);
}
__device__ __forceinline__ void stick_req_v(const __amdgpu_buffer_rsrc_t rs, int vo, int tb, LAS char* slot, int lane) {
#pragma unroll
    for (int dh = 0; dh < 2; ++dh)
#pragma unroll
        for (int kh = 0; kh < 2; ++kh) { int vt = tb + 16 * kh + (lane >> 2); vt = vt < 0 ? 0 : vt;
            __builtin_amdgcn_raw_ptr_buffer_load_lds(rs, (LAS void*)(slot + dh * 2048 + kh * 1024), 16, (vt * 64 + vo + dh * 32 + 8 * (lane & 3)) * 2, 0, 0, 0); }
}
__device__ __forceinline__ void stick_req(KRegs& R, const bf16_t* Pb, const __amdgpu_buffer_rsrc_t rs, int ko, int vo, int tb, LAS char* slot, int lane) {
    stick_req_k(R, Pb, ko, tb, lane); stick_req_v(rs, vo, tb, slot, lane);
}
__device__ __forceinline__ bool stick_tile(const KRegs& C, int tb, int tq, int lane, const bf16x8 (&qf)[4], float& carry, f32x16 (&O)[2], const LAS char* vimg, int nwait) {
    const int hh = lane >> 5;
    f32x16 S;
#pragma unroll
    for (int i = 0; i < 16; ++i) S[i] = 0.f;
#pragma unroll
    for (int s4 = 0; s4 < 4; ++s4) S = __builtin_amdgcn_mfma_f32_32x32x16_bf16(__builtin_bit_cast(bf16x8, C.k[s4]), qf[s4], S, 0, 0, 0);
    const int dist0 = tq - tb - 4 * hh;
    float lk[16];
#pragma unroll
    for (int i = 0; i < 16; ++i) { const int dist = dist0 - ((i & 3) + 8 * (i >> 2)); const bool valid = dist > 0;
        const float z = S[i] * 0.125f;
        const float sp = fmaxf(z, 0.f) + __logf(1.f + __expf(-fabsf(z)));
        lk[i] = valid ? -sp : 0.f; S[i] = valid ? (z - sp) : -1e30f; }
    float G[4], PG[4];
#pragma unroll
    for (int g = 0; g < 4; ++g) { G[g] = (lk[4 * g] + lk[4 * g + 1]) + (lk[4 * g + 2] + lk[4 * g + 3]); PG[g] = xor32(G[g]); }
    float after[4]; float run = 0.f;
#pragma unroll
    for (int g = 3; g >= 0; --g) { after[g] = run + (hh == 0 ? PG[g] : 0.f); run += G[g] + PG[g]; }
    float p[16];
#pragma unroll
    for (int g = 0; g < 4; ++g) { const float b3 = carry + after[g], b2 = b3 + lk[4 * g + 3], b1 = b2 + lk[4 * g + 2], b0 = b1 + lk[4 * g + 1];
        p[4 * g + 3] = __expf(S[4 * g + 3] + b3); p[4 * g + 2] = __expf(S[4 * g + 2] + b2); p[4 * g + 1] = __expf(S[4 * g + 1] + b1); p[4 * g] = __expf(S[4 * g] + b0); }
    carry += run;
    bf16x8 pk[2]; pack_p(p, pk);
    if (nwait >= 16) asm volatile("s_waitcnt vmcnt(16)" ::: "memory"); else if (nwait >= 8) asm volatile("s_waitcnt vmcnt(8)" ::: "memory"); else asm volatile("s_waitcnt vmcnt(0)" ::: "memory");
    pv_mma(O, pk, vimg, lane);
    return __all(carry < -110.f) != 0;
}
__device__ __forceinline__ void phase_stick(Frame& F) {
    frame_refresh(F);
    const int gw = F.vcu * NWAVES + F.wave, NGW = F.G * NWAVES, lane = F.lane, hh = lane >> 5;
    const bf16_t* P = (const bf16_t*)(F.ws + WS_QH); bf16_t* MIX = (bf16_t*)(F.ws + WS_MIX);
    LAS char* ring = (LAS char*)F.lds + F.wave * 12288;
    int wt = gw;
    bf16x8 qf[4]; KRegs R0, R1, R2;
    if (wt < 16384) { const int qt = wt & 127, hd = (wt >> 7) & 7, b = wt >> 10; const bf16_t* Pb = P + (size_t)(b * 8 + hd) * SEQ * 64;
#pragma unroll
        for (int s4 = 0; s4 < 4; ++s4) qf[s4] = *(const bf16x8*)(Pb + (size_t)(qt * 32 + (lane & 31)) * 64 + 16 * s4 + 8 * hh);
        stick_req_k(R0, Pb, (int)QKV_SEC, qt * 32, lane); stick_req_k(R1, Pb, (int)QKV_SEC, qt * 32 - 32, lane); }
    asm volatile("s_waitcnt lgkmcnt(0)" ::: "memory");
    for (; wt < 16384; wt += NGW) {
        const int qt = wt & 127, hd = (wt >> 7) & 7, b = wt >> 10;
        const int tq = qt * 32 + (lane & 31);
        const bf16_t* Pb = P + (size_t)(b * 8 + hd) * SEQ * 64;
        const __amdgpu_buffer_rsrc_t rs = __builtin_amdgcn_make_buffer_rsrc((void*)(Pb + 2 * QKV_SEC), 0, 0x7fffffff, 0x00020000);
        const int ko = (int)QKV_SEC, vo = 0;
        float carry = 0.f; f32x16 O[2];
#pragma unroll
        for (int i = 0; i < 16; ++i) { O[0][i] = 0.f; O[1][i] = 0.f; }
        stick_req_v(rs, vo, qt * 32, ring, lane);
        if (qt >= 1) stick_req_v(rs, vo, qt * 32 - 32, ring + 4096, lane);
#pragma unroll 1
        for (int kt = qt; kt >= 0; kt -= 3) {
            if (kt >= 2) stick_req(R2, Pb, rs, ko, vo, (kt - 2) * 32, ring + 8192, lane);
            if (stick_tile(R0, kt * 32, tq, lane, qf, carry, O, ring, kt == qt ? (kt >= 2 ? 12 : (kt >= 1 ? 4 : 0)) : (kt >= 2 ? 16 : (kt >= 1 ? 8 : 0)))) break;
            if (kt < 1) break;
            if (kt >= 3) stick_req(R0, Pb, rs, ko, vo, (kt - 3) * 32, ring, lane);
            if (stick_tile(R1, (kt - 1) * 32, tq, lane, qf, carry, O, ring + 4096, kt >= 3 ? 16 : (kt >= 2 ? 8 : 0))) break;
            if (kt < 2) break;
            if (kt >= 4) stick_req(R1, Pb, rs, ko, vo, (kt - 4) * 32, ring + 4096, lane);
            if (stick_tile(R2, (kt - 2) * 32, tq, lane, qf, carry, O, ring + 8192, kt >= 4 ? 16 : (kt >= 3 ? 8 : 0))) break;
        }
        const int wn = wt + NGW;
        asm volatile("" ::: "memory");
        if (wn < 16384) { const int qn = wn & 127, hn = (wn >> 7) & 7, bn = wn >> 10; const bf16_t* Pn = P + (size_t)(bn * 8 + hn) * SEQ * 64;
#pragma unroll
            for (int s4 = 0; s4 < 4; ++s4) qf[s4] = *(const bf16x8*)(Pn + (size_t)(qn * 32 + (lane & 31)) * 64 + 16 * s4 + 8 * hh);
            stick_req_k(R0, Pn, (int)QKV_SEC, qn * 32, lane); stick_req_k(R1, Pn, (int)QKV_SEC, qn * 32 - 32, lane); }
        asm volatile("" ::: "memory");
        store_ot(O, 1.f, MIX + ((size_t)b * SEQ + tq) * D + 512 + hd * 64, lane);
        asm volatile("s_waitcnt vmcnt(20) lgkmcnt(0)" ::: "memory");
    }
}

__device__ __forceinline__ void phase_gmlp(Frame& F, const Args& a, int j2) {
    frame_refresh(F);
    const bf16_t* P = (const bf16_t*)(F.ws + WS_PROJ); bf16_t* MIX = (bf16_t*)(F.ws + WS_MIX);
    const bf16_t* WSM = (const bf16_t*)(F.ws + WS_WS) + (size_t)j2 * 4 * 128 * 128;
    const float* lng = a.in[9] + (size_t)j2 * 512; const float* lnb = a.in[10] + (size_t)j2 * 512; const float* bs = a.in[12] + (size_t)j2 * 4 * 128;
    constexpr int VP = 136;
    LAS bf16_t* vT = (LAS bf16_t*)F.lds;
    const int lane = F.lane, wave = F.wave;
    for (int ch = F.vcu; ch < T / 128; ch += F.G) {
        const int row0 = ch * 128;
        float lg[8], lb[8];
#pragma unroll
        for (int i = 0; i < 8; ++i) { lg[i] = lng[8 * lane + i]; lb[i] = lnb[8 * lane + i]; }
        u32x4 wv[16];
#pragma unroll
        for (int tt = 0; tt < 16; ++tt) wv[tt] = *(const u32x4*)(P + (size_t)(row0 + wave * 16 + tt) * 1024 + 512 + 8 * lane);
#pragma unroll
        for (int tt = 0; tt < 16; ++tt) asm volatile("" : "+v"(wv[tt]));
#pragma unroll
        for (int tt = 0; tt < 16; ++tt) { const int tl = wave * 16 + tt;
            const u32x4 w = wv[tt];
            float g[8]; g[0] = gelu_tanh(bf_lo(w.x)); g[1] = gelu_tanh(bf_hi(w.x)); g[2] = gelu_tanh(bf_lo(w.y)); g[3] = gelu_tanh(bf_hi(w.y));
            g[4] = gelu_tanh(bf_lo(w.z)); g[5] = gelu_tanh(bf_hi(w.z)); g[6] = gelu_tanh(bf_lo(w.w)); g[7] = gelu_tanh(bf_hi(w.w));
            float s = 0.f;
#pragma unroll
            for (int i = 0; i < 8; ++i) s += g[i];
            const float mu = wave_sum(s) * (1.f / 512.f); float s2 = 0.f;
#pragma unroll
            for (int i = 0; i < 8; ++i) { g[i] -= mu; s2 += g[i] * g[i]; }
            const float rstd = rsqrtf(wave_sum(s2) * (1.f / 512.f) + EPS);
#pragma unroll
            for (int i = 0; i < 8; ++i) { const float v = g[i] * rstd * lg[i] + lb[i]; vT[(8 * lane + i) * VP + tl] = (bf16_t)(pk2(v, 0.f) & 0xffffu); }
        }
        __syncthreads();
        const int g = wave >> 1, r32 = lane & 31, hh = lane >> 5;
        f32x16 accv[2][4];
#pragma unroll
        for (int ti = 0; ti < 2; ++ti) { const int tm = (wave & 1) + 2 * ti;
#pragma unroll
            for (int c4 = 0; c4 < 4; ++c4)
#pragma unroll
                for (int i = 0; i < 16; ++i) accv[ti][c4][i] = 0.f;
            const int nks = 2 * (tm + 1);
            bf16x8 afr[8];
#pragma unroll
            for (int ks = 0; ks < 8; ++ks) { const int kc = ks < nks ? ks : 0; afr[ks] = *(const bf16x8*)(WSM + ((size_t)g * 128 + tm * 32 + r32) * 128 + kc * 16 + 8 * hh); }
#pragma unroll
            for (int ks = 0; ks < 8; ++ks) asm volatile("" : "+v"(afr[ks]));
#pragma unroll
            for (int ks = 0; ks < 8; ++ks) { if (ks < nks) {
#pragma unroll
                for (int c4 = 0; c4 < 4; ++c4) { const bf16x8 bfv = *(const LAS bf16x8*)(vT + (g * 128 + c4 * 32 + r32) * VP + ks * 16 + 8 * hh);
                    accv[ti][c4] = __builtin_amdgcn_mfma_f32_32x32x16_bf16(afr[ks], bfv, accv[ti][c4], 0, 0, 0); } } }
        }
        __syncthreads();
        constexpr int OP = 520;
        LAS bf16_t* outL = (LAS bf16_t*)F.lds;
#pragma unroll
        for (int ti = 0; ti < 2; ++ti) { const int tm = (wave & 1) + 2 * ti;
#pragma unroll
            for (int i = 0; i < 16; ++i) { const int tl = tm * 32 + (i & 3) + 8 * (i >> 2) + 4 * hh; const float bsv = bs[g * 128 + tl];
#pragma unroll
                for (int c4 = 0; c4 < 4; ++c4) outL[tl * OP + g * 128 + c4 * 32 + r32] = (bf16_t)(pk2(accv[ti][c4][i] + bsv, 0.f) & 0xffffu); } }
        __syncthreads();
        { u32x4 uv[16];
#pragma unroll
          for (int tt = 0; tt < 16; ++tt) uv[tt] = *(const u32x4*)(P + (size_t)(row0 + wave * 16 + tt) * 1024 + 8 * lane);
#pragma unroll
          for (int tt = 0; tt < 16; ++tt) asm volatile("" : "+v"(uv[tt]));
#pragma unroll
          for (int tt = 0; tt < 16; ++tt) { const int tl = wave * 16 + tt; const u32x4 m = *(const LAS u32x4*)(outL + tl * OP + 8 * lane); const u32x4 u = uv[tt];
              u32x4 o;
#pragma unroll
              for (int e = 0; e < 4; ++e) o[e] = pk2(gelu_tanh(bf_lo(u[e])) * bf_lo(m[e]), gelu_tanh(bf_hi(u[e])) * bf_hi(m[e]));
              *(u32x4*)(MIX + (size_t)(row0 + tl) * D + 512 + 8 * lane) = o; } }
        __syncthreads();
    }
}

template <bool OUT>
__device__ __forceinline__ void conv_chunk(const bf16_t* P, int row0, int tseq0, int tl0, int c0, float (&x0)[32], float (&x1)[32], const float (&w0)[31], const float (&w1)[31], float bd0, float bd1, LAS float* tile) {
    unsigned av[32], gv[32];
#pragma unroll
    for (int i = 0; i < 32; ++i) { int tl = tl0 + i; tl = (tseq0 + tl < 0) ? -tseq0 : tl;
        const bf16_t* pr = P + (size_t)(row0 + tl) * 1024; av[i] = *(const unsigned*)(pr + c0); gv[i] = *(const unsigned*)(pr + 512 + c0); }
#pragma unroll
    for (int i = 0; i < 32; ++i) asm volatile("" : "+v"(av[i]), "+v"(gv[i]));
#pragma unroll
    for (int i = 0; i < 32; ++i) { const int tl = tl0 + i; const bool ok = (tseq0 + tl >= 0);
        const float h0 = ok ? bf_lo(av[i]) * sigmoid_f(bf_lo(gv[i])) : 0.f, h1 = ok ? bf_hi(av[i]) * sigmoid_f(bf_hi(gv[i])) : 0.f;
        x0[i] = h0; x1[i] = h1;
        if (OUT) { float o0 = bd0, o1 = bd1;
#pragma unroll
            for (int j = 0; j < 31; ++j) { o0 += w0[j] * x0[(i + 2 + j) & 31]; o1 += w1[j] * x1[(i + 2 + j) & 31]; }
            *(LAS f32x2*)(tile + i * 512 + c0) = (f32x2){o0, o1}; }
    }
}
__device__ __forceinline__ void phase_conv(Frame& F, const Args& a, int j2) {
    frame_refresh(F);
    const bf16_t* P = (const bf16_t*)(F.ws + WS_PROJ); bf16_t* MIX = (bf16_t*)(F.ws + WS_MIX);
    const float* wdw = a.in[15] + (size_t)j2 * 31 * 512; const float* bdw = a.in[16] + (size_t)j2 * 512;
    const float* lng = a.in[17] + (size_t)j2 * 512; const float* lnb = a.in[18] + (size_t)j2 * 512;
    const int half = F.tid >> 8, ht = F.tid & 255, c0 = 2 * ht;
    LAS float* tile = (LAS float*)F.lds + half * (32 * 512);
    float w0[31], w1[31];
#pragma unroll
    for (int j = 0; j < 31; ++j) { w0[j] = wdw[j * 512 + c0]; w1[j] = wdw[j * 512 + c0 + 1]; }
    const float bd0 = bdw[c0], bd1 = bdw[c0 + 1];
    const int wih = F.wave & 3;
    for (int s0 = F.vcu * 2; s0 < T / 128; s0 += F.G * 2) {
        const int seg = s0 + half;
        const int row0 = seg * 128, tseq0 = row0 & (SEQ - 1);
        float x0[32], x1[32];
        conv_chunk<false>(P, row0, tseq0, -32, c0, x0, x1, w0, w1, bd0, bd1, tile);
#pragma unroll 1
        for (int cb = 0; cb < 4; ++cb) {
            conv_chunk<true>(P, row0, tseq0, cb * 32, c0, x0, x1, w0, w1, bd0, bd1, tile);
            __syncthreads();
            for (int rr = wih; rr < 32; rr += 4) { const LAS float* tr = tile + rr * 512 + 8 * F.lane; float v[8]; float s = 0.f;
#pragma unroll
                for (int e = 0; e < 8; ++e) { v[e] = tr[e]; s += v[e]; }
                const float mu = wave_sum(s) * (1.f / 512.f); float s2 = 0.f;
#pragma unroll
                for (int e = 0; e < 8; ++e) { v[e] -= mu; s2 += v[e] * v[e]; }
                const float rstd = rsqrtf(wave_sum(s2) * (1.f / 512.f) + EPS);
                float o[8];
#pragma unroll
                for (int e = 0; e < 8; ++e) o[e] = silu_f(v[e] * rstd * lng[8 * F.lane + e] + lnb[8 * F.lane + e]);
                u32x4 ow; ow.x = pk2(o[0], o[1]); ow.y = pk2(o[2], o[3]); ow.z = pk2(o[4], o[5]); ow.w = pk2(o[6], o[7]);
                *(u32x4*)(MIX + (size_t)(row0 + cb * 32 + rr) * D + 8 * F.lane) = ow; }
            __syncthreads();
        }
    }
}

__device__ __forceinline__ void phase_router(Frame& F, const Args& a, int l, const float* xin) {
    frame_refresh(F);
    LAS float* wl = (LAS float*)F.lds;
    LAS int* cls_s = (LAS int*)(F.lds + 81920);
    LAS int* pos_s = cls_s + 256;
    LAS int* lcnt = pos_s + 256;
    LAS int* lbase = lcnt + 32;
    const float* wg = a.in[19] + (size_t)l * 1024 * 4; const float* wrt = a.in[21] + (size_t)l * 4 * 1024 * 4;
    { f32x4 wv[10];
#pragma unroll
      for (int p = 0; p < 10; ++p) { const int q = F.tid + NTHREADS * p; wv[p] = (q < 1024) ? ((const f32x4*)wg)[q] : ((const f32x4*)wrt)[q - 1024]; }
#pragma unroll
      for (int p = 0; p < 10; ++p) { const int q = F.tid + NTHREADS * p, g5 = q >> 10, k = q & 1023;
          wl[(4 * g5 + 0) * 1024 + k] = wv[p].x; wl[(4 * g5 + 1) * 1024 + k] = wv[p].y; wl[(4 * g5 + 2) * 1024 + k] = wv[p].z; wl[(4 * g5 + 3) * 1024 + k] = wv[p].w; } }
    __syncthreads();
    const float* MOD = (const float*)(F.ws + WS_MOD) + (size_t)l * 16 * 6144;
    const float* gam = a.in[4] + (size_t)l * D; const float* bg = a.in[20] + l * 4; const float* br = a.in[22] + l * 16;
    bf16_t* HB = (bf16_t*)(F.ws + WS_HBUF); float* RW = (float*)(F.ws + WS_RW); int* SINFO = (int*)(F.ws + WS_LIST);
    unsigned char* H8 = F.ws + WS_H8; int* TLIST = (int*)(F.ws + WS_TLIST);
    unsigned* cnt = (unsigned*)(F.ws + WS_CTL) + CW_CNT + l * NCLS * 64;
    const float* x = a.in[0]; bf16_t* XB = (bf16_t*)(F.ws + WS_XB); const bool first = (l == 0);
    const f32x4 one4[4] = {{1.f, 1.f, 1.f, 1.f}, {1.f, 1.f, 1.f, 1.f}, {1.f, 1.f, 1.f, 1.f}, {1.f, 1.f, 1.f, 1.f}};
    const int lane = F.lane;
    for (int rb = F.vcu; rb < T / 256; rb += F.G) {
        if (F.tid < 32) lcnt[F.tid] = 0;
        __syncthreads();
        const int rowb = rb * 256 + F.wave * 32, b = rowb >> 12;
        f32x4 gp[4], shv[4]; load_mod(gam, MOD + (size_t)b * 6144 + 3072, MOD + (size_t)b * 6144 + 4096, lane, gp, shv);
        f32x4 h0[4], h1[4], n0[4], n1[4]; u32x2 d0[4], d1[4], nd0[4], nd1[4];
        float lgv[20];
#pragma unroll
        for (int c = 0; c < 20; ++c) lgv[c] = 0.f;
        if (first) { load_row(x + (size_t)rowb * D, lane, h0); load_row(x + (size_t)(rowb + 1) * D, lane, h1); } else { load_row_bf(XB + (size_t)rowb * D, lane, h0); load_row_bf(XB + (size_t)(rowb + 1) * D, lane, h1); }
        load_y(HB + (size_t)rowb * D, lane, d0); load_y(HB + (size_t)(rowb + 1) * D, lane, d1);
#pragma unroll 1
        for (int it = 0; it < 16; ++it) {
            const int rl0 = F.wave * 32 + it * 2, row0 = rb * 256 + rl0;
            if (it + 1 < 16) { if (first) { load_row(x + (size_t)(row0 + 2) * D, lane, n0); load_row(x + (size_t)(row0 + 3) * D, lane, n1); } else { load_row_bf(XB + (size_t)(row0 + 2) * D, lane, n0); load_row_bf(XB + (size_t)(row0 + 3) * D, lane, n1); }
                load_y(HB + (size_t)(row0 + 2) * D, lane, nd0); load_y(HB + (size_t)(row0 + 3) * D, lane, nd1); }
            add_y(h0, d0, one4); add_y(h1, d1, one4);
            store_row_bf16(XB + (size_t)row0 * D, lane, h0); store_row_bf16(XB + (size_t)(row0 + 1) * D, lane, h1);
            const float r0 = row_rstd(h0), r1 = row_rstd(h1);
#pragma unroll
            for (int j = 0; j < 4; ++j) { h0[j] = h0[j] * r0 * gp[j] + shv[j]; h1[j] = h1[j] * r1 * gp[j] + shv[j]; }
            store_row_fp8(H8 + (size_t)row0 * D, lane, h0, SC_H2); store_row_fp8(H8 + (size_t)(row0 + 1) * D, lane, h1, SC_H2);
#pragma unroll
            for (int c = 0; c < 20; c += 2) {
                f32x4 w[2][4];
#pragma unroll
                for (int cc = 0; cc < 2; ++cc)
#pragma unroll
                    for (int j = 0; j < 4; ++j) w[cc][j] = *(const LAS f32x4*)(wl + (c + cc) * 1024 + 4 * lane + 256 * j);
#pragma unroll
                for (int cc = 0; cc < 2; ++cc)
#pragma unroll
                    for (int j = 0; j < 4; ++j) asm volatile("" : "+v"(w[cc][j]));
#pragma unroll
                for (int cc = 0; cc < 2; ++cc) { f32x2 a0 = {0.f, 0.f}, a1 = {0.f, 0.f};
#pragma unroll
                    for (int j = 0; j < 4; ++j) { const f32x4 wv = w[cc][j]; const f32x2 wlo = {wv.x, wv.y}, whi = {wv.z, wv.w};
                        a0 += (f32x2){h0[j].x, h0[j].y} * wlo; a0 += (f32x2){h0[j].z, h0[j].w} * whi;
                        a1 += (f32x2){h1[j].x, h1[j].y} * wlo; a1 += (f32x2){h1[j].z, h1[j].w} * whi; }
                    const float t0 = wave_sum(a0.x + a0.y), t1 = wave_sum(a1.x + a1.y);
                    lgv[c + cc] = (lane == it * 2) ? t0 : ((lane == it * 2 + 1) ? t1 : lgv[c + cc]); } }
#pragma unroll
            for (int j = 0; j < 4; ++j) { h0[j] = n0[j]; h1[j] = n1[j]; d0[j] = nd0[j]; d1[j] = nd1[j]; }
        }
        {
            float gl[4];
#pragma unroll
            for (int i = 0; i < 4; ++i) gl[i] = lgv[i] + bg[i];
            int gi = 0; float gm = gl[0];
#pragma unroll
            for (int i = 1; i < 4; ++i) if (gl[i] > gm) { gm = gl[i]; gi = i; }
            float gs = 0.f;
#pragma unroll
            for (int i = 0; i < 4; ++i) gs += __expf(gl[i] - gm);
            const float gwt = 1.f / gs;
            float el[4];
#pragma unroll
            for (int e = 0; e < 4; ++e) { const float v = (gi == 0) ? lgv[4 + e] : (gi == 1) ? lgv[8 + e] : (gi == 2) ? lgv[12 + e] : lgv[16 + e]; el[e] = v + br[gi * 4 + e]; }
            int ea = 0; float va = el[0];
#pragma unroll
            for (int e = 1; e < 4; ++e) if (el[e] > va) { va = el[e]; ea = e; }
            int eb = -1; float vb = -3.0e38f;
#pragma unroll
            for (int e = 0; e < 4; ++e) if (e != ea && el[e] > vb) { vb = el[e]; eb = e; }
            const float wa = 1.f / (1.f + __expf(vb - va)), wb = 1.f - wa;
            const int lo = ea < eb ? ea : eb, hi = ea < eb ? eb : ea;
            const int pidx = (lo == 0) ? hi - 1 : (lo == 1 ? hi + 1 : 5);
            const int cls = gi * 6 + pidx;
            const float wlo = gwt * (ea == lo ? wa : wb), whi = gwt * (ea == lo ? wb : wa);
            if (lane < 32) { cls_s[F.wave * 32 + lane] = cls; *(f32x2*)(RW + (size_t)(rowb + lane) * 2) = (f32x2){wlo, whi}; }
        }
        __syncthreads();
        if (F.tid < 256) pos_s[F.tid] = atomicAdd((int*)&lcnt[cls_s[F.tid]], 1);
        __syncthreads();
        if (F.tid < NCLS) lbase[F.tid] = (int)__hip_atomic_fetch_add(cnt + F.tid * 64, (unsigned)lcnt[F.tid], __ATOMIC_RELAXED, __HIP_MEMORY_SCOPE_AGENT);
        __syncthreads();
        if (F.tid < 256) { const int c = cls_s[F.tid], pos = lbase[c] + pos_s[F.tid]; SINFO[rb * 256 + F.tid] = (c << 16) | pos;
            __hip_atomic_store(TLIST + (size_t)c * T + pos, rb * 256 + F.tid, __ATOMIC_RELAXED, __HIP_MEMORY_SCOPE_AGENT); }
        __syncthreads();
    }
}

__device__ __forceinline__ void build_moe_table(Frame& F, int l) {
    frame_refresh(F);
    LAS int* tbl = (LAS int*)(F.lds + 131072);
    unsigned* cnt = (unsigned*)(F.ws + WS_CTL) + CW_CNT + l * NCLS * 64;
    if (F.tid == 0) { int acc = 0;
        for (int c = 0; c < NCLS; ++c) { const int n = (int)__hip_atomic_load(cnt + c * 64, __ATOMIC_RELAXED, __HIP_MEMORY_SCOPE_AGENT); tbl[c] = acc; tbl[32 + c] = n; acc += (n + 255) >> 8; }
        tbl[24] = acc; }
    __syncthreads();
    if (F.tid < 320) { const int mt = F.tid; int cls = 0;
        for (int k = 1; k < NCLS; ++k) if (tbl[k] <= mt) cls = k;
        tbl[64 + mt] = cls; }
    __syncthreads();
}

__device__ __forceinline__ void phase_final(Frame& F, const Args& a) {
    frame_refresh(F);
    const int gw = F.vcu * NWAVES + F.wave, NGW = F.G * NWAVES, lane = F.lane;
    const float* MOD = (const float*)(F.ws + WS_MOD) + (size_t)3 * 16 * 6144;
    const bf16_t* Y2 = (const bf16_t*)(F.ws + WS_HSORT); const int* SINFO = (const int*)(F.ws + WS_LIST);
    const LAS int* tbl = (const LAS int*)(F.lds + 131072);
    f32x4 g4[4];
#pragma unroll
    for (int j = 0; j < 4; ++j) g4[j] = ((const f32x4*)a.in[26])[lane + 64 * j];
    for (int blk = gw; blk < T / 32; blk += NGW) {
        const int row0 = blk * 32, b = row0 >> 12;
        f32x4 g2[4];
#pragma unroll
        for (int j = 0; j < 4; ++j) g2[j] = ((const f32x4*)(MOD + (size_t)b * 6144 + 5120))[lane + 64 * j];
        const int si = SINFO[row0 + (lane & 31)]; const int slotv = tbl[si >> 16] * 256 + (si & 0xffff);
        f32x4 xa[4], xb[4], na[4], nb[4]; u32x2 ya[4], yb[4], nya[4], nyb[4];
        const bf16_t* XB = (const bf16_t*)(F.ws + WS_XB); load_row_bf(XB + (size_t)row0 * D, lane, xa); load_row_bf(XB + (size_t)(row0 + 1) * D, lane, xb);
        load_y(Y2 + (size_t)__builtin_amdgcn_readlane(slotv, 0) * D, lane, ya); load_y(Y2 + (size_t)__builtin_amdgcn_readlane(slotv, 1) * D, lane, yb);
#pragma unroll 1
        for (int r = 0; r < 32; r += 2) {
            if (r + 2 < 32) { load_row_bf(XB + (size_t)(row0 + r + 2) * D, lane, na); load_row_bf(XB + (size_t)(row0 + r + 3) * D, lane, nb);
                load_y(Y2 + (size_t)__builtin_amdgcn_readlane(slotv, r + 2) * D, lane, nya); load_y(Y2 + (size_t)__builtin_amdgcn_readlane(slotv, r + 3) * D, lane, nyb); }
            add_y(xa, ya, g2); add_y(xb, yb, g2);
            const float ra = row_rstd(xa), rb = row_rstd(xb);
            f32x4* oa = (f32x4*)(a.out + (size_t)(row0 + r) * D) + lane; f32x4* ob = (f32x4*)(a.out + (size_t)(row0 + r + 1) * D) + lane;
#pragma unroll
            for (int j = 0; j < 4; ++j) { oa[64 * j] = xa[j] * ra * g4[j]; ob[64 * j] = xb[j] * rb * g4[j]; }
#pragma unroll
            for (int j = 0; j < 4; ++j) { xa[j] = na[j]; xb[j] = nb[j]; ya[j] = nya[j]; yb[j] = nyb[j]; }
        }
    }
}

constexpr int NPHASE = 34;
#ifndef PHMASK
#define PHMASK 0xFFFFu
#endif
#define PHON(b) ((PHMASK >> (b)) & 1u)
#ifndef REPMASK
#define REPMASK 0u
#endif
#ifndef REPN
#define REPN 1
#endif
#define NREP(b) (((REPMASK >> (b)) & 1u) ? (1 + REPN) : 1)
#ifndef TIMEMASK
#define TIMEMASK 0u
#endif
#ifndef TIMEK
#define TIMEK 4
#endif
#define TIMEON(b) ((TIMEMASK >> (b)) & 1u)
#define TBEG(b) do { if (TIMEON(b)) t_beg = __builtin_amdgcn_s_memrealtime(); } while (0)
#define TEND(b) do { if (TIMEON(b)) t_acc += __builtin_amdgcn_s_memrealtime() - t_beg; } while (0)

__global__ void __launch_bounds__(NTHREADS, 2) fwd_kernel(Args args) {
    extern __shared__ __attribute__((aligned(16))) unsigned char lds_raw[];
    Frame F;
    F.lds = (LAS unsigned char*)lds_raw;
    F.tid = threadIdx.x; F.lane = F.tid & 63; F.wave = __builtin_amdgcn_readfirstlane(F.tid >> 6);
    F.G = gridDim.x; { const int bx = blockIdx.x; F.vcu = (F.G % 8 == 0) ? (bx % 8) * (F.G / 8) + bx / 8 : bx; }
    F.ws = args.ws;
    volatile LAS unsigned* MISC = (volatile LAS unsigned*)(F.lds + MISC_OFF);
    for (int u = F.tid; u < 256; u += NTHREADS) MISC[u] = 0u;
    __syncthreads();
    unsigned* ctl = (unsigned*)(F.ws + WS_CTL);
    const int lo = args.ph_lo, hi = args.ph_hi;
    const bool multi = (hi - lo) > 1;
    XcdBarrier bar; bar.bar = ctl + CW_BAR; bar.x = 0; bar.st = nullptr;
    if (multi) bar = xcd_barrier_post(ctl + CW_BAR, MISC + 8);
#define IN(k) (lo <= (k) && (k) < hi)
#define SEAM(k) do { if (IN(k) && IN((k) + 1)) xcd_barrier(bar); } while (0)

    unsigned long long t_beg = 0, t_acc = 0;
    TBEG(0);
    if (PHON(0) && IN(0)) { for (int rep = 0; rep < NREP(0); ++rep) { phase_prologue(F, args); __syncthreads(); } }
    SEAM(0);
    TEND(0);

    const float* MODB = (const float*)(F.ws + WS_MOD);
#pragma unroll 1
    for (int l = 0; l < NL; ++l) {
        const int pb = 1 + 8 * l;
        const float* xin = (l == 0) ? args.in[0] : args.out;
        TBEG(1);
        if (PHON(1) && IN(pb + 0)) { if (l > 0) build_moe_table(F, l - 1); phase_norm1(F, args, l); }
        SEAM(pb + 0);
        TEND(1);
        TBEG(2);
        if (PHON(2) && IN(pb + 1)) {
            pg8::DenseSched S{(const char*)(F.ws + WS_HBUF), (const char*)(F.ws + WS_WIN) + (size_t)l * NPROJ * 1024 * 2, T / 256, NPROJ / 256, F.G, (int)blockIdx.x, 2048, 2048};
            pg8::EpiProj E{(bf16_t*)(F.ws + WS_REST), (bf16_t*)(F.ws + WS_QH), l & 1};
            for (int rep = 0; rep < NREP(2); ++rep) pg8::gemm_phase<pg8::EpiProj, pg8::DenseSched, false>(F.lds, 2048, 2048, S, E);
        }
        SEAM(pb + 1);
        TEND(2);
        TBEG(3);
        if (IN(pb + 2)) { if (l & 1) { if (PHON(3)) for (int rep = 0; rep < NREP(3); ++rep) { phase_conv(F, args, l >> 1); __syncthreads(); } } else { if (PHON(4)) for (int rep = 0; rep < NREP(4); ++rep) { phase_dilated2(F, args); __syncthreads(); } } }
        if (l & 1) __syncthreads(); else SEAM(pb + 2);
        TEND(3);
        TBEG(5);
        if (IN(pb + 3)) { if (l & 1) { if (PHON(5)) for (int rep = 0; rep < NREP(5); ++rep) { phase_stick(F); __syncthreads(); } } else { if (PHON(6)) for (int rep = 0; rep < NREP(6); ++rep) { phase_gmlp(F, args, l >> 1); __syncthreads(); } if (PHON(4)) phase_dil_combine(F); } }
        SEAM(pb + 3);
        TEND(5);
        TBEG(7);
        if (PHON(7) && IN(pb + 4)) {
            pg8::DenseSched S{(const char*)(F.ws + WS_MIX), (const char*)(F.ws + WS_WOUT) + (size_t)l * 1024 * 1024 * 2, T / 256, D / 256, F.G, (int)blockIdx.x, 2048, 2048};
            pg8::EpiDelta E{(bf16_t*)(F.ws + WS_HBUF), MODB + (size_t)l * 16 * 6144 + 2048};
            for (int rep = 0; rep < NREP(7); ++rep) pg8::gemm_phase<pg8::EpiDelta, pg8::DenseSched, false>(F.lds, 2048, 2048, S, E);
        }
        SEAM(pb + 4);
        TEND(7);
        TBEG(8);
        if (PHON(8) && IN(pb + 5)) phase_router(F, args, l, xin);
        SEAM(pb + 5);
        TEND(8);
        TBEG(9);
        if (PHON(9) && IN(pb + 6)) {
            build_moe_table(F, l);
            pg8::MoeSched1 S{(const char*)(F.ws + WS_H8), (const char*)(F.ws + WS_WGU) + (size_t)l * 16 * 1024 * 1024, (const char*)(F.ws + WS_TLIST), (const LAS int*)(F.lds + 131072), F.G, (int)blockIdx.x};
            pg8::EpiHid E{F.ws + WS_PROJ, (const float*)(F.ws + WS_RW), 1.f / (SC_H2 * SC_WGU), SC_HID};
            for (int rep = 0; rep < NREP(9); ++rep) pg8::gemm_phase<pg8::EpiHid, pg8::MoeSched1, true, true>(F.lds, 1024, 1024, S, E);
        }
        SEAM(pb + 6);
        TEND(9);
        TBEG(10);
        if (PHON(10) && IN(pb + 7)) {
            build_moe_table(F, l);
            pg8::MoeSched2 S{(const char*)(F.ws + WS_PROJ), (const char*)(F.ws + WS_WDT) + (size_t)l * 1024 * 8192, (const LAS int*)(F.lds + 131072), F.G, (int)blockIdx.x};
            pg8::EpiBf16Store E{(bf16_t*)(F.ws + WS_HSORT), D, 1.f / (SC_HID * SC_WD)};
            for (int rep = 0; rep < NREP(10); ++rep) pg8::gemm_phase<pg8::EpiBf16Store, pg8::MoeSched2, true>(F.lds, 1024, 8192, S, E);
        }
        SEAM(pb + 7);
        TEND(10);
    }
    TBEG(11);
    if (PHON(11) && IN(33)) { build_moe_table(F, NL - 1); phase_final(F, args); }
    TEND(11);
    if (TIMEMASK != 0u && blockIdx.x == 0) {
        const unsigned long long t0 = __builtin_amdgcn_s_memrealtime();
        while (__builtin_amdgcn_s_memrealtime() - t0 < (unsigned long long)TIMEK * t_acc) __builtin_amdgcn_s_sleep(8);
    }
#undef IN
#undef SEAM
}

extern "C" void kernel_launch(void* const* d_in, const int* in_sizes, int n_in, void* d_out, int out_size, void* d_ws, size_t ws_size, hipStream_t stream) {
    static int grid = 0;
    if (grid == 0) {
        if (n_in != 27 || out_size != T * D || ws_size < WS_END) { fprintf(stderr, "kernel_launch: unexpected shapes (n_in %d out %d ws %zu)\n", n_in, out_size, ws_size); grid = -1; return; }
        int dev = 0, cus = 0, per_cu = 0;
        if (hipGetDevice(&dev) != hipSuccess || hipDeviceGetAttribute(&cus, hipDeviceAttributeMultiprocessorCount, dev) != hipSuccess) { grid = -1; return; }
        if (hipFuncSetAttribute((const void*)fwd_kernel, hipFuncAttributeMaxDynamicSharedMemorySize, LDS_BYTES) != hipSuccess) { fprintf(stderr, "kernel_launch: hipFuncSetAttribute failed\n"); grid = -1; return; }
        if (hipOccupancyMaxActiveBlocksPerMultiprocessor(&per_cu, (const void*)fwd_kernel, NTHREADS, LDS_BYTES) != hipSuccess || per_cu < 1) { fprintf(stderr, "kernel_launch: occupancy query says %d\n", per_cu); }
        (void)hipGetLastError();
        grid = cus;
    }
    if (grid < 0) return;
    (void)hipMemsetAsync((char*)d_ws + WS_CTL, 0, CTL_ZERO_BYTES, stream);
    Args a{};
    for (int i = 0; i < 27; ++i) a.in[i] = (const float*)d_in[i];
    a.out = (float*)d_out; a.ws = (unsigned char*)d_ws;
#ifndef MK_MULTI
    a.ph_lo = 0; a.ph_hi = NPHASE;
    hipLaunchKernelGGL(fwd_kernel, dim3(grid), dim3(NTHREADS), LDS_BYTES, stream, a);
#else
    for (int p = 0; p < NPHASE; ++p) { a.ph_lo = p; a.ph_hi = p + 1; hipLaunchKernelGGL(fwd_kernel, dim3(grid), dim3(NTHREADS), LDS_BYTES, stream, a); }
#endif
}
```
